# Optimizing an MI355X kernel written in HIP

```python
import jax, jax.numpy as jnp
from jax import lax

D_MODEL = 1024
BATCH = 8
SEQ = 2048
DEPTH = 4

GRID_W = 64
CTX_LEN = 256
N_MIXERS = 2
N_LRU_LAYERS = (DEPTH + 1) // 2
N_ATTN_LAYERS = DEPTH // 2
LRU_WIDTH = D_MODEL
LRU_BLOCKS = 8
LRU_BLOCK_W = LRU_WIDTH // LRU_BLOCKS
CONV_W = 4
LRU_C = 8.0
HEAD_DIM = 128
N_HEADS = D_MODEL // HEAD_DIM
N_KV_HEADS = 2
GROUP = N_HEADS // N_KV_HEADS
WINDOW = 128
QBLOCK = 128
QKV_WIDTH = (N_HEADS + 2 * N_KV_HEADS) * HEAD_DIM
ROPE_BASE = 10000.0
N_EXPERTS = 16
EXPERT_FF = 1024
CAPACITY_FACTOR = 2
NORM_EPS = 1e-6
NEG_INF = -1e30

kernel_name = "hybrid_rglru_swa_ecmoe_diffusion"


def rmsnorm(x, g):
    xf = x.astype(jnp.float32)
    y = xf * lax.rsqrt(jnp.mean(xf * xf, axis=-1, keepdims=True) + NORM_EPS)
    return y.astype(x.dtype) * g


def modulate(h, shift, scale):
    return h * (1 + scale) + shift


def short_conv(x, w, b):
    n = x.shape[1]
    left = (CONV_W - 1) // 2
    right = CONV_W - 1 - left
    xp = jnp.pad(x, ((0, 0), (left, right), (0, 0)))
    return sum(xp[:, k:k + n] * w[k] for k in range(CONV_W)) + b


def _lin_combine(e1, e2):
    a1, b1 = e1
    a2, b2 = e2
    return a1 * a2, a2 * b1 + b2


def linear_scan(a, b, h0, reverse):
    A, H = lax.associative_scan(_lin_combine, (a, b), axis=1, reverse=reverse)
    if h0 is None:
        return H
    return H + A * h0[:, None]


def rglru_gates(xb, gate_w, gate_b, lam):
    bsz, n = xb.shape[:2]
    xg = xb.reshape(bsz, n, LRU_BLOCKS, LRU_BLOCK_W)
    gates = (jnp.einsum('bnhi,hij->bnhj', xg, gate_w.astype(jnp.float32))
             + gate_b.astype(jnp.float32))
    r = jax.nn.sigmoid(gates[..., :LRU_BLOCK_W]).reshape(bsz, n, LRU_WIDTH)
    i = jax.nn.sigmoid(gates[..., LRU_BLOCK_W:]).reshape(bsz, n, LRU_WIDTH)
    log_a = LRU_C * r * jax.nn.log_sigmoid(lam.astype(jnp.float32))
    a = jnp.exp(log_a)
    b = jnp.sqrt(-jnp.expm1(2.0 * log_a)) * (i * xb)
    return a, b


def rglru_mixer(h_lat, h_ctx, w_in, conv_w, conv_b, gate_w, gate_b, lam, w_out, need_ctx):
    def branches(h):
        u = h @ w_in
        y = jax.nn.gelu(u[..., :LRU_WIDTH])
        xb = short_conv(u[..., LRU_WIDTH:], conv_w, conv_b).astype(jnp.float32)
        return y, xb

    y_l, x_l = branches(h_lat)
    y_c, x_c = branches(h_ctx)
    s_l = 0.0
    s_c = 0.0
    for d, rev in enumerate((False, True)):
        a_c, b_c = rglru_gates(x_c, gate_w[d], gate_b[d], lam[d])
        hc = linear_scan(a_c, b_c, None, rev)
        h0 = hc[:, 0] if rev else hc[:, -1]
        a_l, b_l = rglru_gates(x_l, gate_w[d], gate_b[d], lam[d])
        hl = linear_scan(a_l, b_l, h0, rev)
        s_l = s_l + hl
        s_c = s_c + hc
    out_l = (s_l.astype(h_lat.dtype) * y_l) @ w_out
    if not need_ctx:
        return out_l, None
    out_c = (s_c.astype(h_ctx.dtype) * y_c) @ w_out
    return out_l, out_c


def rope_axial(x, rows, cols):
    half = HEAD_DIM // 2
    freqs = ROPE_BASE ** (-jnp.arange(0, half, 2, dtype=jnp.float32) / half)

    def rot(xp, pos):
        ang = pos.astype(jnp.float32)[:, None] * freqs
        cos = jnp.cos(ang)[None, :, None].astype(x.dtype)
        sin = jnp.sin(ang)[None, :, None].astype(x.dtype)
        x1, x2 = jnp.split(xp, 2, axis=-1)
        return jnp.concatenate([x1 * cos - x2 * sin, x1 * sin + x2 * cos], axis=-1)

    return jnp.concatenate([rot(x[..., :half], rows), rot(x[..., half:], cols)], axis=-1)


def split_qkv(h, w_qkv):
    bsz, n = h.shape[:2]
    u = h @ w_qkv
    nq = N_HEADS * HEAD_DIM
    nk = N_KV_HEADS * HEAD_DIM
    q = u[..., :nq].reshape(bsz, n, N_HEADS, HEAD_DIM)
    k = u[..., nq:nq + nk].reshape(bsz, n, N_KV_HEADS, HEAD_DIM)
    v = u[..., nq + nk:].reshape(bsz, n, N_KV_HEADS, HEAD_DIM)
    return q, k, v


def attn_mixer(h_lat, h_ctx, w_qkv, sink, w_o, need_ctx):
    bsz, seq, _ = h_lat.shape
    lc = h_ctx.shape[1]
    rows_n = seq // GRID_W
    rows = jnp.repeat(jnp.arange(rows_n), GRID_W)
    cols = jnp.tile(jnp.arange(GRID_W), rows_n)
    scale = HEAD_DIM ** -0.5

    q, k, v = split_qkv(h_lat, w_qkv)
    q = rope_axial(q, rows, cols)
    k = rope_axial(k, rows, cols)
    qc, kc, vc = split_qkv(h_ctx, w_qkv)

    nblk = seq // QBLOCK
    qb = (q * scale).reshape(bsz, nblk, QBLOCK, N_KV_HEADS, GROUP, HEAD_DIM)

    def band(t):
        tp = jnp.pad(t, ((0, 0), (QBLOCK, QBLOCK), (0, 0), (0, 0)))
        tp = tp.reshape(bsz, nblk + 2, QBLOCK, N_KV_HEADS, HEAD_DIM)
        return jnp.concatenate([tp[:, j:j + nblk] for j in range(3)], axis=2)

    kb, vb = band(k), band(v)
    s_band = jnp.einsum('bnqkgd,bnskd->bnkgqs', qb, kb).astype(jnp.float32)
    qi = jnp.arange(QBLOCK)[:, None]
    sj = jnp.arange(3 * QBLOCK)[None, :]
    in_win = jnp.abs(sj - QBLOCK - qi) <= WINDOW
    kpos = jnp.arange(nblk)[:, None] * QBLOCK - QBLOCK + jnp.arange(3 * QBLOCK)[None, :]
    valid = (kpos >= 0) & (kpos < seq)
    mask = in_win[None] & valid[:, None, :]
    s_band = jnp.where(mask[None, :, None, None], s_band, NEG_INF)
    s_ctx = jnp.einsum('bnqkgd,bckd->bnkgqc', qb, kc).astype(jnp.float32)
    sink_h = sink.astype(jnp.float32).reshape(N_KV_HEADS, GROUP)
    sink_l = jnp.broadcast_to(sink_h[None, None, :, :, None, None], s_band.shape[:-1] + (1,))
    p = jax.nn.softmax(jnp.concatenate([s_band, s_ctx, sink_l], axis=-1), axis=-1)
    p_band = p[..., :3 * QBLOCK].astype(v.dtype)
    p_ctx = p[..., 3 * QBLOCK:3 * QBLOCK + lc].astype(v.dtype)
    o = (jnp.einsum('bnkgqs,bnskd->bnqkgd', p_band, vb)
         + jnp.einsum('bnkgqc,bckd->bnqkgd', p_ctx, vc))
    out_l = o.reshape(bsz, seq, N_HEADS * HEAD_DIM) @ w_o
    if not need_ctx:
        return out_l, None
    qcg = (qc * scale).reshape(bsz, lc, N_KV_HEADS, GROUP, HEAD_DIM)
    sc = jnp.einsum('bqkgd,bckd->bkgqc', qcg, kc).astype(jnp.float32)
    sink_c = jnp.broadcast_to(sink_h[None, :, :, None, None], sc.shape[:-1] + (1,))
    pc = jax.nn.softmax(jnp.concatenate([sc, sink_c], axis=-1), axis=-1)[..., :lc].astype(vc.dtype)
    oc = jnp.einsum('bkgqc,bckd->bqkgd', pc, vc).reshape(bsz, lc, N_HEADS * HEAD_DIM) @ w_o
    return out_l, oc


def ec_moe(h, router, w_gate, w_up, w_down):
    bsz, n, d = h.shape
    cap = CAPACITY_FACTOR * n // N_EXPERTS
    aff = jax.nn.softmax((h @ router).astype(jnp.float32), axis=-1)
    g, idx = lax.top_k(jnp.swapaxes(aff, 1, 2), cap)
    xg = jax.vmap(lambda hb, ib: hb[ib])(h, idx)
    a = jnp.einsum('becd,edf->becf', xg, w_gate)
    u = jnp.einsum('becd,edf->becf', xg, w_up)
    y = jnp.einsum('becf,efd->becd', jax.nn.silu(a) * u, w_down) * g[..., None].astype(h.dtype)
    return jax.vmap(lambda yb, ib: jnp.zeros((n, d), yb.dtype).at[ib.reshape(-1)].add(yb.reshape(-1, d)))(y, idx)


def setup_inputs(seed: int = 0) -> dict:
    key = jax.random.key(seed)
    ks = jax.random.split(key, 24)
    f32 = jnp.float32
    nrm = lambda k, shape, s: jax.random.normal(k, shape, f32) * s
    u = jax.random.uniform(ks[12], (N_LRU_LAYERS, 2, LRU_WIDTH), f32, minval=0.9, maxval=0.999)
    p = u ** (1.0 / LRU_C)
    lru_lambda = jnp.log(p) - jnp.log1p(-p)
    return {
        "x": nrm(ks[0], (BATCH, SEQ, D_MODEL), 1.0),
        "c": nrm(ks[1], (BATCH, D_MODEL), 1.0),
        "ctx": nrm(ks[2], (BATCH, CTX_LEN, D_MODEL), 1.0),
        "c_ctx": nrm(ks[3], (D_MODEL,), 1.0),
        "ada_w": nrm(ks[4], (DEPTH, D_MODEL, 6 * D_MODEL), 0.5 * D_MODEL ** -0.5),
        "ada_b": nrm(ks[5], (DEPTH, 6 * D_MODEL), 0.02),
        "norm1_g": 1.0 + nrm(ks[6], (DEPTH, D_MODEL), 0.02),
        "norm2_g": 1.0 + nrm(ks[7], (DEPTH, D_MODEL), 0.02),
        "lru_w_in": nrm(ks[8], (N_LRU_LAYERS, D_MODEL, 2 * LRU_WIDTH), D_MODEL ** -0.5),
        "lru_conv_w": nrm(ks[9], (N_LRU_LAYERS, CONV_W, LRU_WIDTH), CONV_W ** -0.5),
        "lru_conv_b": nrm(ks[10], (N_LRU_LAYERS, LRU_WIDTH), 0.02),
        "lru_gate_w": nrm(ks[11], (N_LRU_LAYERS, 2, LRU_BLOCKS, LRU_BLOCK_W, 2 * LRU_BLOCK_W), LRU_BLOCK_W ** -0.5),
        "lru_gate_b": nrm(ks[13], (N_LRU_LAYERS, 2, LRU_BLOCKS, 2 * LRU_BLOCK_W), 0.02),
        "lru_lambda": lru_lambda,
        "lru_w_out": nrm(ks[14], (N_LRU_LAYERS, LRU_WIDTH, D_MODEL), LRU_WIDTH ** -0.5),
        "attn_w_qkv": nrm(ks[15], (N_ATTN_LAYERS, D_MODEL, QKV_WIDTH), D_MODEL ** -0.5),
        "attn_sink": nrm(ks[16], (N_ATTN_LAYERS, N_HEADS), 0.5),
        "attn_w_o": nrm(ks[17], (N_ATTN_LAYERS, N_HEADS * HEAD_DIM, D_MODEL), (N_HEADS * HEAD_DIM) ** -0.5),
        "moe_router": nrm(ks[18], (DEPTH, D_MODEL, N_EXPERTS), D_MODEL ** -0.5),
        "moe_w_gate": nrm(ks[19], (DEPTH, N_EXPERTS, D_MODEL, EXPERT_FF), D_MODEL ** -0.5),
        "moe_w_up": nrm(ks[20], (DEPTH, N_EXPERTS, D_MODEL, EXPERT_FF), D_MODEL ** -0.5),
        "moe_w_down": nrm(ks[21], (DEPTH, N_EXPERTS, EXPERT_FF, D_MODEL), EXPERT_FF ** -0.5),
        "final_g": 1.0 + nrm(ks[22], (D_MODEL,), 0.02),
    }


def reference(x, c, ctx, c_ctx, ada_w, ada_b, norm1_g, norm2_g,
              lru_w_in, lru_conv_w, lru_conv_b, lru_gate_w, lru_gate_b, lru_lambda, lru_w_out,
              attn_w_qkv, attn_sink, attn_w_o,
              moe_router, moe_w_gate, moe_w_up, moe_w_down, final_g):
    sc = jax.nn.silu(c)[:, None, :]
    sc_ctx = jax.nn.silu(c_ctx)
    for l in range(DEPTH):
        need_ctx = l < DEPTH - 1
        sh1, sc1, g1, sh2, sc2, g2 = jnp.split(sc @ ada_w[l] + ada_b[l], 6, axis=-1)
        ch1, cs1, cg1, ch2, cs2, cg2 = jnp.split(sc_ctx @ ada_w[l] + ada_b[l], 6, axis=-1)

        h_l = modulate(rmsnorm(x, norm1_g[l]), sh1, sc1)
        h_c = modulate(rmsnorm(ctx, norm1_g[l]), ch1, cs1)
        j = l // N_MIXERS
        if l % N_MIXERS == 0:
            y_l, y_c = rglru_mixer(h_l, h_c, lru_w_in[j], lru_conv_w[j], lru_conv_b[j],
                                   lru_gate_w[j], lru_gate_b[j], lru_lambda[j], lru_w_out[j], need_ctx)
        else:
            y_l, y_c = attn_mixer(h_l, h_c, attn_w_qkv[j], attn_sink[j], attn_w_o[j], need_ctx)
        x = x + g1 * y_l
        if need_ctx:
            ctx = ctx + cg1 * y_c

        h_l = modulate(rmsnorm(x, norm2_g[l]), sh2, sc2)
        x = x + g2 * ec_moe(h_l, moe_router[l], moe_w_gate[l], moe_w_up[l], moe_w_down[l])
        if need_ctx:
            h_c = modulate(rmsnorm(ctx, norm2_g[l]), ch2, cs2)
            ctx = ctx + cg2 * ec_moe(h_c, moe_router[l], moe_w_gate[l], moe_w_up[l], moe_w_down[l])
    return rmsnorm(x, final_g)
```

```cpp
#include <hip/hip_runtime.h>
#include <stdint.h>
#include <stdio.h>

#define DI __device__ __forceinline__
typedef _Float16 h16;
typedef _Float16 h16x2 __attribute__((ext_vector_type(2)));
typedef _Float16 h16x4 __attribute__((ext_vector_type(4)));
typedef _Float16 h16x8 __attribute__((ext_vector_type(8)));
typedef float f32x2 __attribute__((ext_vector_type(2)));
typedef float f32x4 __attribute__((ext_vector_type(4)));
typedef unsigned u32x4 __attribute__((ext_vector_type(4)));
typedef unsigned long long u64;

constexpr int D = 1024, NB = 8, SEQ = 2048, CTXL = 256, DEPTH = 4;
constexpr int ML = NB * SEQ, MC = NB * CTXL, MT = ML + MC;
constexpr int NE = 16, FF = 1024, CAPL = 256, CAPC = 32;
constexpr int PPE = NB * CAPL + NB * CAPC;
constexpr int NPAIR = NE * PPE;
constexpr int NH = 8, HD = 128, NKV = 2, QKVW = 1536;
constexpr int NT = 512;
constexpr float EPS = 1e-6f;
constexpr float QSCALE = 0.08838834764831845f * 1.4426950408889634f;
constexpr float LOG2E = 1.4426950408889634f;

constexpr size_t MiB = 1u << 20;
constexpr size_t WS_CTL = 0;
constexpr size_t WS_MOD = 1 * MiB;
constexpr size_t WS_ROPE = 2 * MiB;
constexpr size_t WS_AFF = 3 * MiB;
constexpr size_t WS_INV = 5 * MiB;
constexpr size_t WS_ROWIDX = 7 * MiB;
constexpr size_t WS_GV = 8 * MiB;
constexpr size_t WS_AGG = 9 * MiB;
constexpr size_t WS_XRES = 16 * MiB;
constexpr size_t WS_HB = 88 * MiB;
constexpr size_t WS_UB = 124 * MiB;
constexpr size_t WS_SYB = 196 * MiB;
constexpr size_t WS_ACT = 232 * MiB;
constexpr size_t WS_YO = 304 * MiB;
constexpr size_t WS_CSCR = 376 * MiB;
constexpr size_t WS_W16 = 520 * MiB;
constexpr size_t WS_END = 1024 * MiB;

struct P {
    const float *x, *c, *ctx, *c_ctx, *ada_w, *ada_b, *norm1_g, *norm2_g;
    const float *lru_w_in, *lru_conv_w, *lru_conv_b, *lru_gate_w, *lru_gate_b, *lru_lambda, *lru_w_out;
    const float *attn_w_qkv, *attn_sink, *attn_w_o, *moe_router, *moe_w_gate, *moe_w_up, *moe_w_down, *final_g;
    float* out; unsigned char* ws;
};
struct Prog { unsigned char kind[96]; unsigned char layer[96]; int n; int pad; };

enum Kind : unsigned char {
    K_MOD = 1, K_ROWFIN, K_NG_IN, K_EPI_IN, K_CONV, K_SCAN, K_NG_OUT, K_EPI_RES, K_NG_QKV, K_EPI_QKV, K_ATTN, K_NG_O,
    K_NORM2, K_TOPK, K_NG_MOE1, K_NG_MOE2, K_EPI_YO
};

DI int row_modr(int m) { return m < ML ? (m >> 11) : 8; }
DI float wave_sum(float v) {
#pragma unroll
    for (int o = 1; o < 64; o <<= 1) v += __shfl_xor(v, o);
    return v;
}
DI float wave_max(float v) {
#pragma unroll
    for (int o = 1; o < 64; o <<= 1) v = fmaxf(v, __shfl_xor(v, o));
    return v;
}
DI float fast_exp(float x) { return __builtin_amdgcn_exp2f(x * LOG2E); }
DI float sigmoidf_(float x) { return 1.0f / (1.0f + fast_exp(-x)); }
DI float siluf_(float x) { return x * sigmoidf_(x); }
DI float gelu_tanh(float x) {
    const float z = 0.7978845608028654f * (x + 0.044715f * x * x * x);
    const float e = fast_exp(2.0f * z);
    const float t = 1.0f - 2.0f / (e + 1.0f);
    return 0.5f * x * (1.0f + t);
}
DI float logsig8(float lam) {
    const float e = fast_exp(-lam);
    float l1p;
    if (e < 0.03f) l1p = e * (1.0f - e * (0.5f - e * (0.33333333f - e * (0.25f - e * 0.2f))));
    else l1p = log1pf(e);
    return -8.0f * l1p;
}
DI float neg_expm1(float z) {
    if (z > -0.25f) { const float p = z * (1.0f + z * (0.5f + z * (0.16666667f + z * (0.041666667f + z * (0.0083333333f + z * 0.0013888889f))))); return -p; }
    return 1.0f - fast_exp(z);
}
DI void lru_ab(float pr, float pi, float c8, float xb, float& a, float& bb) {
    const float r = sigmoidf_(pr), ig = sigmoidf_(pi);
    const float la = c8 * r;
    a = fast_exp(la);
    bb = sqrtf(neg_expm1(2.0f * la)) * (ig * xb);
}

DI void phase_mod(const P& p, unsigned char* lds) {
    float* s = (float*)lds;
    float* red = s + 9 * 1024;
    const int tid = threadIdx.x;
    for (int i = tid; i < 9 * 1024; i += NT) { const int r = i >> 10, k = i & 1023; const float v = r < 8 ? p.c[r * 1024 + k] : p.c_ctx[k]; s[i] = siluf_(v); }
    __syncthreads();
    float* mod = (float*)(p.ws + WS_MOD);
    const int nchunk = DEPTH * 6144 / 128;
    for (int ch = blockIdx.x; ch < nchunk; ch += gridDim.x) {
        const int l = ch / 48, n0 = (ch % 48) * 128;
        const int c = tid & 127, kq = tid >> 7;
        float acc[9];
#pragma unroll
        for (int r = 0; r < 9; ++r) acc[r] = 0.f;
        const float* w = p.ada_w + (size_t)l * 1024 * 6144 + n0 + c;
        for (int k = kq; k < 1024; k += 4) {
            const float wv = w[(size_t)k * 6144];
#pragma unroll
            for (int r = 0; r < 9; ++r) acc[r] += s[r * 1024 + k] * wv;
        }
#pragma unroll
        for (int r = 0; r < 9; ++r) red[(kq * 9 + r) * 128 + c] = acc[r];
        __syncthreads();
        for (int i = tid; i < 9 * 128; i += NT) {
            const int r = i >> 7, cc = i & 127;
            const float v = red[(0 * 9 + r) * 128 + cc] + red[(1 * 9 + r) * 128 + cc] + red[(2 * 9 + r) * 128 + cc] + red[(3 * 9 + r) * 128 + cc];
            mod[((size_t)l * 9 + r) * 6144 + n0 + cc] = v + p.ada_b[l * 6144 + n0 + cc];
        }
        __syncthreads();
    }
    if (blockIdx.x == gridDim.x - 1) {
        f32x2* tab = (f32x2*)(p.ws + WS_ROPE);
        for (int idx = tid; idx < 64 * 32; idx += NT) {
            const int pos = idx >> 5, i = idx & 31;
            double f = 1.0; for (int q = 0; q < i; ++q) f *= 0.74989420933245582730;
            const double xa = (double)pos * f;
            const double n = __builtin_rint(xa * 0.63661977236758134308);
            const double r = (xa - n * 1.5707963267948966192) - n * 6.123233995736766e-17;
            const double r2 = r * r;
            double sn = r * (1.0 + r2 * (-1.0 / 6 + r2 * (1.0 / 120 + r2 * (-1.0 / 5040 + r2 * (1.0 / 362880 + r2 * (-1.0 / 39916800 + r2 * (1.0 / 6227020800.0)))))));
            double cs = 1.0 + r2 * (-0.5 + r2 * (1.0 / 24 + r2 * (-1.0 / 720 + r2 * (1.0 / 40320 + r2 * (-1.0 / 3628800 + r2 * (1.0 / 479001600.0 + r2 * (-1.0 / 87178291200.0)))))));
            const int q = ((int)n) & 3;
            double cv, sv;
            if (q == 0) { cv = cs; sv = sn; } else if (q == 1) { cv = -sn; sv = cs; } else if (q == 2) { cv = -cs; sv = -sn; } else { cv = sn; sv = -cs; }
            tab[idx] = (f32x2){(float)cv, (float)sv};
        }
    }
}

DI void phase_rowfin(const P& p, int l  ) {
    const int lane = threadIdx.x & 63, wv = threadIdx.x >> 6;
    const int gw = blockIdx.x * 8 + wv, ngw = gridDim.x * 8;
    const bool pro = (l == 255);
    float* xres = (float*)(p.ws + WS_XRES);
    const float* mod = (const float*)(p.ws + WS_MOD);
    const int* inv = (const int*)(p.ws + WS_INV);
    const h16* yo = (const h16*)(p.ws + WS_YO);
    h16* hb = (h16*)(p.ws + WS_HB);
    const int mend = (!pro && l == 3) ? ML : MT;
    for (int m = gw; m < mend; m += ngw) {
        f32x4 v[4];
        const int modr = row_modr(m);
        if (pro) {
            const float* src = m < ML ? p.x + (size_t)m * D : p.ctx + (size_t)(m - ML) * D;
#pragma unroll
            for (int j = 0; j < 4; ++j) v[j] = *(const f32x4*)(src + 4 * lane + 256 * j);
        } else {
#pragma unroll
            for (int j = 0; j < 4; ++j) v[j] = *(const f32x4*)(xres + (size_t)m * D + 4 * lane + 256 * j);
            f32x4 acc[4];
#pragma unroll
            for (int j = 0; j < 4; ++j) acc[j] = (f32x4){0.f, 0.f, 0.f, 0.f};
            for (int e = 0; e < NE; ++e) {
                const int pr = inv[m * NE + e];
                if (pr >= 0) {
                    const h16* yr = yo + (size_t)pr * D + 4 * lane;
#pragma unroll
                    for (int j = 0; j < 4; ++j) { const h16x4 y = *(const h16x4*)(yr + 256 * j); acc[j] += (f32x4){(float)y[0], (float)y[1], (float)y[2], (float)y[3]}; }
                }
            }
            const float* g2 = mod + ((size_t)l * 9 + modr) * 6144 + 5120 + 4 * lane;
#pragma unroll
            for (int j = 0; j < 4; ++j) v[j] += *(const f32x4*)(g2 + 256 * j) * acc[j];
        }
        float ss = 0.f;
#pragma unroll
        for (int j = 0; j < 4; ++j) ss += (v[j][0] * v[j][0] + v[j][1] * v[j][1]) + (v[j][2] * v[j][2] + v[j][3] * v[j][3]);
        ss = wave_sum(ss);
        const float rs = 1.0f / sqrtf(ss * (1.0f / D) + EPS);
        if (!pro && l == 3) {
#pragma unroll
            for (int j = 0; j < 4; ++j) { const f32x4 g = *(const f32x4*)(p.final_g + 4 * lane + 256 * j); *(f32x4*)(p.out + (size_t)m * D + 4 * lane + 256 * j) = v[j] * rs * g; }
        } else {
            const int nl = pro ? 0 : l + 1;
            const float* mb = mod + ((size_t)nl * 9 + modr) * 6144 + 4 * lane;
#pragma unroll
            for (int j = 0; j < 4; ++j) {
                *(f32x4*)(xres + (size_t)m * D + 4 * lane + 256 * j) = v[j];
                const f32x4 g = *(const f32x4*)(p.norm1_g + nl * D + 4 * lane + 256 * j);
                const f32x4 sh = *(const f32x4*)(mb + 256 * j), sc = *(const f32x4*)(mb + 1024 + 256 * j);
                const f32x4 h = (v[j] * rs * g) * (sc + 1.0f) + sh;
                *(h16x4*)(hb + (size_t)m * D + 4 * lane + 256 * j) = (h16x4){(h16)h[0], (h16)h[1], (h16)h[2], (h16)h[3]};
            }
        }
    }
}

DI void phase_norm2(const P& p, int l, unsigned char* lds) {
    float* rt = (float*)lds;
    const float* rsrc = p.moe_router + (size_t)l * D * NE;
    for (int i = threadIdx.x; i < D * NE / 4; i += NT) ((f32x4*)rt)[i] = ((const f32x4*)rsrc)[i];
    __syncthreads();
    const int lane = threadIdx.x & 63, wv = threadIdx.x >> 6;
    const int gw = blockIdx.x * 8 + wv, ngw = gridDim.x * 8;
    const float* xres = (const float*)(p.ws + WS_XRES);
    const float* mod = (const float*)(p.ws + WS_MOD);
    h16* hb = (h16*)(p.ws + WS_HB);
    float* aff = (float*)(p.ws + WS_AFF);
    const int mend = (l == 3) ? ML : MT;
    for (int m = gw; m < mend; m += ngw) {
        f32x4 v[4];
#pragma unroll
        for (int j = 0; j < 4; ++j) v[j] = *(const f32x4*)(xres + (size_t)m * D + 4 * lane + 256 * j);
        float ss = 0.f;
#pragma unroll
        for (int j = 0; j < 4; ++j) ss += (v[j][0] * v[j][0] + v[j][1] * v[j][1]) + (v[j][2] * v[j][2] + v[j][3] * v[j][3]);
        ss = wave_sum(ss);
        const float rs = 1.0f / sqrtf(ss * (1.0f / D) + EPS);
        const float* mb = mod + ((size_t)l * 9 + row_modr(m)) * 6144 + 3072 + 4 * lane;
        float lg[NE];
#pragma unroll
        for (int e = 0; e < NE; ++e) lg[e] = 0.f;
#pragma unroll
        for (int j = 0; j < 4; ++j) {
            const f32x4 g = *(const f32x4*)(p.norm2_g + l * D + 4 * lane + 256 * j);
            const f32x4 sh = *(const f32x4*)(mb + 256 * j), sc = *(const f32x4*)(mb + 1024 + 256 * j);
            const f32x4 h = (v[j] * rs * g) * (sc + 1.0f) + sh;
            *(h16x4*)(hb + (size_t)m * D + 4 * lane + 256 * j) = (h16x4){(h16)h[0], (h16)h[1], (h16)h[2], (h16)h[3]};
#pragma unroll
            for (int q = 0; q < 4; ++q) {
                const float* rr = rt + (size_t)(4 * lane + 256 * j + q) * NE;
#pragma unroll
                for (int e4 = 0; e4 < 4; ++e4) { const f32x4 w = *(const f32x4*)(rr + 4 * e4); lg[4 * e4 + 0] += h[q] * w[0]; lg[4 * e4 + 1] += h[q] * w[1]; lg[4 * e4 + 2] += h[q] * w[2]; lg[4 * e4 + 3] += h[q] * w[3]; }
                asm volatile("" ::: "memory");
            }
        }
        float mx = -1e30f;
#pragma unroll
        for (int e = 0; e < NE; ++e) { lg[e] = wave_sum(lg[e]); mx = fmaxf(mx, lg[e]); }
        float den = 0.f;
#pragma unroll
        for (int e = 0; e < NE; ++e) { lg[e] = expf(lg[e] - mx); den += lg[e]; }
        const float inv = 1.0f / den;
        if (lane < NE) {
            float val = 0.f;
#pragma unroll
            for (int e = 0; e < NE; ++e) val = (lane == e) ? lg[e] * inv : val;
            aff[(size_t)m * NE + lane] = val;
        }
    }
}

DI void phase_topk(const P& p, int l, unsigned char* lds) {
    u64* key = (u64*)lds;
    const float* aff = (const float*)(p.ws + WS_AFF);
    int* inv = (int*)(p.ws + WS_INV);
    int* rowidx = (int*)(p.ws + WS_ROWIDX);
    float* gv = (float*)(p.ws + WS_GV);
    const int nprob = (l == 3) ? 128 : 256;
    const int tid = threadIdx.x;
    for (int pb = blockIdx.x; pb < nprob; pb += gridDim.x) {
        const int s = pb >> 7, b = (pb >> 4) & 7, e = pb & 15;
        const int n = s ? CTXL : SEQ, cap = n >> 3;
        const int row0 = s ? ML + b * CTXL : b * SEQ;
        for (int t = tid; t < n; t += NT) key[t] = ((u64)__float_as_uint(aff[(size_t)(row0 + t) * NE + e]) << 32) | (u64)(0xFFFFFFFFu - (unsigned)t);
        __syncthreads();
        for (int k = 2; k <= n; k <<= 1)
            for (int j = k >> 1; j > 0; j >>= 1) {
                for (int i = tid; i < (n >> 1); i += NT) {
                    const int idx = ((i & ~(j - 1)) << 1) | (i & (j - 1)), ixj = idx | j;
                    const u64 a = key[idx], c = key[ixj];
                    const bool desc = (idx & k) == 0;
                    if (desc ? (a < c) : (a > c)) { key[idx] = c; key[ixj] = a; }
                }
                __syncthreads();
            }
        const int pbase = e * PPE + (s ? NB * CAPL + b * CAPC : b * CAPL);
        for (int r = tid; r < n; r += NT) {
            const u64 kk = key[r];
            const int t = (int)(0xFFFFFFFFu - (unsigned)(kk & 0xFFFFFFFFull));
            const int m = row0 + t;
            if (r < cap) { rowidx[pbase + r] = m; gv[pbase + r] = __uint_as_float((unsigned)(kk >> 32)); inv[m * NE + e] = pbase + r; }
            else inv[m * NE + e] = -1;
        }
        __syncthreads();
    }
}

struct NG {
    const h16* A; int lda; const int* rowidx;
    const float* W; const float* W2; int ldw; size_t wgroup; int rows_per_group;
    float* C; int ldc; h16* Cact; const float* gv;
    int M, N, K, mode; int m_skip_lo, m_skip_hi;
};
template <int MODE> DI void gemm_naive(const NG& g, unsigned char* lds) {
    float* As = (float*)lds;
    float* Bs = As + 16 * 68;
    float* Bs2 = Bs + 16 * 128;
    const int tid = threadIdx.x, ty = tid >> 5, tx = tid & 31;
    const int ntn = g.N / 128, ntm = g.M / 64;
    for (int tile = blockIdx.x; tile < ntm * ntn; tile += gridDim.x) {
        const int tm = tile / ntn, tn = tile % ntn, m0 = tm * 64, n0 = tn * 128;
        const int grp = m0 / g.rows_per_group, min_g = m0 - grp * g.rows_per_group;
        if (min_g >= g.m_skip_lo && min_g < g.m_skip_hi) continue;
        const float* W = g.W + grp * g.wgroup; const float* W2 = MODE == 1 ? g.W2 + grp * g.wgroup : nullptr;
        float acc[4][4], acc2[4][4];
#pragma unroll
        for (int i = 0; i < 4; ++i)
#pragma unroll
            for (int j = 0; j < 4; ++j) { acc[i][j] = 0.f; acc2[i][j] = 0.f; }
        const int ar = tid >> 3, ak = (tid & 7) * 2;
        const int arow = g.rowidx ? g.rowidx[m0 + ar] : (m0 + ar);
        const h16* ap = g.A + (size_t)arow * g.lda + ak;
        const int bk = tid >> 5, bc = (tid & 31) * 4;
        for (int k0 = 0; k0 < g.K; k0 += 16) {
            const h16x2 av = *(const h16x2*)(ap + k0);
            const f32x4 bv = *(const f32x4*)(W + (size_t)(k0 + bk) * g.ldw + n0 + bc);
            f32x4 bv2 = (f32x4){0.f, 0.f, 0.f, 0.f};
            if (MODE == 1) bv2 = *(const f32x4*)(W2 + (size_t)(k0 + bk) * g.ldw + n0 + bc);
            __syncthreads();
            As[ak * 68 + ar] = (float)av[0]; As[(ak + 1) * 68 + ar] = (float)av[1];
            *(f32x4*)(Bs + bk * 128 + bc) = bv;
            if (MODE == 1) *(f32x4*)(Bs2 + bk * 128 + bc) = bv2;
            __syncthreads();
#pragma unroll
            for (int kk = 0; kk < 16; ++kk) {
                const f32x4 a = *(const f32x4*)(As + kk * 68 + ty * 4);
                const f32x4 b = *(const f32x4*)(Bs + kk * 128 + tx * 4);
#pragma unroll
                for (int i = 0; i < 4; ++i)
#pragma unroll
                    for (int j = 0; j < 4; ++j) acc[i][j] += a[i] * b[j];
                if (MODE == 1) {
                    const f32x4 b2 = *(const f32x4*)(Bs2 + kk * 128 + tx * 4);
#pragma unroll
                    for (int i = 0; i < 4; ++i)
#pragma unroll
                        for (int j = 0; j < 4; ++j) acc2[i][j] += a[i] * b2[j];
                }
            }
        }
#pragma unroll
        for (int i = 0; i < 4; ++i) {
            const int row = m0 + ty * 4 + i, col = n0 + tx * 4;
            if (MODE == 0) *(f32x4*)(g.C + (size_t)row * g.ldc + col) = (f32x4){acc[i][0], acc[i][1], acc[i][2], acc[i][3]};
            else {
                const float gg = g.gv[row];
                h16x4 o;
#pragma unroll
                for (int j = 0; j < 4; ++j) o[j] = (h16)(siluf_(acc[i][j]) * acc2[i][j] * gg);
                *(h16x4*)(g.Cact + (size_t)row * g.ldc + col) = o;
            }
        }
    }
}

DI void phase_epi_in(const P& p) {
    const float* C = (const float*)(p.ws + WS_CSCR);
    h16* yg = (h16*)(p.ws + WS_UB); h16* xr = yg + (size_t)MT * D;
    for (size_t i = (size_t)blockIdx.x * NT + threadIdx.x; i < (size_t)MT * D / 4; i += (size_t)gridDim.x * NT) {
        const size_t m = i >> 8; const int c = (int)(i & 255) * 4;
        const f32x4 a = *(const f32x4*)(C + m * 2048 + c), b = *(const f32x4*)(C + m * 2048 + 1024 + c);
        *(h16x4*)(yg + m * D + c) = (h16x4){(h16)gelu_tanh(a[0]), (h16)gelu_tanh(a[1]), (h16)gelu_tanh(a[2]), (h16)gelu_tanh(a[3])};
        *(h16x4*)(xr + m * D + c) = (h16x4){(h16)b[0], (h16)b[1], (h16)b[2], (h16)b[3]};
    }
}
DI void phase_epi_res(const P& p, int l) {
    const float* C = (const float*)(p.ws + WS_CSCR);
    float* xres = (float*)(p.ws + WS_XRES);
    const float* mod = (const float*)(p.ws + WS_MOD);
    const size_t mend = (l == 3) ? ML : MT;
    for (size_t i = (size_t)blockIdx.x * NT + threadIdx.x; i < mend * D / 4; i += (size_t)gridDim.x * NT) {
        const size_t m = i >> 8; const int c = (int)(i & 255) * 4;
        const f32x4 g = *(const f32x4*)(mod + ((size_t)l * 9 + row_modr((int)m)) * 6144 + 2048 + c);
        *(f32x4*)(xres + m * D + c) += g * *(const f32x4*)(C + m * D + c);
    }
}
DI void phase_epi_qkv(const P& p) {
    const float* C = (const float*)(p.ws + WS_CSCR);
    h16* qkv = (h16*)(p.ws + WS_UB);
    const f32x2* tab = (const f32x2*)(p.ws + WS_ROPE);
    for (size_t i = (size_t)blockIdx.x * NT + threadIdx.x; i < (size_t)MT * QKVW; i += (size_t)gridDim.x * NT) {
        const int m = (int)(i / QKVW), col = (int)(i % QKVW);
        float v = C[i]; int dcol = col;
        if (col < 1280) {
            const int d = col & 127, hb = col - d, hh = d >> 6, e = d & 63, s = e >> 5, fi = e & 31;
            if (m < ML) {
                const int t = m & 2047, pos = hh ? (t & 63) : (t >> 6);
                const f32x2 cs = tab[pos * 32 + fi];
                const float x1 = C[(size_t)m * QKVW + hb + hh * 64 + fi], x2 = C[(size_t)m * QKVW + hb + hh * 64 + 32 + fi];
                v = s ? (x1 * cs[1] + x2 * cs[0]) : (x1 * cs[0] - x2 * cs[1]);
            }
            if (col < 1024) v *= QSCALE;
            dcol = hb + hh * 64 + 2 * fi + s;
        }
        qkv[(size_t)m * QKVW + dcol] = (h16)v;
    }
}
DI void phase_epi_yo(const P& p, int l) {
    const float* C = (const float*)(p.ws + WS_CSCR);
    h16* yo = (h16*)(p.ws + WS_YO);
    for (size_t i = (size_t)blockIdx.x * NT + threadIdx.x; i < (size_t)NPAIR * D / 4; i += (size_t)gridDim.x * NT) {
        const f32x4 a = *(const f32x4*)(C + i * 4);
        *(h16x4*)(yo + i * 4) = (h16x4){(h16)a[0], (h16)a[1], (h16)a[2], (h16)a[3]};
    }
}

DI void phase_conv(const P& p, int j) {
    const h16* xr = (const h16*)(p.ws + WS_UB) + (size_t)MT * D;
    h16* xb = (h16*)(p.ws + WS_CSCR);
    const float* cw = p.lru_conv_w + (size_t)j * 4 * D; const float* cb = p.lru_conv_b + (size_t)j * D;
    for (size_t i = (size_t)blockIdx.x * NT + threadIdx.x; i < (size_t)MT * D; i += (size_t)gridDim.x * NT) {
        const int m = (int)(i >> 10), c = (int)(i & 1023);
        int t, n; if (m < ML) { t = m & 2047; n = SEQ; } else { t = (m - ML) & 255; n = CTXL; }
        float acc = cb[c];
#pragma unroll
        for (int k = 0; k < 4; ++k) { const int tt = t + k - 1; if (tt >= 0 && tt < n) acc += cw[k * D + c] * (float)xr[(size_t)(m + k - 1) * D + c]; }
        xb[i] = (h16)acc;
    }
}
DI void phase_scan_ref(const P& p, int j, unsigned char* lds) {
    float* gw = (float*)lds;
    float* xs = gw + 128 * 256;
    float* red = xs + 128;
    const h16* xb = (const h16*)(p.ws + WS_CSCR);
    float* S = (float*)(p.ws + WS_CSCR + 40 * MiB);
    const h16* yg = (const h16*)(p.ws + WS_UB);
    h16* sy = (h16*)(p.ws + WS_SYB);
    const int tid = threadIdx.x, ch = tid & 127, kq = tid >> 7;
    for (int it = blockIdx.x; it < NB * 8; it += gridDim.x) {
        const int b = it >> 3, blk = it & 7, chan = blk * 128 + ch;
        for (int d = 0; d < 2; ++d) {
            __syncthreads();
            const float* gsrc = p.lru_gate_w + ((size_t)((j * 2 + d) * 8 + blk)) * 128 * 256;
            for (int i = tid; i < 128 * 256 / 4; i += NT) ((f32x4*)gw)[i] = ((const f32x4*)gsrc)[i];
            const float gbr = p.lru_gate_b[((j * 2 + d) * 8 + blk) * 256 + ch], gbi = p.lru_gate_b[((j * 2 + d) * 8 + blk) * 256 + 128 + ch];
            const float c8 = logsig8(p.lru_lambda[(j * 2 + d) * D + chan]);
            float h = 0.f;
            __syncthreads();
            for (int step = 0; step < CTXL + SEQ; ++step) {
                int v;
                if (d == 0) v = step; else v = step < CTXL ? (CTXL - 1 - step) : (CTXL + SEQ - 1 - (step - CTXL));
                const int m = v < CTXL ? ML + b * CTXL + v : b * SEQ + (v - CTXL);
                if (tid < 128) xs[tid] = (float)xb[(size_t)m * D + blk * 128 + tid];
                __syncthreads();
                float pr = 0.f, pi = 0.f;
#pragma unroll 8
                for (int i = 0; i < 32; ++i) { const float xv = xs[kq * 32 + i]; pr += xv * gw[(kq * 32 + i) * 256 + ch]; pi += xv * gw[(kq * 32 + i) * 256 + 128 + ch]; }
                red[(kq * 2 + 0) * 128 + ch] = pr; red[(kq * 2 + 1) * 128 + ch] = pi;
                __syncthreads();
                if (kq == 0) {
                    pr = gbr + ((red[0 * 128 + ch] + red[2 * 128 + ch]) + (red[4 * 128 + ch] + red[6 * 128 + ch]));
                    pi = gbi + ((red[1 * 128 + ch] + red[3 * 128 + ch]) + (red[5 * 128 + ch] + red[7 * 128 + ch]));
                    float a, bb; lru_ab(pr, pi, c8, xs[ch], a, bb);
                    h = a * h + bb;
                    if (d == 0) S[(size_t)m * D + chan] = h;
                    else sy[(size_t)m * D + chan] = (h16)((S[(size_t)m * D + chan] + h) * (float)yg[(size_t)m * D + chan]);
                }
            }
        }
    }
}

DI void phase_attn_ref(const P& p, int l, unsigned char* lds) {
    const int lane = threadIdx.x & 63, wv = threadIdx.x >> 6;
    float* pl = (float*)lds + wv * 576;
    const h16* qkv = (const h16*)(p.ws + WS_UB);
    h16* o = (h16*)(p.ws + WS_SYB);
    const int j = l >> 1;
    const int mend = (l == 3) ? ML : MT;
    const int gw = blockIdx.x * 8 + wv, ngw = gridDim.x * 8;
    for (int it = gw; it < mend * NH; it += ngw) {
        const int m = it >> 3, hq = it & 7, kvh = hq >> 2;
        int b, nband, t0 = 0;
        if (m < ML) { b = m >> 11; const int t = m & 2047; t0 = t - 128 < 0 ? 0 : t - 128; const int t1 = t + 128 > SEQ - 1 ? SEQ - 1 : t + 128; nband = t1 - t0 + 1; }
        else { b = (m - ML) >> 8; nband = 0; }
        const int nk = nband + CTXL;
        const h16* q = qkv + (size_t)m * QKVW + hq * HD;
        float qv[2]; qv[0] = (float)q[lane * 2]; qv[1] = (float)q[lane * 2 + 1];
        float mx = p.attn_sink[j * NH + hq] * LOG2E;
        for (int kk = lane; kk < nk; kk += 64) {
            const int krow = kk < nband ? (b * SEQ + t0 + kk) : (ML + b * CTXL + (kk - nband));
            const h16* kp = qkv + (size_t)krow * QKVW + 1024 + kvh * HD;
            float s = 0.f;
#pragma unroll 4
            for (int d8 = 0; d8 < 16; ++d8) { const h16x8 kv = *(const h16x8*)(kp + d8 * 8), qq = *(const h16x8*)(q + d8 * 8);
#pragma unroll
                for (int e = 0; e < 8; ++e) s += (float)kv[e] * (float)qq[e]; }
            pl[kk] = s; mx = fmaxf(mx, s);
        }
        mx = wave_max(mx);
        float den = 0.f;
        for (int kk = lane; kk < nk; kk += 64) { const float e = __builtin_amdgcn_exp2f(pl[kk] - mx); pl[kk] = e; den += e; }
        den = wave_sum(den) + __builtin_amdgcn_exp2f(p.attn_sink[j * NH + hq] * LOG2E - mx);
        asm volatile("s_waitcnt lgkmcnt(0)" ::: "memory");
        float o0 = 0.f, o1 = 0.f;
        for (int kk = 0; kk < nk; ++kk) {
            const int krow = kk < nband ? (b * SEQ + t0 + kk) : (ML + b * CTXL + (kk - nband));
            const h16x2 vv = *(const h16x2*)(qkv + (size_t)krow * QKVW + 1280 + kvh * HD + lane * 2);
            const float pp = pl[kk];
            o0 += pp * (float)vv[0]; o1 += pp * (float)vv[1];
        }
        const float id = 1.0f / den;
        *(h16x2*)(o + (size_t)m * D + hq * HD + lane * 2) = (h16x2){(h16)(o0 * id), (h16)(o1 * id)};
        (void)qv;
    }
}

constexpr int LDS_BYTES = 147456;
template <int KIND> __global__ void __launch_bounds__(NT, 2) k_phase(P p, int l) {
    extern __shared__ __attribute__((aligned(16))) unsigned char lds[];
    const int j = l >> 1;
    const h16* hb = (const h16*)(p.ws + WS_HB);
    float* cscr = (float*)(p.ws + WS_CSCR);
    if constexpr (KIND == K_MOD) phase_mod(p, lds);
    if constexpr (KIND == K_ROWFIN) phase_rowfin(p, l);
    if constexpr (KIND == K_NG_IN) { NG g{hb, D, nullptr, p.lru_w_in + (size_t)j * D * 2048, nullptr, 2048, 0, MT, cscr, 2048, nullptr, nullptr, MT, 2048, D, 0, 0, 0}; gemm_naive<0>(g, lds); }
    if constexpr (KIND == K_EPI_IN) phase_epi_in(p);
    if constexpr (KIND == K_CONV) phase_conv(p, j);
    if constexpr (KIND == K_SCAN) phase_scan_ref(p, j, lds);
    if constexpr (KIND == K_NG_OUT) { NG g{(const h16*)(p.ws + WS_SYB), D, nullptr, p.lru_w_out + (size_t)j * D * D, nullptr, D, 0, MT, cscr, D, nullptr, nullptr, MT, D, D, 0, 0, 0}; gemm_naive<0>(g, lds); }
    if constexpr (KIND == K_EPI_RES) phase_epi_res(p, l);
    if constexpr (KIND == K_NG_QKV) { NG g{hb, D, nullptr, p.attn_w_qkv + (size_t)j * D * QKVW, nullptr, QKVW, 0, MT, cscr, QKVW, nullptr, nullptr, MT, QKVW, D, 0, 0, 0}; gemm_naive<0>(g, lds); }
    if constexpr (KIND == K_EPI_QKV) phase_epi_qkv(p);
    if constexpr (KIND == K_ATTN) phase_attn_ref(p, l, lds);
    if constexpr (KIND == K_NG_O) { NG g{(const h16*)(p.ws + WS_SYB), D, nullptr, p.attn_w_o + (size_t)j * D * D, nullptr, D, 0, MT, cscr, D, nullptr, nullptr, (l == 3 ? ML : MT), D, D, 0, 0, 0}; gemm_naive<0>(g, lds); }
    if constexpr (KIND == K_NORM2) phase_norm2(p, l, lds);
    if constexpr (KIND == K_TOPK) phase_topk(p, l, lds);
    if constexpr (KIND == K_NG_MOE1) { NG g{hb, D, (const int*)(p.ws + WS_ROWIDX), p.moe_w_gate + (size_t)l * NE * D * FF, p.moe_w_up + (size_t)l * NE * D * FF, FF, (size_t)D * FF, PPE,
                               nullptr, FF, (h16*)(p.ws + WS_ACT), (const float*)(p.ws + WS_GV), NPAIR, FF, D, 1, (l == 3 ? NB * CAPL : PPE), PPE}; gemm_naive<1>(g, lds); }
    if constexpr (KIND == K_NG_MOE2) { NG g{(const h16*)(p.ws + WS_ACT), FF, nullptr, p.moe_w_down + (size_t)l * NE * FF * D, nullptr, D, (size_t)FF * D, PPE,
                               cscr, D, nullptr, nullptr, NPAIR, D, FF, 0, (l == 3 ? NB * CAPL : PPE), PPE}; gemm_naive<0>(g, lds); }
    if constexpr (KIND == K_EPI_YO) phase_epi_yo(p, l);
}
template <int KIND> static void launch_kind(int grid, hipStream_t stream, const P& p, int l) { hipLaunchKernelGGL(k_phase<KIND>, dim3(grid), dim3(NT), LDS_BYTES, stream, p, l); }
static void launch_phase(int kind, int grid, hipStream_t stream, const P& p, int l) {
    switch (kind) {
#define LK(K) case K: launch_kind<K>(grid, stream, p, l); break;
        LK(K_MOD) LK(K_ROWFIN) LK(K_NG_IN) LK(K_EPI_IN) LK(K_CONV) LK(K_SCAN) LK(K_NG_OUT) LK(K_EPI_RES) LK(K_NG_QKV) LK(K_EPI_QKV) LK(K_ATTN) LK(K_NG_O)
        LK(K_NORM2) LK(K_TOPK) LK(K_NG_MOE1) LK(K_NG_MOE2) LK(K_EPI_YO)
#undef LK
    }
}
template <int KIND> static bool set_attr() { return hipFuncSetAttribute((const void*)k_phase<KIND>, hipFuncAttributeMaxDynamicSharedMemorySize, LDS_BYTES) == hipSuccess; }

static void add(Prog& g, int kind, int layer) { g.kind[g.n] = (unsigned char)kind; g.layer[g.n] = (unsigned char)layer; ++g.n; }

extern "C" void kernel_launch(void* const* d_in, const int* in_sizes, int n_in, void* d_out, int out_size, void* d_ws, size_t ws_size, hipStream_t stream) {
    static int grid = 0;
    if (grid == 0) {
        if (n_in != 23 || out_size != ML * D || ws_size < WS_END) { fprintf(stderr, "kernel_launch: unexpected sizes n_in %d out %d ws %zu\n", n_in, out_size, ws_size); grid = -1; return; }
        int dev = 0, cus = 0;
        if (hipGetDevice(&dev) != hipSuccess || hipDeviceGetAttribute(&cus, hipDeviceAttributeMultiprocessorCount, dev) != hipSuccess) { grid = -1; return; }
        bool ok = set_attr<K_MOD>() && set_attr<K_ROWFIN>() && set_attr<K_NG_IN>() && set_attr<K_EPI_IN>() && set_attr<K_CONV>() && set_attr<K_SCAN>() && set_attr<K_NG_OUT>() && set_attr<K_EPI_RES>() &&
                  set_attr<K_NG_QKV>() && set_attr<K_EPI_QKV>() && set_attr<K_ATTN>() && set_attr<K_NG_O>() && set_attr<K_NORM2>() && set_attr<K_TOPK>() && set_attr<K_NG_MOE1>() && set_attr<K_NG_MOE2>() && set_attr<K_EPI_YO>();
        if (!ok) { fprintf(stderr, "hipFuncSetAttribute failed\n"); grid = -1; return; }
        (void)hipGetLastError();
        grid = cus;
    }
    if (grid < 0) return;
    P p{};
    const float** pp = (const float**)&p;
    for (int i = 0; i < 23; ++i) pp[i] = (const float*)d_in[i];
    p.out = (float*)d_out; p.ws = (unsigned char*)d_ws;
    Prog g{};
    add(g, K_MOD, 0); add(g, K_ROWFIN, 255);
    for (int l = 0; l < DEPTH; ++l) {
        if ((l & 1) == 0) { add(g, K_NG_IN, l); add(g, K_EPI_IN, l); add(g, K_CONV, l); add(g, K_SCAN, l); add(g, K_NG_OUT, l); add(g, K_EPI_RES, l); }
        else { add(g, K_NG_QKV, l); add(g, K_EPI_QKV, l); add(g, K_ATTN, l); add(g, K_NG_O, l); add(g, K_EPI_RES, l); }
        add(g, K_NORM2, l); add(g, K_TOPK, l); add(g, K_NG_MOE1, l); add(g, K_NG_MOE2, l); add(g, K_EPI_YO, l); add(g, K_ROWFIN, l);
    }
    (void)hipMemsetAsync((char*)d_ws + WS_CTL, 0, 1 * MiB, stream);
    for (int i = 0; i < g.n; ++i) {
        launch_phase(g.kind[i], grid, stream, p, g.layer[i]);
    }
}
```

```cpp
#include <hip/hip_runtime.h>
#include <stdint.h>
#include <stdio.h>

#define DI __device__ __forceinline__
typedef _Float16 h16;
typedef _Float16 h16x2 __attribute__((ext_vector_type(2)));
typedef _Float16 h16x4 __attribute__((ext_vector_type(4)));
typedef _Float16 h16x8 __attribute__((ext_vector_type(8)));
typedef float f32x2 __attribute__((ext_vector_type(2)));
typedef float f32x4 __attribute__((ext_vector_type(4)));
typedef unsigned u32x4 __attribute__((ext_vector_type(4)));
typedef unsigned long long u64;

constexpr int D = 1024, NB = 8, SEQ = 2048, CTXL = 256, DEPTH = 4;
constexpr int ML = NB * SEQ, MC = NB * CTXL, MT = ML + MC;
constexpr int NE = 16, FF = 1024, CAPL = 256, CAPC = 32;
constexpr int PPE = NB * CAPL + NB * CAPC;
constexpr int NPAIR = NE * PPE;
constexpr int NH = 8, HD = 128, NKV = 2, QKVW = 1536;
constexpr int NT = 512;
constexpr float EPS = 1e-6f;
constexpr float QSCALE = 0.08838834764831845f * 1.4426950408889634f;
constexpr float LOG2E = 1.4426950408889634f;

constexpr size_t MiB = 1u << 20;
constexpr size_t WS_CTL = 0;
constexpr size_t WS_MOD = 1 * MiB;
constexpr size_t WS_ROPE = 2 * MiB;
constexpr size_t WS_AFF = 3 * MiB;
constexpr size_t WS_INV = 5 * MiB;
constexpr size_t WS_ROWIDX = 7 * MiB;
constexpr size_t WS_GV = 8 * MiB;
constexpr size_t WS_AGG = 9 * MiB;
constexpr size_t WS_XRES = 16 * MiB;
constexpr size_t WS_HB = 88 * MiB;
constexpr size_t WS_UB = 124 * MiB;
constexpr size_t WS_SYB = 196 * MiB;
constexpr size_t WS_ACT = 232 * MiB;
constexpr size_t WS_YO = 304 * MiB;
constexpr size_t WS_CSCR = 376 * MiB;
constexpr size_t WS_W16 = 520 * MiB;
constexpr size_t WS_END = 1024 * MiB;

struct P {
    const float *x, *c, *ctx, *c_ctx, *ada_w, *ada_b, *norm1_g, *norm2_g;
    const float *lru_w_in, *lru_conv_w, *lru_conv_b, *lru_gate_w, *lru_gate_b, *lru_lambda, *lru_w_out;
    const float *attn_w_qkv, *attn_sink, *attn_w_o, *moe_router, *moe_w_gate, *moe_w_up, *moe_w_down, *final_g;
    float* out; unsigned char* ws;
};
typedef const P __attribute__((address_space(4)))* PC;
struct Prog { unsigned char kind[96]; unsigned char layer[96]; int n; int pad; };

enum Kind : unsigned char {
    K_MOD = 1, K_ROWFIN, K_NG_IN, K_EPI_IN, K_CONV, K_SCAN, K_NG_OUT, K_EPI_RES, K_NG_QKV, K_EPI_QKV, K_ATTN, K_NG_O,
    K_NORM2, K_TOPK, K_NG_MOE1, K_NG_MOE2, K_EPI_YO
};

DI int row_modr(int m) { return m < ML ? (m >> 11) : 8; }
DI float shx(float v, int m, int lane) { return __int_as_float(__builtin_amdgcn_ds_bpermute((lane ^ m) << 2, __float_as_int(v))); }
DI float wave_sum(float v, int lane) {
#pragma unroll
    for (int o = 1; o < 64; o <<= 1) v += shx(v, o, lane);
    return v;
}
DI float wave_max(float v, int lane) {
#pragma unroll
    for (int o = 1; o < 64; o <<= 1) v = fmaxf(v, shx(v, o, lane));
    return v;
}
DI float fast_exp(float x) { return __builtin_amdgcn_exp2f(x * LOG2E); }
DI float sigmoidf_(float x) { return __builtin_amdgcn_rcpf(1.0f + __builtin_amdgcn_exp2f(-LOG2E * x)); }
DI float siluf_(float x) { return x * sigmoidf_(x); }
DI float gelu_tanh(float x) {
    const float z2 = x * (1.5957691216057308f + 0.07135481627f * x * x);
    return x * __builtin_amdgcn_rcpf(1.0f + __builtin_amdgcn_exp2f(-LOG2E * z2));
}
DI int tid_from(int wid) { unsigned m = ~0u; asm volatile("" : "+s"(m), "+s"(wid)); return wid * 64 + (int)__builtin_amdgcn_mbcnt_hi(m, __builtin_amdgcn_mbcnt_lo(m, 0u)); }
DI float logsig8(float lam) {
    const float e = fast_exp(-lam);
    float l1p;
    if (e < 0.03f) l1p = e * (1.0f - e * (0.5f - e * (0.33333333f - e * (0.25f - e * 0.2f))));
    else l1p = __builtin_amdgcn_logf(1.0f + e) * 0.6931471805599453f;
    return -8.0f * l1p;
}
DI float neg_expm1(float z) {
    if (z > -0.25f) { const float p = z * (1.0f + z * (0.5f + z * (0.16666667f + z * (0.041666667f + z * (0.0083333333f + z * 0.0013888889f))))); return -p; }
    return 1.0f - fast_exp(z);
}
DI void lru_ab(float pr, float pi, float c8, float xb, float& a, float& bb) {
    const float r = sigmoidf_(pr), ig = sigmoidf_(pi);
    const float la = c8 * r;
    a = fast_exp(la);
    bb = sqrtf(neg_expm1(2.0f * la)) * (ig * xb);
}

DI void phase_mod(PC p, unsigned char* lds, int wid_) {
    int tidx = tid_from(wid_), bidx = blockIdx.x; asm volatile("" : "+v"(tidx), "+s"(bidx), "+s"(p));
    float* s = (float*)lds;
    float* red = s + 9 * 1024;
    const int tid = tidx;
    for (int i = tid; i < 9 * 1024; i += NT) { const int r = i >> 10, k = i & 1023; const float v = r < 8 ? p->c[r * 1024 + k] : p->c_ctx[k]; s[i] = siluf_(v); }
    __syncthreads();
    float* mod = (float*)(p->ws + WS_MOD);
    const int nchunk = DEPTH * 6144 / 32;
    const int kq = tid >> 3, cq = (tid & 7) * 4;
    for (int ch = bidx; ch < nchunk; ch += gridDim.x) {
        const int l = ch / 192, n0 = (ch % 192) * 32;
        const float* w = p->ada_w + (size_t)l * 1024 * 6144 + n0 + cq;
        f32x4 wv[16];
#pragma unroll
        for (int i = 0; i < 16; ++i) wv[i] = __builtin_nontemporal_load((const f32x4*)(w + (size_t)(kq + 64 * i) * 6144));
        f32x4 acc[9];
#pragma unroll
        for (int r = 0; r < 9; ++r) acc[r] = (f32x4){0.f, 0.f, 0.f, 0.f};
#pragma unroll
        for (int i = 0; i < 16; ++i)
#pragma unroll
            for (int r = 0; r < 9; ++r) acc[r] += wv[i] * s[r * 1024 + kq + 64 * i];
#pragma unroll
        for (int r = 0; r < 9; ++r) *(f32x4*)(red + (kq * 9 + r) * 32 + cq) = acc[r];
        __syncthreads();
        if (tid < 288) {
            const int r = tid >> 5, cc = tid & 31; float v = 0.f;
#pragma unroll 8
            for (int q = 0; q < 64; ++q) v += red[(q * 9 + r) * 32 + cc];
            mod[((size_t)l * 9 + r) * 6144 + n0 + cc] = v + p->ada_b[l * 6144 + n0 + cc];
        }
        __syncthreads();
    }
    if (bidx == gridDim.x - 1) {
        f32x2* tab = (f32x2*)(p->ws + WS_ROPE);
        for (int idx = tid; idx < 64 * 32; idx += NT) {
            const int pos = idx >> 5, i = idx & 31;
            double f = 1.0; for (int q = 0; q < i; ++q) f *= 0.74989420933245582730;
            const double xa = (double)pos * f;
            const double n = __builtin_rint(xa * 0.63661977236758134308);
            const double r = (xa - n * 1.5707963267948966192) - n * 6.123233995736766e-17;
            const double r2 = r * r;
            double sn = r * (1.0 + r2 * (-1.0 / 6 + r2 * (1.0 / 120 + r2 * (-1.0 / 5040 + r2 * (1.0 / 362880 + r2 * (-1.0 / 39916800 + r2 * (1.0 / 6227020800.0)))))));
            double cs = 1.0 + r2 * (-0.5 + r2 * (1.0 / 24 + r2 * (-1.0 / 720 + r2 * (1.0 / 40320 + r2 * (-1.0 / 3628800 + r2 * (1.0 / 479001600.0 + r2 * (-1.0 / 87178291200.0)))))));
            const int q = ((int)n) & 3;
            double cv, sv;
            if (q == 0) { cv = cs; sv = sn; } else if (q == 1) { cv = -sn; sv = cs; } else if (q == 2) { cv = -cs; sv = -sn; } else { cv = sn; sv = -cs; }
            tab[idx] = (f32x2){(float)cv, (float)sv};
        }
    }
}

DI void rowfin_finish(PC p, int l, bool pro, int m, f32x4 (&v)[4], int lane, const float* T) {
    h16* xres = (h16*)(p->ws + WS_XRES);
    h16* hb = (h16*)(p->ws + WS_HB);
    float ss = 0.f;
#pragma unroll
    for (int j = 0; j < 4; ++j) ss += (v[j][0] * v[j][0] + v[j][1] * v[j][1]) + (v[j][2] * v[j][2] + v[j][3] * v[j][3]);
    ss = wave_sum(ss, lane);
    const float rs = __builtin_amdgcn_rsqf(ss * (1.0f / D) + EPS);
    const float* tb = T + (size_t)row_modr(m) * 3 * D + 4 * lane;
    if (!pro && l == 3) {
#pragma unroll
        for (int j = 0; j < 4; ++j) { const f32x4 g = *(const f32x4*)(tb + 256 * j); *(f32x4*)(p->out + (size_t)m * D + 4 * lane + 256 * j) = v[j] * rs * g; }
    } else {
#pragma unroll
        for (int j = 0; j < 4; ++j) {
            const f32x4 g = *(const f32x4*)(tb + 256 * j), sh = *(const f32x4*)(tb + D + 256 * j);
            const f32x4 h = (v[j] * rs) * g + sh;
            *(h16x4*)(xres + (size_t)m * D + 4 * lane + 256 * j) = (h16x4){(h16)v[j][0], (h16)v[j][1], (h16)v[j][2], (h16)v[j][3]};
            *(h16x4*)(hb + (size_t)m * D + 4 * lane + 256 * j) = (h16x4){(h16)h[0], (h16)h[1], (h16)h[2], (h16)h[3]};
        }
    }
}
DI void phase_rowfin(PC p, int l  , unsigned char* lds, int wid_) {
    int tidx = tid_from(wid_), bidx = blockIdx.x; asm volatile("" : "+v"(tidx), "+s"(bidx), "+s"(p));
    const int lane = tidx & 63, wv = tidx >> 6;
    const int gw = bidx * 8 + wv, ngw = gridDim.x * 8;
    const bool pro = (l == 255);
    const h16* xres = (const h16*)(p->ws + WS_XRES);
    const float* mod = (const float*)(p->ws + WS_MOD);
    const int* inv = (const int*)(p->ws + WS_INV);
    const h16* yo = (const h16*)(p->ws + WS_YO);
    const int mend = (!pro && l == 3) ? ML : MT;
    float* T = (float*)lds;
    { const bool fin = (!pro && l == 3); const int nl = pro ? 0 : l + 1;
      for (int i = tidx; i < 9 * D; i += NT) { const int r = i >> 10, k = i & 1023;
          float g, sh, g2 = 0.f;
          if (fin) { g = p->final_g[k]; sh = 0.f; }
          else { const float* mb = mod + ((size_t)nl * 9 + r) * 6144; g = p->norm1_g[nl * D + k] * (1.0f + mb[1024 + k]); sh = mb[k]; }
          if (!pro) g2 = mod[((size_t)l * 9 + r) * 6144 + 5120 + k];
          T[(r * 3 + 0) * D + k] = g; T[(r * 3 + 1) * D + k] = sh; T[(r * 3 + 2) * D + k] = g2; }
      __syncthreads(); }
    f32x4 n0[4], n1[4]; h16x4 ny0[4], ny1[4]; int npe0 = -1, npe1 = -1, qpe0 = -1, qpe1 = -1;
#pragma unroll
    for (int j = 0; j < 4; ++j) { ny0[j] = (h16x4){0, 0, 0, 0}; ny1[j] = ny0[j]; }
#define RF_INV(M0, d0, d1) { const int a_ = (M0), b_ = (a_ + ngw) < mend ? a_ + ngw : a_; d0 = -1; d1 = -1; \
        if (!pro && a_ < mend) { d0 = lane < NE ? inv[a_ * NE + lane] : -1; d1 = lane < NE ? inv[b_ * NE + lane] : -1; } }
#define RF_LOAD(M0) { const int a_ = (M0), b_ = (a_ + ngw) < mend ? a_ + ngw : a_; \
        if (pro) { const float* s0_ = a_ < ML ? p->x + (size_t)a_ * D : p->ctx + (size_t)(a_ - ML) * D; const float* s1_ = b_ < ML ? p->x + (size_t)b_ * D : p->ctx + (size_t)(b_ - ML) * D; \
            _Pragma("unroll") for (int j = 0; j < 4; ++j) { n0[j] = *(const f32x4*)(s0_ + 4 * lane + 256 * j); n1[j] = *(const f32x4*)(s1_ + 4 * lane + 256 * j); } } \
        else { _Pragma("unroll") for (int j = 0; j < 4; ++j) { const h16x4 q0_ = *(const h16x4*)(xres + (size_t)a_ * D + 4 * lane + 256 * j), q1_ = *(const h16x4*)(xres + (size_t)b_ * D + 4 * lane + 256 * j); \
            n0[j] = (f32x4){(float)q0_[0], (float)q0_[1], (float)q0_[2], (float)q0_[3]}; n1[j] = (f32x4){(float)q1_[0], (float)q1_[1], (float)q1_[2], (float)q1_[3]}; } \
            const unsigned f0_ = (unsigned)__ballot(npe0 >= 0), f1_ = (unsigned)__ballot(npe1 >= 0); \
            const int r0_ = f0_ ? __builtin_amdgcn_readlane(npe0, __builtin_ctz(f0_ | 0x10000u)) : 0, r1_ = f1_ ? __builtin_amdgcn_readlane(npe1, __builtin_ctz(f1_ | 0x10000u)) : 0; \
            _Pragma("unroll") for (int j = 0; j < 4; ++j) { ny0[j] = *(const h16x4*)(yo + (size_t)r0_ * D + 4 * lane + 256 * j); ny1[j] = *(const h16x4*)(yo + (size_t)r1_ * D + 4 * lane + 256 * j); } } }
    if (gw < mend) { RF_INV(gw, npe0, npe1) RF_LOAD(gw) RF_INV(gw + 2 * ngw, qpe0, qpe1) }
    for (int m0 = gw; m0 < mend; m0 += 2 * ngw) {
        const bool has1 = (m0 + ngw) < mend; const int m1 = has1 ? m0 + ngw : m0;
        f32x4 v0[4], v1[4]; h16x4 yf0[4], yf1[4];
#pragma unroll
        for (int j = 0; j < 4; ++j) { v0[j] = n0[j]; v1[j] = n1[j]; yf0[j] = ny0[j]; yf1[j] = ny1[j]; }
        const int pe0 = npe0, pe1 = npe1;
        npe0 = qpe0; npe1 = qpe1;
        if (m0 + 2 * ngw < mend) { RF_LOAD(m0 + 2 * ngw) RF_INV(m0 + 4 * ngw, qpe0, qpe1) }
        if (!pro) {
            f32x4 a0[4], a1[4];
            unsigned k0 = (unsigned)__ballot(pe0 >= 0), k1 = (unsigned)__ballot(pe1 >= 0);
#pragma unroll
            for (int j = 0; j < 4; ++j) {
                a0[j] = k0 ? (f32x4){(float)yf0[j][0], (float)yf0[j][1], (float)yf0[j][2], (float)yf0[j][3]} : (f32x4){0.f, 0.f, 0.f, 0.f};
                a1[j] = k1 ? (f32x4){(float)yf1[j][0], (float)yf1[j][1], (float)yf1[j][2], (float)yf1[j][3]} : (f32x4){0.f, 0.f, 0.f, 0.f}; }
            k0 &= k0 - 1; k1 &= k1 - 1;
            while (k0 | k1) {
                const bool t0 = k0 != 0u, t1 = k1 != 0u;
                const int e0 = t0 ? __builtin_ctz(k0) : 0, e1 = t1 ? __builtin_ctz(k1) : 0;
                k0 &= k0 - 1; k1 &= k1 - 1;
                int pr0 = __builtin_amdgcn_readlane(pe0, e0), pr1 = __builtin_amdgcn_readlane(pe1, e1);
                pr0 = t0 ? pr0 : 0; pr1 = t1 ? pr1 : 0;
                const h16* y0p = yo + (size_t)pr0 * D + 4 * lane; const h16* y1p = yo + (size_t)pr1 * D + 4 * lane;
                h16x4 y0[4], y1[4];
#pragma unroll
                for (int j = 0; j < 4; ++j) { y0[j] = *(const h16x4*)(y0p + 256 * j); y1[j] = *(const h16x4*)(y1p + 256 * j); }
                if (t0) {
#pragma unroll
                    for (int j = 0; j < 4; ++j) a0[j] += (f32x4){(float)y0[j][0], (float)y0[j][1], (float)y0[j][2], (float)y0[j][3]}; }
                if (t1) {
#pragma unroll
                    for (int j = 0; j < 4; ++j) a1[j] += (f32x4){(float)y1[j][0], (float)y1[j][1], (float)y1[j][2], (float)y1[j][3]}; }
            }
            const float* g20 = T + ((size_t)row_modr(m0) * 3 + 2) * D + 4 * lane;
            const float* g21 = T + ((size_t)row_modr(m1) * 3 + 2) * D + 4 * lane;
#pragma unroll
            for (int j = 0; j < 4; ++j) { v0[j] += *(const f32x4*)(g20 + 256 * j) * a0[j]; v1[j] += *(const f32x4*)(g21 + 256 * j) * a1[j]; }
        }
        rowfin_finish(p, l, pro, m0, v0, lane, T);
        if (has1) rowfin_finish(p, l, pro, m1, v1, lane, T);
    }
#undef RF_INV
#undef RF_LOAD
}

DI void phase_norm2(PC p, int l, unsigned char* lds, int cu_lo, int ncu, int m_lo, int m_hi, int wid_) {
    int tidx = tid_from(wid_), bidx = blockIdx.x; asm volatile("" : "+v"(tidx), "+s"(bidx), "+s"(p));
    if (bidx < cu_lo || bidx >= cu_lo + ncu || m_lo >= m_hi) return;
    float* rt = (float*)lds;
    const float* rsrc = p->moe_router + (size_t)l * D * NE;
    for (int i = tidx; i < D * NE / 4; i += NT) { const f32x4 w = ((const f32x4*)rsrc)[i]; const int k = i >> 2, e4 = (i & 3) * 4;
        rt[(e4 + 0) * D + k] = w[0]; rt[(e4 + 1) * D + k] = w[1]; rt[(e4 + 2) * D + k] = w[2]; rt[(e4 + 3) * D + k] = w[3]; }
    float* T2 = rt + NE * D;
    for (int i = tidx; i < 9 * D; i += NT) { const int r = i >> 10, k = i & 1023; const float* mb = (const float*)(p->ws + WS_MOD) + ((size_t)l * 9 + r) * 6144 + 3072;
        T2[(r * 2 + 0) * D + k] = p->norm2_g[l * D + k] * (1.0f + mb[1024 + k]); T2[(r * 2 + 1) * D + k] = mb[k]; }
    __syncthreads();
    const int lane = tidx & 63, wv = tidx >> 6;
    const int gw = (bidx - cu_lo) * 8 + wv, ngw = ncu * 8;
    const h16* xres = (const h16*)(p->ws + WS_XRES);
    const float* mod = (const float*)(p->ws + WS_MOD);
    h16* hb = (h16*)(p->ws + WS_HB);
    float* aff = (float*)(p->ws + WS_AFF);
    const int mend = m_hi;
    for (int m0 = m_lo + gw; m0 < mend; m0 += 2 * ngw) {
        const bool has1 = (m0 + ngw) < mend; const int m1 = has1 ? m0 + ngw : m0;
        f32x4 v0[4], v1[4];
#pragma unroll
        for (int j = 0; j < 4; ++j) { const h16x4 q0_ = *(const h16x4*)(xres + (size_t)m0 * D + 4 * lane + 256 * j), q1_ = *(const h16x4*)(xres + (size_t)m1 * D + 4 * lane + 256 * j);
            v0[j] = (f32x4){(float)q0_[0], (float)q0_[1], (float)q0_[2], (float)q0_[3]}; v1[j] = (f32x4){(float)q1_[0], (float)q1_[1], (float)q1_[2], (float)q1_[3]}; }
        float ss0 = 0.f, ss1 = 0.f;
#pragma unroll
        for (int j = 0; j < 4; ++j) { ss0 += (v0[j][0] * v0[j][0] + v0[j][1] * v0[j][1]) + (v0[j][2] * v0[j][2] + v0[j][3] * v0[j][3]); ss1 += (v1[j][0] * v1[j][0] + v1[j][1] * v1[j][1]) + (v1[j][2] * v1[j][2] + v1[j][3] * v1[j][3]); }
#pragma unroll
        for (int o = 1; o < 64; o <<= 1) { ss0 += shx(ss0, o, lane); ss1 += shx(ss1, o, lane); }
        const float rs0 = __builtin_amdgcn_rsqf(ss0 * (1.0f / D) + EPS), rs1 = __builtin_amdgcn_rsqf(ss1 * (1.0f / D) + EPS);
        const float* tb0 = T2 + (size_t)row_modr(m0) * 2 * D + 4 * lane;
        const float* tb1 = T2 + (size_t)row_modr(m1) * 2 * D + 4 * lane;
#pragma unroll
        for (int j = 0; j < 4; ++j) {
            v0[j] = (v0[j] * rs0) * *(const f32x4*)(tb0 + 256 * j) + *(const f32x4*)(tb0 + D + 256 * j);
            v1[j] = (v1[j] * rs1) * *(const f32x4*)(tb1 + 256 * j) + *(const f32x4*)(tb1 + D + 256 * j);
            *(h16x4*)(hb + (size_t)m0 * D + 4 * lane + 256 * j) = (h16x4){(h16)v0[j][0], (h16)v0[j][1], (h16)v0[j][2], (h16)v0[j][3]};
            if (has1) *(h16x4*)(hb + (size_t)m1 * D + 4 * lane + 256 * j) = (h16x4){(h16)v1[j][0], (h16)v1[j][1], (h16)v1[j][2], (h16)v1[j][3]};
        }
        float lg0[NE], lg1[NE];
#pragma unroll
        for (int e = 0; e < NE; ++e) {
            float a0 = 0.f, a1 = 0.f;
#pragma unroll
            for (int j = 0; j < 4; ++j) { const f32x4 w = *(const f32x4*)(rt + e * D + 4 * lane + 256 * j);
                a0 += (v0[j][0] * w[0] + v0[j][1] * w[1]) + (v0[j][2] * w[2] + v0[j][3] * w[3]); a1 += (v1[j][0] * w[0] + v1[j][1] * w[1]) + (v1[j][2] * w[2] + v1[j][3] * w[3]); }
            lg0[e] = a0; lg1[e] = a1;
            if (e & 1) asm volatile("" ::: "memory");
        }
#define HALVE(N, BIT) { const bool up_ = (lane & (BIT)) != 0; _Pragma("unroll") for (int e = 0; e < (N); ++e) { \
            const float k0_ = up_ ? lg0[e + (N)] : lg0[e], s0_ = up_ ? lg0[e] : lg0[e + (N)]; lg0[e] = k0_ + shx(s0_, (BIT), lane); \
            const float k1_ = up_ ? lg1[e + (N)] : lg1[e], s1_ = up_ ? lg1[e] : lg1[e + (N)]; lg1[e] = k1_ + shx(s1_, (BIT), lane); } }
        HALVE(8, 32) HALVE(4, 16) HALVE(2, 8) HALVE(1, 4)
#undef HALVE
        float x0 = lg0[0], x1 = lg1[0];
        x0 += shx(x0, 2, lane); x1 += shx(x1, 2, lane); x0 += shx(x0, 1, lane); x1 += shx(x1, 1, lane);
        float mx0 = x0, mx1 = x1;
#pragma unroll
        for (int o = 4; o < 64; o <<= 1) { mx0 = fmaxf(mx0, shx(mx0, o, lane)); mx1 = fmaxf(mx1, shx(mx1, o, lane)); }
        const float p0 = __builtin_amdgcn_exp2f((x0 - mx0) * LOG2E), p1 = __builtin_amdgcn_exp2f((x1 - mx1) * LOG2E);
        float d0 = p0, d1 = p1;
#pragma unroll
        for (int o = 4; o < 64; o <<= 1) { d0 += shx(d0, o, lane); d1 += shx(d1, o, lane); }
        if ((lane & 3) == 0) { aff[(size_t)m0 * NE + (lane >> 2)] = p0 / d0; if (has1) aff[(size_t)m1 * NE + (lane >> 2)] = p1 / d1; }
    }
}

constexpr int LDS_BYTES = 147456;
constexpr size_t W_IN_T = WS_W16, W_OUT_T = WS_W16 + 8 * MiB, W_QKV_T = WS_W16 + 12 * MiB, W_O_T = WS_W16 + 18 * MiB, W_GATE16 = WS_W16 + 22 * MiB;
constexpr size_t W_GU_T = WS_W16 + 24 * MiB, W_DN_T = WS_W16 + 280 * MiB;
static_assert(W_DN_T + 128 * MiB <= WS_END, "ws map");

DI int map_row(int kind, int n) {
    if (kind == 1) { if (n >= 1280) return n; const int d = n & 127, hb = n - d, hh = d >> 6, e = d & 63; return hb + hh * 64 + 2 * (e & 31) + (e >> 5); }
    if (kind == 2) return 256 * (n >> 7) + (n & 127);
    if (kind == 3) return 256 * (n >> 7) + 128 + (n & 127);
    return n;
}
struct CvItem { const float* src; h16* dst; int K, N, kind, k0, n0; };
DI void cv_load(const CvItem& c, f32x4 (&ld)[8], int lane) {
#pragma unroll
    for (int i = 0; i < 8; ++i) ld[i] = __builtin_nontemporal_load((const f32x4*)(c.src + (size_t)(c.k0 + 8 * i + (lane >> 3)) * c.N + c.n0 + (lane & 7) * 4));
}
DI void cv_finish(const CvItem& c, const f32x4 (&ld)[8], float* scr, int lane) {
#pragma unroll
    for (int i = 0; i < 8; ++i) { float* d = scr + (8 * i + (lane >> 3)) * 33 + (lane & 7) * 4; d[0] = ld[i][0]; d[1] = ld[i][1]; d[2] = ld[i][2]; d[3] = ld[i][3]; }
    asm volatile("s_waitcnt lgkmcnt(0)" ::: "memory");
    const int cc = lane & 7;
#pragma unroll
    for (int j = 0; j < 4; ++j) { const int n = (lane >> 3) + 8 * j; const float* sp = scr + (8 * cc) * 33 + n;
        h16x8 o;
#pragma unroll
        for (int q = 0; q < 8; ++q) o[q] = (h16)sp[q * 33];
        __builtin_nontemporal_store(o, (h16x8*)(c.dst + (size_t)map_row(c.kind, c.n0 + n) * c.K + c.k0 + 8 * cc)); }
    asm volatile("s_waitcnt lgkmcnt(0)" ::: "memory");
}
constexpr int CV_DENSE = 5632, CV_PRE = 6144, CV_LAYER = 24576;
constexpr int FQ_A = 80, FQ_T = 24, FQ_Z = 96, FQ_AT = 44;
constexpr int SEG_T = 128 * FQ_T, SEG_Z = 64 * FQ_Z, SEG_PREV = SEG_T + SEG_Z, SEG_A_LRU = 192 * FQ_A, SEG_A_ATT = 80 * FQ_A, SEG_AT = 192 * FQ_AT;
DI constexpr int cv_prev(int L) { return L == 0 ? 0 : SEG_PREV; }
DI constexpr int cv_own(int L) { return (L & 1) ? SEG_A_ATT + (L == DEPTH - 1 ? 0 : SEG_AT) : SEG_A_LRU; }
DI constexpr int cv_p(int L) { return CV_LAYER - cv_prev(L) - cv_own(L); }
static_assert(cv_p(0) >= 0 && cv_p(1) >= 0 && cv_p(2) >= 0 && cv_p(3) >= 0, "filler plan");
DI CvItem cv_decode(PC p, int it) {
    constexpr int I_IN = 1024, I_SQ = 512, I_QKV = 768;
    CvItem c; int r = it, item;
    if (r >= CV_PRE) {
        r -= CV_PRE; const int mat = r / I_SQ, le = mat / 3, kind = mat % 3; item = r % I_SQ;
        c.K = D; c.N = FF;
        if (kind == 0) { c.src = p->moe_w_gate + (size_t)le * D * FF; c.dst = (h16*)(p->ws + W_GU_T) + (size_t)le * 2048 * D; c.kind = 2; }
        else if (kind == 1) { c.src = p->moe_w_up + (size_t)le * D * FF; c.dst = (h16*)(p->ws + W_GU_T) + (size_t)le * 2048 * D; c.kind = 3; }
        else { c.src = p->moe_w_down + (size_t)le * FF * D; c.dst = (h16*)(p->ws + W_DN_T) + (size_t)le * D * FF; c.kind = 0; }
    } else if (r >= CV_DENSE) { r -= CV_DENSE; const int mat = r >> 4; item = r & 15;
        c.src = p->lru_gate_w + (size_t)mat * 128 * 256; c.dst = (h16*)(p->ws + W_GATE16) + (size_t)mat * 256 * 128; c.K = 128; c.N = 256; c.kind = 0;
    } else if (r < 2 * I_IN) { const int j = r / I_IN; item = r % I_IN; c.src = p->lru_w_in + (size_t)j * D * 2048; c.dst = (h16*)(p->ws + W_IN_T) + (size_t)j * 2048 * D; c.K = D; c.N = 2048; c.kind = 0;
    } else if (r < 2 * I_IN + 2 * I_SQ) { r -= 2 * I_IN; const int j = r / I_SQ; item = r % I_SQ; c.src = p->lru_w_out + (size_t)j * D * D; c.dst = (h16*)(p->ws + W_OUT_T) + (size_t)j * D * D; c.K = D; c.N = D; c.kind = 0;
    } else if (r < 2 * I_IN + 2 * I_SQ + 2 * I_QKV) { r -= 2 * I_IN + 2 * I_SQ; const int j = r / I_QKV; item = r % I_QKV; c.src = p->attn_w_qkv + (size_t)j * D * QKVW; c.dst = (h16*)(p->ws + W_QKV_T) + (size_t)j * QKVW * D; c.K = D; c.N = QKVW; c.kind = 1;
    } else { r -= 2 * I_IN + 2 * I_SQ + 2 * I_QKV; const int j = r / I_SQ; item = r % I_SQ; c.src = p->attn_w_o + (size_t)j * D * D; c.dst = (h16*)(p->ws + W_O_T) + (size_t)j * D * D; c.K = D; c.N = D; c.kind = 0; }
    const int nblk = c.N / 32; c.k0 = 64 * (item / nblk); c.n0 = 32 * (item % nblk);
    return c;
}
#define CV_PIPE(COUNT, ITEM_OF) { const int cnt_ = (COUNT); if (cnt_ > 0) { CvItem ca_ = cv_decode(p, ITEM_OF(0)), cb_; f32x4 la_[8], lb_[8]; cv_load(ca_, la_, lane); \
        for (int k_ = 0; k_ < cnt_; k_ += 2) { \
            if (k_ + 1 < cnt_) { cb_ = cv_decode(p, ITEM_OF(k_ + 1)); cv_load(cb_, lb_, lane); } \
            cv_finish(ca_, la_, scr, lane); \
            if (k_ + 1 < cnt_) { if (k_ + 2 < cnt_) { ca_ = cv_decode(p, ITEM_OF(k_ + 2)); cv_load(ca_, la_, lane); } cv_finish(cb_, lb_, scr, lane); } } } }
DI void phase_convw(PC p, unsigned char* lds, int wid_) {
    int tidx = tid_from(wid_), bidx = blockIdx.x; asm volatile("" : "+v"(tidx), "+s"(bidx), "+s"(p));
    const int lane = tidx & 63, wv = tidx >> 6;
    float* scr = (float*)lds + wv * (64 * 33 + 16);
    const int gw = bidx * 8 + wv, ngw = gridDim.x * 8;
    if (gridDim.x != 256) {
#define IT_ALL(k) (gw + (k) * ngw)
        CV_PIPE((CV_PRE + 4 * CV_LAYER - gw + ngw - 1) / ngw, IT_ALL)
#undef IT_ALL
        return; }
    const int n0 = cv_p(0), n1 = cv_p(1), n2 = cv_p(2), n3 = cv_p(3), ntot = CV_PRE + n0 + n1 + n2 + n3;
    auto gmap = [&](int k) { int r = gw + k * ngw, g;
        if (r < CV_PRE + n0) g = r;
        else { r -= CV_PRE + n0; if (r < n1) g = CV_PRE + CV_LAYER + r; else { r -= n1; if (r < n2) g = CV_PRE + 2 * CV_LAYER + r; else g = CV_PRE + 3 * CV_LAYER + (r - n2); } }
        return g; };
    CV_PIPE(gw < ntot ? (ntot - gw + ngw - 1) / ngw : 0, gmap)
}
DI void conv_fill(PC p, unsigned char* lds, int l, int first, int quota, int wid_) {
    int tidx = tid_from(wid_), bidx = blockIdx.x; asm volatile("" : "+v"(tidx), "+s"(bidx), "+s"(p), "+s"(l));
    if (l >= DEPTH || gridDim.x != 256) return;
    const int lane = tidx & 63, wv = tidx >> 6;
    float* scr = (float*)lds + wv * (64 * 33 + 16);
    const int base = first;
    int cnt = 0; { const int lim = (CV_LAYER - base) < quota ? (CV_LAYER - base) : quota; cnt = lim > wv ? (lim - wv + 7) / 8 : 0; }
#define IT_FILL(k) (CV_PRE + l * CV_LAYER + base + wv + 8 * (k))
    CV_PIPE(cnt, IT_FILL)
#undef IT_FILL
}

namespace pg8 {
#define PG8_LAS __attribute__((address_space(3)))
constexpr int BM = 256, BK = 64, HALF = 128, HTB = HALF * BK * 2, STAGE_BYTES = 8 * HTB, NXCD = 8, WGM = 8;
DI int lds_byte(int r, int c) { const int st = (r >> 4) * 2 + (c >> 5), rr = r & 15, cc = c & 31, ob = rr * 64 + cc * 2; return st * 1024 + (ob ^ (((ob >> 9) & 1) << 5)); }
DI void stage_rc(int b, int& R, int& C) { const int st = b / 1024, sb = b % 1024, swz = sb ^ (((sb >> 9) & 1) << 5); R = (st >> 1) * 16 + swz / 64; C = (st & 1) * 32 + (swz % 64) / 2; }
DI int perm32(int rho) { const int n = rho >> 4, i = rho & 15; return 8 * (i >> 2) + 4 * n + (i & 3); }
struct Unit { int pm, pn, row0, e, job; };
struct Job { int nM, nN, pm0, TPE; const char* A; const char* Bt; size_t bstride; };
struct Sched {
    Job j0, j1; int n0, nwg, G, c, K;
    DI void init(const Job& a, const Job& b, int G_, int c_, int K_) { j0 = a; j1 = b; n0 = a.nM * a.nN; nwg = n0 + b.nM * b.nN; G = G_; c = c_; K = K_; }
    DI bool next(int i, Unit& u) const {
        const long L = (long)i * G + c; if (L >= nwg || c >= G) return false;
        const int job = L >= n0 ? 1 : 0; int wgid = job ? (int)L - n0 : (int)L;
        const int nM = job ? j1.nM : j0.nM, nN = job ? j1.nN : j0.nN, pm0 = job ? j1.pm0 : j0.pm0, TPE = job ? j1.TPE : j0.TPE, nw = nM * nN;
        { const int q = nw / NXCD, r = nw % NXCD, xcd = wgid % NXCD, off = wgid / NXCD; wgid = (xcd < r ? xcd * (q + 1) : r * (q + 1) + (xcd - r) * q) + off; }
        const int nig = WGM * nN, gid = wgid / nig, fm = gid * WGM, gsz = (nM - fm) < WGM ? (nM - fm) : WGM;
        u.pm = pm0 + fm + ((wgid % nig) % gsz); u.pn = (wgid % nig) / gsz; u.job = job;
        u.row0 = u.pm * 256; u.e = TPE ? (u.pm < 128 ? (u.pm >> 3) : (u.pm - 128)) : 0;
        return true;
    }
    DI const char* a_base(const Unit& u) const { return (u.job ? j1.A : j0.A) + (size_t)u.row0 * K * 2; }
    DI const char* b_base(const Unit& u) const { return (u.job ? j1.Bt : j0.Bt) + (size_t)u.e * (u.job ? j1.bstride : j0.bstride) + (size_t)u.pn * 256 * K * 2; }
};
DI u32x4 pack8(const f32x4 a, const f32x4 b) {
    const h16x8 o = {(h16)a[0], (h16)a[1], (h16)a[2], (h16)a[3], (h16)b[0], (h16)b[1], (h16)b[2], (h16)b[3]};
    return __builtin_bit_cast(u32x4, o);
}
struct EpiF16 {
    static constexpr bool PERM = true;
    h16* O; int ldc;
    DI void operator()(const f32x4 (&acc)[2][2][4][2], const Unit& u, int wr, int wc, int fr, int fq) const {
        const int row0 = u.row0 + wr * 64 + fr, col0 = u.pn * BM + wc * 32 + 8 * fq;
#pragma unroll
        for (int ai = 0; ai < 2; ++ai)
#pragma unroll
            for (int m = 0; m < 4; ++m) { h16* rowp = O + (size_t)(row0 + ai * HALF + m * 16) * ldc + col0;
#pragma unroll
                for (int bj = 0; bj < 2; ++bj) *(u32x4*)(rowp + bj * HALF) = pack8(acc[ai][bj][m][0], acc[ai][bj][m][1]); }
    }
};
struct EpiLruIn {
    static constexpr bool PERM = true;
    h16* yg; h16* xr;
    DI void operator()(const f32x4 (&acc)[2][2][4][2], const Unit& u, int wr, int wc, int fr, int fq) const {
        const int row0 = u.row0 + wr * 64 + fr; const bool act = u.pn < 4;
        h16* base = act ? yg : xr; const int col0 = (u.pn & 3) * BM + wc * 32 + 8 * fq;
#pragma unroll
        for (int ai = 0; ai < 2; ++ai)
#pragma unroll
            for (int m = 0; m < 4; ++m) { h16* rowp = base + (size_t)(row0 + ai * HALF + m * 16) * D + col0;
#pragma unroll
                for (int bj = 0; bj < 2; ++bj) { f32x4 v0 = acc[ai][bj][m][0], v1 = acc[ai][bj][m][1];
                    if (act) {
#pragma unroll
                        for (int q = 0; q < 4; ++q) { v0[q] = gelu_tanh(v0[q]); v1[q] = gelu_tanh(v1[q]); } }
                    *(u32x4*)(rowp + bj * HALF) = pack8(v0, v1); } }
    }
};
struct EpiResid {
    static constexpr bool PERM = true;
    h16* x; const float* gate;
    DI void operator()(const f32x4 (&acc)[2][2][4][2], const Unit& u, int wr, int wc, int fr, int fq) const {
        const float* gp = gate + (size_t)(u.pm < 64 ? (u.pm >> 3) : 8) * 6144;
        const int col0 = u.pn * BM + wc * 32 + 8 * fq;
        f32x4 gv[2][2];
#pragma unroll
        for (int bj = 0; bj < 2; ++bj)
#pragma unroll
            for (int n = 0; n < 2; ++n) gv[bj][n] = *(const f32x4*)(gp + col0 + bj * HALF + n * 4);
        h16x8 xo[2][4][2];
#pragma unroll
        for (int ai = 0; ai < 2; ++ai)
#pragma unroll
            for (int m = 0; m < 4; ++m)
#pragma unroll
                for (int bj = 0; bj < 2; ++bj) xo[ai][m][bj] = *(const h16x8*)(x + (size_t)(u.row0 + ai * HALF + wr * 64 + m * 16 + fr) * D + col0 + bj * HALF);
#pragma unroll
        for (int ai = 0; ai < 2; ++ai)
#pragma unroll
            for (int m = 0; m < 4; ++m) { h16* xp = x + (size_t)(u.row0 + ai * HALF + wr * 64 + m * 16 + fr) * D + col0;
#pragma unroll
                for (int bj = 0; bj < 2; ++bj) { f32x4 o0, o1;
#pragma unroll
                    for (int q = 0; q < 4; ++q) { o0[q] = (float)xo[ai][m][bj][q] + gv[bj][0][q] * acc[ai][bj][m][0][q]; o1[q] = (float)xo[ai][m][bj][4 + q] + gv[bj][1][q] * acc[ai][bj][m][1][q]; }
                    *(u32x4*)(xp + bj * HALF) = pack8(o0, o1); } }
    }
};
struct EpiQKV {
    static constexpr bool PERM = true;
    h16* qkv; const f32x2* tab;
    DI void operator()(const f32x4 (&acc)[2][2][4][2], const Unit& u, int wr, int wc, int fr, int fq) const {
        const int row0 = u.row0 + wr * 64 + fr, col0 = u.pn * BM + wc * 32 + 8 * fq;
        const bool rope = (u.pn < 5) && (u.pm < 64); const float sc = u.pn < 4 ? QSCALE : 1.0f;
        const int hh = wc >> 1, i0 = 16 * (wc & 1) + 4 * fq;
        f32x4 csa[2][4][2];
#pragma unroll
        for (int ai = 0; ai < 2; ++ai)
#pragma unroll
            for (int m = 0; m < 4; ++m) { const int row = row0 + ai * HALF + m * 16;
                csa[ai][m][0] = (f32x4){1.f, 0.f, 1.f, 0.f}; csa[ai][m][1] = csa[ai][m][0];
                if (rope) { const int t = row & 2047, pos = hh ? (t & 63) : (t >> 6); const f32x4* tp = (const f32x4*)(tab + pos * 32 + i0); csa[ai][m][0] = tp[0]; csa[ai][m][1] = tp[1]; } }
#pragma unroll
        for (int ai = 0; ai < 2; ++ai)
#pragma unroll
            for (int m = 0; m < 4; ++m) { const int row = row0 + ai * HALF + m * 16; h16* rowp = qkv + (size_t)row * QKVW + col0;
                const f32x4 cs0 = csa[ai][m][0], cs1 = csa[ai][m][1];
#pragma unroll
                for (int bj = 0; bj < 2; ++bj) { const f32x4 a = acc[ai][bj][m][0], b = acc[ai][bj][m][1]; f32x4 o0, o1;
                    o0[0] = (a[0] * cs0[0] - a[1] * cs0[1]) * sc; o0[1] = (a[0] * cs0[1] + a[1] * cs0[0]) * sc; o0[2] = (a[2] * cs0[2] - a[3] * cs0[3]) * sc; o0[3] = (a[2] * cs0[3] + a[3] * cs0[2]) * sc;
                    o1[0] = (b[0] * cs1[0] - b[1] * cs1[1]) * sc; o1[1] = (b[0] * cs1[1] + b[1] * cs1[0]) * sc; o1[2] = (b[2] * cs1[2] - b[3] * cs1[3]) * sc; o1[3] = (b[2] * cs1[3] + b[3] * cs1[2]) * sc;
                    *(u32x4*)(rowp + bj * HALF) = pack8(o0, o1); } }
    }
};
struct EpiMoe1 {
    static constexpr bool PERM = true;
    h16* act; const float* gvp;
    DI void operator()(const f32x4 (&acc)[2][2][4][2], const Unit& u, int wr, int wc, int fr, int fq) const {
        const int row0 = u.row0 + wr * 64 + fr, col0 = u.pn * HALF + wc * 32 + 8 * fq;
        float gq[2][4];
#pragma unroll
        for (int ai = 0; ai < 2; ++ai)
#pragma unroll
            for (int m = 0; m < 4; ++m) gq[ai][m] = gvp[row0 + ai * HALF + m * 16];
        f32x4 t0[2][4], t1[2][4];
#pragma unroll
        for (int ai = 0; ai < 2; ++ai)
#pragma unroll
            for (int m = 0; m < 4; ++m)
#pragma unroll
                for (int q = 0; q < 4; ++q) { t0[ai][m][q] = siluf_(acc[ai][0][m][0][q]) * acc[ai][1][m][0][q]; t1[ai][m][q] = siluf_(acc[ai][0][m][1][q]) * acc[ai][1][m][1][q]; }
        __builtin_amdgcn_sched_barrier(0);
#pragma unroll
        for (int ai = 0; ai < 2; ++ai)
#pragma unroll
            for (int m = 0; m < 4; ++m) { const int row = row0 + ai * HALF + m * 16; const float g = gq[ai][m]; f32x4 o0, o1;
#pragma unroll
                for (int q = 0; q < 4; ++q) { o0[q] = t0[ai][m][q] * g; o1[q] = t1[ai][m][q] * g; }
                *(u32x4*)(act + (size_t)row * FF + col0) = pack8(o0, o1); }
    }
};

struct EpiMoeMix {
    static constexpr bool PERM = true;
    EpiMoe1 e1; EpiF16 e2;
    DI void operator()(const f32x4 (&acc)[2][2][4][2], const Unit& u, int wr, int wc, int fr, int fq) const { if (u.job == 0) e1(acc, u, wr, wc, fr, fq); else e2(acc, u, wr, wc, fr, fq); }
};
template <class Epi>
DI void gemm_phase(PG8_LAS unsigned char* lds, const Sched& S, const Epi& E, int wid_) {
    const int tid = tid_from(wid_);
    const int wid = wid_, lane = tid & 63, wr = wid >> 2, wc = wid & 3, fr = lane & 15, fq = lane >> 4;
    const int K = S.K, nt = K / BK;
    unsigned voffA[2], voffB[2];
#pragma unroll
    for (int i = 0; i < 2; ++i) { int R, C; stage_rc(tid * 16 + i * 8192, R, C); const int Rb = Epi::PERM ? ((R & ~31) + perm32(R & 31)) : R;
        voffA[i] = (unsigned)(R * K + C) * 2u; voffB[i] = (unsigned)(Rb * K + C) * 2u; }
    const size_t kstep = (size_t)(BK * 2);
    const size_t hstep = (size_t)HALF * K * 2;
    const unsigned ldsw = (unsigned)wid * 1024u;
    const int aoff = lds_byte(wr * 64 + fr, fq * 8), boff = lds_byte(wc * 32 + fr, fq * 8);
#define PG8_SA(b, h) (((b) * 2 + (h)) * HTB)
#define PG8_SB(b, h) ((4 + (b) * 2 + (h)) * HTB)
#define PG8_STAGE(bufoff, gbase, voff) do { _Pragma("unroll") for (int _i = 0; _i < 2; ++_i) \
        __builtin_amdgcn_global_load_lds((const unsigned*)((const char*)(gbase) + (voff)[_i]), (PG8_LAS unsigned*)(lds + (bufoff) + ldsw + _i * 8192), 16, 0, 0); } while (0)
#define PG8_LDA(dst, b, h) do { _Pragma("unroll") for (int m = 0; m < 4; ++m) _Pragma("unroll") for (int k = 0; k < 2; ++k) dst[m][k] = *(const PG8_LAS h16x8*)(lds + PG8_SA(b, h) + aoff + m * 2048 + k * 1024); } while (0)
#define PG8_LDB(dst, b, h) do { _Pragma("unroll") for (int n = 0; n < 2; ++n) _Pragma("unroll") for (int k = 0; k < 2; ++k) dst[n][k] = *(const PG8_LAS h16x8*)(lds + PG8_SB(b, h) + boff + n * 2048 + k * 1024); } while (0)
#define PG8_MMA(ai, bj, At, Bt) do { __builtin_amdgcn_s_setprio(1); _Pragma("unroll") for (int m = 0; m < 4; ++m) _Pragma("unroll") for (int n = 0; n < 2; ++n) _Pragma("unroll") for (int k = 0; k < 2; ++k) \
        acc[ai][bj][m][n] = __builtin_amdgcn_mfma_f32_16x16x32_f16(Bt[n][k], At[m][k], acc[ai][bj][m][n], 0, 0, 0); __builtin_amdgcn_s_setprio(0); } while (0)
#define PG8_WAIT_V(n) asm volatile("s_waitcnt vmcnt(" #n ")" ::: "memory")
#define PG8_WAIT_L(n) asm volatile("s_waitcnt lgkmcnt(" #n ")" ::: "memory")
#define PG8_BAR __builtin_amdgcn_s_barrier()
#define PG8_SCHED __builtin_amdgcn_sched_barrier(0)
    Unit cur, nxt; int ui = 0;
    if (!S.next(0, cur)) return;
    f32x4 acc[2][2][4][2];
#pragma unroll
    for (int a = 0; a < 2; ++a)
#pragma unroll
        for (int b = 0; b < 2; ++b)
#pragma unroll
            for (int m = 0; m < 4; ++m)
#pragma unroll
                for (int n = 0; n < 2; ++n) acc[a][b][m][n] = (f32x4){0.f, 0.f, 0.f, 0.f};
    h16x8 At[4][2], B0[2][2], B1[2][2];
    const char* cA = S.a_base(cur); const char* cB = S.b_base(cur);
    PG8_STAGE(PG8_SB(0, 0), cB, voffB); PG8_STAGE(PG8_SB(0, 1), cB + hstep, voffB); PG8_STAGE(PG8_SA(0, 0), cA, voffA); PG8_STAGE(PG8_SA(0, 1), cA + hstep, voffA);
    if (wr == 1) PG8_BAR;
    PG8_WAIT_V(2); PG8_BAR;
    PG8_STAGE(PG8_SB(1, 0), cB + kstep, voffB); PG8_STAGE(PG8_SA(1, 0), cA + kstep, voffA); PG8_STAGE(PG8_SB(1, 1), cB + hstep + kstep, voffB);
    PG8_WAIT_V(6); PG8_BAR;
    for (;;) {
        const bool has_next = S.next(ui + 1, nxt);
        const char* nA = has_next ? S.a_base(nxt) : cA; const char* nB = has_next ? S.b_base(nxt) : cB;
        for (int t = 0; t < nt; t += 2) {
            const bool last = (t == nt - 2);
            const char* a1 = cA + (size_t)(t + 1) * kstep;
            const char* a2 = last ? nA : cA + (size_t)(t + 2) * kstep; const char* b2 = last ? nB : cB + (size_t)(t + 2) * kstep;
            const char* a3 = a2 + kstep; const char* b3 = b2 + kstep;
            PG8_LDB(B0, 0, 0); PG8_LDB(B1, 0, 1); PG8_SCHED; PG8_LDA(At, 0, 0); PG8_STAGE(PG8_SA(1, 1), a1 + hstep, voffA);
            PG8_WAIT_V(8); PG8_WAIT_L(0); PG8_BAR; PG8_MMA(0, 0, At, B0); PG8_MMA(0, 1, At, B1); PG8_BAR; PG8_SCHED;
            PG8_LDA(At, 0, 1); PG8_STAGE(PG8_SB(0, 0), b2, voffB); PG8_STAGE(PG8_SB(0, 1), b2 + hstep, voffB); PG8_STAGE(PG8_SA(0, 0), a2, voffA);
            PG8_WAIT_V(8); PG8_WAIT_L(0); PG8_BAR; PG8_MMA(1, 0, At, B0); PG8_MMA(1, 1, At, B1); PG8_BAR; PG8_SCHED;
            PG8_LDB(B0, 1, 0); PG8_LDB(B1, 1, 1); PG8_SCHED; PG8_LDA(At, 1, 0); PG8_STAGE(PG8_SA(0, 1), a2 + hstep, voffA);
            PG8_WAIT_V(8); PG8_WAIT_L(0); PG8_BAR; PG8_MMA(0, 0, At, B0); PG8_MMA(0, 1, At, B1); PG8_BAR; PG8_SCHED;
            PG8_LDA(At, 1, 1); PG8_STAGE(PG8_SB(1, 0), b3, voffB); PG8_STAGE(PG8_SB(1, 1), b3 + hstep, voffB); PG8_STAGE(PG8_SA(1, 0), a3, voffA);
            PG8_WAIT_V(8); PG8_WAIT_L(0); PG8_BAR; PG8_MMA(1, 0, At, B0); PG8_MMA(1, 1, At, B1); PG8_BAR; PG8_SCHED;
        }
        if (wr == 0) PG8_BAR;
        E(acc, cur, wr, wc, fr, fq);
        if (!has_next) break;
#pragma unroll
        for (int a = 0; a < 2; ++a)
#pragma unroll
            for (int b = 0; b < 2; ++b)
#pragma unroll
                for (int m = 0; m < 4; ++m)
#pragma unroll
                    for (int n = 0; n < 2; ++n) acc[a][b][m][n] = (f32x4){0.f, 0.f, 0.f, 0.f};
        cur = nxt; cA = nA; cB = nB; ++ui;
        if (wr == 1) PG8_BAR;
    }
    PG8_WAIT_V(0);
    PG8_BAR;
#undef PG8_SA
#undef PG8_SB
#undef PG8_STAGE
#undef PG8_LDA
#undef PG8_LDB
#undef PG8_MMA
#undef PG8_WAIT_V
#undef PG8_WAIT_L
#undef PG8_BAR
#undef PG8_SCHED
}
template <class Epi>
DI void gemm_phase_g(PG8_LAS unsigned char* lds, const Sched& S, const Epi& E, const int* gidx, int wid_) {
    const int tid = tid_from(wid_);
    const int wid = wid_, lane = tid & 63, wr = wid >> 2, wc = wid & 3, fr = lane & 15, fq = lane >> 4;
    const int K = S.K, nt = K / BK;
    unsigned voffB[2]; int R0, C0;
    stage_rc(tid * 16, R0, C0);
#pragma unroll
    for (int i = 0; i < 2; ++i) { int R, C; stage_rc(tid * 16 + i * 8192, R, C); const int Rb = Epi::PERM ? ((R & ~31) + perm32(R & 31)) : R; voffB[i] = (unsigned)(Rb * K + C) * 2u; }
    const unsigned cshift = (unsigned)C0 * 2u, rowb = (unsigned)K * 2u;
    const size_t kstep = (size_t)(BK * 2);
    const size_t hstep = (size_t)HALF * K * 2;
    const unsigned ldsw = (unsigned)wid * 1024u;
    const int aoff = lds_byte(wr * 64 + fr, fq * 8), boff = lds_byte(wc * 32 + fr, fq * 8);
#define PG8_SA(b, h) (((b) * 2 + (h)) * HTB)
#define PG8_SB(b, h) ((4 + (b) * 2 + (h)) * HTB)
#define PG8_STAGE(bufoff, gbase, voff) do { _Pragma("unroll") for (int _i = 0; _i < 2; ++_i) \
        __builtin_amdgcn_global_load_lds((const unsigned*)((const char*)(gbase) + (voff)[_i]), (PG8_LAS unsigned*)(lds + (bufoff) + ldsw + _i * 8192), 16, 0, 0); } while (0)
#define PG8_LDA(dst, b, h) do { _Pragma("unroll") for (int m = 0; m < 4; ++m) _Pragma("unroll") for (int k = 0; k < 2; ++k) dst[m][k] = *(const PG8_LAS h16x8*)(lds + PG8_SA(b, h) + aoff + m * 2048 + k * 1024); } while (0)
#define PG8_LDB(dst, b, h) do { _Pragma("unroll") for (int n = 0; n < 2; ++n) _Pragma("unroll") for (int k = 0; k < 2; ++k) dst[n][k] = *(const PG8_LAS h16x8*)(lds + PG8_SB(b, h) + boff + n * 2048 + k * 1024); } while (0)
#define PG8_MMA(ai, bj, At, Bt) do { __builtin_amdgcn_s_setprio(1); _Pragma("unroll") for (int m = 0; m < 4; ++m) _Pragma("unroll") for (int n = 0; n < 2; ++n) _Pragma("unroll") for (int k = 0; k < 2; ++k) \
        acc[ai][bj][m][n] = __builtin_amdgcn_mfma_f32_16x16x32_f16(Bt[n][k], At[m][k], acc[ai][bj][m][n], 0, 0, 0); __builtin_amdgcn_s_setprio(0); } while (0)
#define PG8_WAIT_V(n) asm volatile("s_waitcnt vmcnt(" #n ")" ::: "memory")
#define PG8_WAIT_L(n) asm volatile("s_waitcnt lgkmcnt(" #n ")" ::: "memory")
#define PG8_BAR __builtin_amdgcn_s_barrier()
#define PG8_SCHED __builtin_amdgcn_sched_barrier(0)
#define PG8_ROWOFF(u, o) do { _Pragma("unroll") for (int h_ = 0; h_ < 2; ++h_) _Pragma("unroll") for (int i_ = 0; i_ < 2; ++i_) { int row_ = (u).row0 + h_ * HALF + R0 + 64 * i_; \
        if ((u).job == 0 && gidx) row_ = gidx[row_]; (o)[h_][i_] = (unsigned)row_ * rowb + cshift; } } while (0)
    Unit cur, nxt; int ui = 0;
    if (!S.next(0, cur)) return;
    f32x4 acc[2][2][4][2];
#pragma unroll
    for (int a = 0; a < 2; ++a)
#pragma unroll
        for (int b = 0; b < 2; ++b)
#pragma unroll
            for (int m = 0; m < 4; ++m)
#pragma unroll
                for (int n = 0; n < 2; ++n) acc[a][b][m][n] = (f32x4){0.f, 0.f, 0.f, 0.f};
    h16x8 At[4][2], B0[2][2], B1[2][2];
    unsigned offA[2][2];
    PG8_ROWOFF(cur, offA);
    const char* cAj = cur.job ? S.j1.A : S.j0.A; const char* cB = S.b_base(cur);
    PG8_STAGE(PG8_SB(0, 0), cB, voffB); PG8_STAGE(PG8_SB(0, 1), cB + hstep, voffB); PG8_STAGE(PG8_SA(0, 0), cAj, offA[0]); PG8_STAGE(PG8_SA(0, 1), cAj, offA[1]);
    if (wr == 1) PG8_BAR;
    PG8_WAIT_V(2); PG8_BAR;
    PG8_STAGE(PG8_SB(1, 0), cB + kstep, voffB); PG8_STAGE(PG8_SA(1, 0), cAj + kstep, offA[0]); PG8_STAGE(PG8_SB(1, 1), cB + hstep + kstep, voffB);
    PG8_WAIT_V(6); PG8_BAR;
    for (;;) {
        const bool has_next = S.next(ui + 1, nxt);
        const char* nAj = has_next ? (nxt.job ? S.j1.A : S.j0.A) : cAj; const char* nB = has_next ? S.b_base(nxt) : cB;
        if (has_next) { unsigned offN[2][2]; PG8_ROWOFF(nxt, offN); *(PG8_LAS u32x4*)(lds + STAGE_BYTES + tid * 16) = (u32x4){offN[0][0], offN[0][1], offN[1][0], offN[1][1]}; }
        for (int t = 0; t < nt; t += 2) {
            const bool last = (t == nt - 2);
            const char* a1 = cAj + (size_t)(t + 1) * kstep;
            const char* b2 = last ? nB : cB + (size_t)(t + 2) * kstep; const char* b3 = b2 + kstep;
            PG8_LDB(B0, 0, 0); PG8_LDB(B1, 0, 1); PG8_SCHED; PG8_LDA(At, 0, 0); PG8_STAGE(PG8_SA(1, 1), a1, offA[1]);
            if (last) { if (has_next) { const u32x4 o_ = *(const PG8_LAS u32x4*)(lds + STAGE_BYTES + tid * 16); offA[0][0] = o_[0]; offA[0][1] = o_[1]; offA[1][0] = o_[2]; offA[1][1] = o_[3]; }
                cAj = nAj; }
            const char* a2 = last ? cAj : cAj + (size_t)(t + 2) * kstep; const char* a3 = a2 + kstep;
            PG8_WAIT_V(8); PG8_WAIT_L(0); PG8_BAR; PG8_MMA(0, 0, At, B0); PG8_MMA(0, 1, At, B1); PG8_BAR; PG8_SCHED;
            PG8_LDA(At, 0, 1); PG8_STAGE(PG8_SB(0, 0), b2, voffB); PG8_STAGE(PG8_SB(0, 1), b2 + hstep, voffB); PG8_STAGE(PG8_SA(0, 0), a2, offA[0]);
            PG8_WAIT_V(8); PG8_WAIT_L(0); PG8_BAR; PG8_MMA(1, 0, At, B0); PG8_MMA(1, 1, At, B1); PG8_BAR; PG8_SCHED;
            PG8_LDB(B0, 1, 0); PG8_LDB(B1, 1, 1); PG8_SCHED; PG8_LDA(At, 1, 0); PG8_STAGE(PG8_SA(0, 1), a2, offA[1]);
            PG8_WAIT_V(8); PG8_WAIT_L(0); PG8_BAR; PG8_MMA(0, 0, At, B0); PG8_MMA(0, 1, At, B1); PG8_BAR; PG8_SCHED;
            PG8_LDA(At, 1, 1); PG8_STAGE(PG8_SB(1, 0), b3, voffB); PG8_STAGE(PG8_SB(1, 1), b3 + hstep, voffB); PG8_STAGE(PG8_SA(1, 0), a3, offA[0]);
            PG8_WAIT_V(8); PG8_WAIT_L(0); PG8_BAR; PG8_MMA(1, 0, At, B0); PG8_MMA(1, 1, At, B1); PG8_BAR; PG8_SCHED;
        }
        if (wr == 0) PG8_BAR;
        E(acc, cur, wr, wc, fr, fq);
        if (!has_next) break;
#pragma unroll
        for (int a = 0; a < 2; ++a)
#pragma unroll
            for (int b = 0; b < 2; ++b)
#pragma unroll
                for (int m = 0; m < 4; ++m)
#pragma unroll
                    for (int n = 0; n < 2; ++n) acc[a][b][m][n] = (f32x4){0.f, 0.f, 0.f, 0.f};
        cur = nxt; cB = nB; ++ui;
        if (wr == 1) PG8_BAR;
    }
    PG8_WAIT_V(0);
    PG8_BAR;
#undef PG8_SA
#undef PG8_SB
#undef PG8_STAGE
#undef PG8_LDA
#undef PG8_LDB
#undef PG8_MMA
#undef PG8_WAIT_V
#undef PG8_WAIT_L
#undef PG8_BAR
#undef PG8_SCHED
#undef PG8_ROWOFF
}
}

DI void phase_topk_gather(PC p, int l, unsigned char* lds, int wid_) {
    int tidx = tid_from(wid_), bidx = blockIdx.x; asm volatile("" : "+v"(tidx), "+s"(bidx), "+s"(p));
    unsigned* hist = (unsigned*)lds;
    int* wtot = (int*)(lds + 4096);
    const float* aff = (const float*)(p->ws + WS_AFF);
    int* inv = (int*)(p->ws + WS_INV);
    float* gv = (float*)(p->ws + WS_GV);
    int* rowidx = (int*)(p->ws + WS_ROWIDX);
    const int nprob = (l == 3) ? 128 : 256;
    const int tid = tidx, wv = tid >> 6;
    const int lane = (int)__builtin_amdgcn_mbcnt_hi(~0u, __builtin_amdgcn_mbcnt_lo(~0u, 0u));
    for (int pb = bidx; pb < nprob; pb += gridDim.x) {
        const int s = pb >> 7, b = (pb >> 4) & 7, e = pb & 15;
        const int n = s ? CTXL : SEQ, cap = n >> 3;
        const int row0 = s ? ML + b * CTXL : b * SEQ;
        const bool wvalid = wv * 256 < n;
        const int m0 = row0 + wv * 256 + lane;
        unsigned v[4];
#pragma unroll
        for (int i = 0; i < 4; ++i) v[i] = wvalid ? __float_as_uint(aff[(size_t)(m0 + 64 * i) * NE + e]) : 0u;
        hist[tid] = 0u; hist[tid + 512] = 0u;
        __syncthreads();
        unsigned prefix = 0u; int need = cap;
#pragma unroll
        for (int ps = 0; ps < 4; ++ps) {
            const int shift = 24 - 8 * ps;
            unsigned* h = hist + ps * 256;
            if (wvalid) {
#pragma unroll
                for (int i = 0; i < 4; ++i) {
                    bool in = true;
                    if (ps > 0) in = ((v[i] ^ prefix) >> ((shift + 8) & 31)) == 0u;
                    if (in) atomicAdd(&h[(v[i] >> shift) & 255u], 1u);
                }
            }
            __syncthreads();
            const uint4 c = *(const uint4*)(h + lane * 4);
            const unsigned sl = c.x + c.y + c.z + c.w;
            unsigned S = sl;
#pragma unroll
            for (int d = 1; d < 64; d <<= 1) {
                const unsigned t = (unsigned)__builtin_amdgcn_ds_bpermute(((lane + d) & 63) * 4, (int)S);
                S += (lane + d < 64) ? t : 0u;
            }
            int a = (int)(S - sl), dsel = -1, nneed = 0;
            if (a < need && need <= a + (int)c.w) { dsel = 4 * lane + 3; nneed = need - a; } a += (int)c.w;
            if (a < need && need <= a + (int)c.z) { dsel = 4 * lane + 2; nneed = need - a; } a += (int)c.z;
            if (a < need && need <= a + (int)c.y) { dsel = 4 * lane + 1; nneed = need - a; } a += (int)c.y;
            if (a < need && need <= a + (int)c.x) { dsel = 4 * lane + 0; nneed = need - a; }
            const u64 bm = __ballot(dsel >= 0);
            const int srcl = (int)__builtin_ctzll(bm);
            dsel = __builtin_amdgcn_readlane(dsel, srcl); nneed = __builtin_amdgcn_readlane(nneed, srcl);
            prefix |= (unsigned)dsel << shift; need = nneed;
        }
        const unsigned T = prefix;
        u64 bg[4], bq[4];
        int wg = 0, wq = 0;
#pragma unroll
        for (int i = 0; i < 4; ++i) {
            bg[i] = __ballot(wvalid && v[i] > T); bq[i] = __ballot(wvalid && v[i] == T);
            wg += __builtin_popcountll(bg[i]); wq += __builtin_popcountll(bq[i]);
        }
        if (lane == 0) { wtot[wv * 2] = wg; wtot[wv * 2 + 1] = wq; }
        __syncthreads();
        int base_g = 0, base_q = 0, tot_g = 0;
#pragma unroll
        for (int w = 0; w < 8; ++w) {
            const int g_ = wtot[2 * w], q_ = wtot[2 * w + 1];
            tot_g += g_;
            if (w < wv) { base_g += g_; base_q += q_; }
        }
        const int pbase = s ? NE * NB * CAPL + e * NB * CAPC + b * CAPC : e * NB * CAPL + b * CAPL;
        if (wvalid) {
#pragma unroll
            for (int i = 0; i < 4; ++i) {
                const int m = m0 + 64 * i;
                int slot = -1;
                if (v[i] > T) slot = base_g + (int)__builtin_amdgcn_mbcnt_hi((unsigned)(bg[i] >> 32), __builtin_amdgcn_mbcnt_lo((unsigned)bg[i], 0u));
                else if (v[i] == T) {
                    const int r = base_q + (int)__builtin_amdgcn_mbcnt_hi((unsigned)(bq[i] >> 32), __builtin_amdgcn_mbcnt_lo((unsigned)bq[i], 0u));
                    if (r < need) slot = tot_g + r;
                }
                base_g += __builtin_popcountll(bg[i]); base_q += __builtin_popcountll(bq[i]);
                if (slot >= 0) { gv[pbase + slot] = __uint_as_float(v[i]); rowidx[pbase + slot] = m; inv[m * NE + e] = pbase + slot; }
                else inv[m * NE + e] = -1;
            }
        }
        __syncthreads();
    }
}
DI float fsig(float x) { return __builtin_amdgcn_rcpf(1.0f + __builtin_amdgcn_exp2f(-LOG2E * x)); }
DI void lru_ab_fast(float tr, float ti, float c8l, float xb, float& a, float& bb, float& la2) {
    const float r = __builtin_amdgcn_rcpf(1.0f + __builtin_amdgcn_exp2f(tr)), ig = __builtin_amdgcn_rcpf(1.0f + __builtin_amdgcn_exp2f(ti));
    la2 = c8l * r;
    a = __builtin_amdgcn_exp2f(la2);
    const float om = fmaxf(__builtin_fmaf(-a, a, 1.0f), 0.0f);
    bb = __builtin_amdgcn_sqrtf(om) * (ig * xb);
}
template <int MODE> DI void phase_lru1(PC p, int j, unsigned char* lds, int wid_) {
    int tidx = tid_from(wid_), bidx = blockIdx.x; asm volatile("" : "+v"(tidx), "+s"(bidx), "+s"(p));
    constexpr int XBS = 136;
    h16* XB = (h16*)lds;
    const int tid = tidx, lane = tid & 63, wv = tid >> 6, d = wv >> 2, w4 = wv & 3;
    unsigned* stg = (unsigned*)(lds + 17408) + wv * 512;
    const int blk = bidx & 7, nslot = gridDim.x >> 3;
    if (bidx >= nslot * 8) return;
    const h16* xr = (const h16*)(p->ws + WS_UB) + (size_t)MT * D;
    f32x2* agg = (f32x2*)(p->ws + WS_AGG);
    unsigned* ab16 = (unsigned*)(p->ws + WS_CSCR) + (size_t)d * MT * D + blk * 128 + 32 * w4 + (lane & 3) * 8;
    const h16* GT = (const h16*)(p->ws + W_GATE16) + (size_t)((j * 2 + d) * 8 + blk) * 256 * 128;
    h16x8 Bf[2][2][4];
#pragma unroll
    for (int ct = 0; ct < 2; ++ct)
#pragma unroll
        for (int g = 0; g < 2; ++g)
#pragma unroll
            for (int ks = 0; ks < 4; ++ks) Bf[ct][g][ks] = *(const h16x8*)(GT + (size_t)(g * 128 + 32 * w4 + 16 * ct + (lane & 15)) * 128 + ks * 32 + 8 * (lane >> 4));
    float gbr[2], gbi[2], c8[2];
#pragma unroll
    for (int ct = 0; ct < 2; ++ct) { const int chl = 32 * w4 + 16 * ct + (lane & 15);
        gbr[ct] = -LOG2E * p->lru_gate_b[((j * 2 + d) * 8 + blk) * 256 + chl]; gbi[ct] = -LOG2E * p->lru_gate_b[((j * 2 + d) * 8 + blk) * 256 + 128 + chl];
        c8[ct] = LOG2E * logsig8(p->lru_lambda[(j * 2 + d) * D + blk * 128 + chl]); }
    const float* cw = p->lru_conv_w + (size_t)j * 4 * D + blk * 128; const float* cb = p->lru_conv_b + (size_t)j * D + blk * 128;
    const bool rev = d != 0;
    const bool first16 = rev ? ((lane >> 4) & 1) != 0 : ((lane >> 4) & 1) == 0;
    const bool first32 = rev ? (lane >> 5) != 0 : (lane >> 5) == 0;
    const int c0 = (tid & 15) * 8, tl0 = tid >> 4;
    h16x8 pre[2][4];
#define LRU_ROWS(q_, row0_, t0_, ns_) const int b_##q_ = (q_) / 36, c_##q_ = (q_) % 36; \
        const int row0_ = c_##q_ < 4 ? ML + b_##q_ * CTXL + c_##q_ * 64 : b_##q_ * SEQ + (c_##q_ - 4) * 64, t0_ = c_##q_ < 4 ? c_##q_ * 64 : (c_##q_ - 4) * 64, ns_ = c_##q_ < 4 ? CTXL : SEQ;
#define LRU_CONV_LOAD(row0_, t0_, ns_) { _Pragma("unroll") for (int rep = 0; rep < 2; ++rep) _Pragma("unroll") for (int k = 0; k < 4; ++k) { \
            const int tl = tl0 + 32 * rep, tt = (t0_) + tl + k - 1; \
            pre[rep][k] = (tt >= 0 && tt < (ns_)) ? *(const h16x8*)(xr + (size_t)((row0_) + tl + k - 1) * D + blk * 128 + c0) : (h16x8){0, 0, 0, 0, 0, 0, 0, 0}; } }
#define LRU_CONV_STORE() { _Pragma("unroll") for (int rep = 0; rep < 2; ++rep) { float acc[8]; \
            { const f32x4 b0 = *(const f32x4*)(cb + c0), b1 = *(const f32x4*)(cb + c0 + 4); acc[0] = b0[0]; acc[1] = b0[1]; acc[2] = b0[2]; acc[3] = b0[3]; acc[4] = b1[0]; acc[5] = b1[1]; acc[6] = b1[2]; acc[7] = b1[3]; } \
            _Pragma("unroll") for (int k = 0; k < 4; ++k) { const f32x4 w0 = *(const f32x4*)(cw + k * D + c0), w1 = *(const f32x4*)(cw + k * D + c0 + 4); \
                _Pragma("unroll") for (int e = 0; e < 4; ++e) { acc[e] += w0[e] * (float)pre[rep][k][e]; acc[4 + e] += w1[e] * (float)pre[rep][k][4 + e]; } } \
            h16x8 o; _Pragma("unroll") for (int e = 0; e < 8; ++e) o[e] = (h16)acc[e]; \
            *(h16x8*)(XB + (tl0 + 32 * rep) * XBS + c0) = o; } }
    int q = bidx >> 3;
    if (q < NB * 36) { LRU_ROWS(q, r0a, t0a, nsa) LRU_CONV_LOAD(r0a, t0a, nsa) LRU_CONV_STORE() }
    for (; q < NB * 36; q += nslot) {
        const int b = q / 36, c = q % 36;
        const int row0 = c < 4 ? ML + b * CTXL + c * 64 : b * SEQ + (c - 4) * 64;
        __syncthreads();
        const int qn = q + nslot; const bool hasn = qn < NB * 36;
        if (hasn) { LRU_ROWS(qn, r0n, t0n, nsn) LRU_CONV_LOAD(r0n, t0n, nsn) }
        float Ac[2] = {1.f, 1.f}, Hc[2] = {0.f, 0.f};
#pragma unroll 1
        for (int k = 0; k < 4; ++k) {
            const int sc = rev ? 3 - k : k;
            f32x4 acc[2][2];
#pragma unroll
            for (int ct = 0; ct < 2; ++ct)
#pragma unroll
                for (int g = 0; g < 2; ++g) acc[ct][g] = (f32x4){0.f, 0.f, 0.f, 0.f};
#pragma unroll
            for (int ks = 0; ks < 4; ++ks) {
                const h16x8 af = *(const h16x8*)(XB + (sc * 16 + (lane & 15)) * XBS + ks * 32 + 8 * (lane >> 4));
#pragma unroll
                for (int ct = 0; ct < 2; ++ct)
#pragma unroll
                    for (int g = 0; g < 2; ++g) acc[ct][g] = __builtin_amdgcn_mfma_f32_16x16x32_f16(af, Bf[ct][g][ks], acc[ct][g], 0, 0, 0);
            }
#pragma unroll
            for (int ct = 0; ct < 2; ++ct) { const int chl = 32 * w4 + 16 * ct + (lane & 15);
                float av[4], bv[4];
#pragma unroll
                for (int r = 0; r < 4; ++r) { const int tk = 4 * (lane >> 4) + r;
                    float la2;
                    lru_ab_fast(__builtin_fmaf(acc[ct][0][r], -LOG2E, gbr[ct]), __builtin_fmaf(acc[ct][1][r], -LOG2E, gbi[ct]), c8[ct], (float)XB[(sc * 16 + tk) * XBS + chl], av[r], bv[r], la2);
                    const h16x2 pk = {(h16)(la2 * 1024.0f), (h16)bv[r]};
                    stg[tk * 32 + 16 * ct + (lane & 15)] = __builtin_bit_cast(unsigned, pk); }
                float A, H;
                if (!rev) { A = av[0]; H = bv[0];
#pragma unroll
                    for (int r = 1; r < 4; ++r) { H = av[r] * H + bv[r]; A *= av[r]; } }
                else { A = av[3]; H = bv[3];
#pragma unroll
                    for (int r = 2; r >= 0; --r) { H = av[r] * H + bv[r]; A *= av[r]; } }
                { const float Ao = shx(A, 16, lane), Ho = shx(H, 16, lane); const float Hn = first16 ? Ao * H + Ho : A * Ho + H; A *= Ao; H = Hn; }
                { const float Ao = shx(A, 32, lane), Ho = shx(H, 32, lane); const float Hn = first32 ? Ao * H + Ho : A * Ho + H; A *= Ao; H = Hn; }
                Hc[ct] = A * Hc[ct] + H; Ac[ct] *= A;
            }
            asm volatile("s_waitcnt lgkmcnt(0)" ::: "memory"); __builtin_amdgcn_wave_barrier();
            { const int tk = lane >> 2; const u32x4 s0 = *(const u32x4*)(stg + tk * 32 + (lane & 3) * 8), s1 = *(const u32x4*)(stg + tk * 32 + (lane & 3) * 8 + 4);
              unsigned* dst = ab16 + (size_t)(row0 + sc * 16 + tk) * D; *(u32x4*)dst = s0; *(u32x4*)(dst + 4) = s1; }
            asm volatile("s_waitcnt lgkmcnt(0)" ::: "memory"); __builtin_amdgcn_wave_barrier();
        }
        if ((lane >> 4) == 0) {
#pragma unroll
            for (int ct = 0; ct < 2; ++ct) agg[(size_t)((b * 2 + d) * 36 + c) * D + blk * 128 + 32 * w4 + 16 * ct + (lane & 15)] = (f32x2){Ac[ct], Hc[ct]};
        }
        __syncthreads();
        if (hasn) LRU_CONV_STORE()
    }
#undef LRU_ROWS
#undef LRU_CONV_LOAD
#undef LRU_CONV_STORE
}

DI void phase_lru2(PC p, unsigned char* lds, int wid_) {
    int tidx = tid_from(wid_), bidx = blockIdx.x; asm volatile("" : "+v"(tidx), "+s"(bidx), "+s"(p));
    const int tid = tidx, half = tid >> 8, t8 = tid & 255, sd = t8 >> 7, sch = t8 & 127;
    float* SH = (float*)lds + (size_t)half * (2 * 64 * 128);
    const int blk = bidx & 7, nslot = gridDim.x >> 3;
    if (bidx >= nslot * 8) return;
    const unsigned* ab = (const unsigned*)(p->ws + WS_CSCR);
    const float* carry = (const float*)(p->ws + WS_AGG + 4608 * 1024);
    const h16* yg = (const h16*)(p->ws + WS_UB);
    h16* sy = (h16*)(p->ws + WS_SYB);
    for (int q0 = bidx >> 3; q0 < NB * 36; q0 += 2 * nslot) {
        const int q = q0 + half * nslot; const bool live = q < NB * 36;
        const int qq = live ? q : q0, b = qq / 36, c = qq % 36;
        const int row0 = c < 4 ? ML + b * CTXL + c * 64 : b * SEQ + (c - 4) * 64;
        const unsigned* src = ab + (size_t)sd * MT * D + (size_t)row0 * D + blk * 128 + sch;
        unsigned pk[64];
#pragma unroll
        for (int t = 0; t < 64; ++t) pk[t] = src[(size_t)(sd == 0 ? t : 63 - t) * D];
        h16x8 ygv[4];
#pragma unroll
        for (int rep = 0; rep < 4; ++rep) { const int idx = t8 + rep * 256; ygv[rep] = *(const h16x8*)(yg + (size_t)(row0 + (idx >> 4)) * D + blk * 128 + (idx & 15) * 8); }
        float h = carry[(size_t)((b * 2 + sd) * 36 + c) * D + blk * 128 + sch];
        float* sw = SH + (size_t)sd * 64 * 128 + sch;
#pragma unroll
        for (int t = 0; t < 64; ++t) { const h16x2 v = __builtin_bit_cast(h16x2, pk[t]); const float a = __builtin_amdgcn_exp2f((float)v[0] * (1.0f / 1024.0f));
            h = a * h + (float)v[1]; sw[(sd == 0 ? t : 63 - t) * 128] = h; }
        __syncthreads();
        if (live) {
#pragma unroll
            for (int rep = 0; rep < 4; ++rep) {
                const int idx = t8 + rep * 256, tl = idx >> 4, c0 = (idx & 15) * 8;
                const h16x8 yv = ygv[rep];
                const float* s0p = SH + tl * 128 + c0; const float* s1p = s0p + 64 * 128;
                const f32x4 f0 = *(const f32x4*)s0p, f1 = *(const f32x4*)(s0p + 4), r0 = *(const f32x4*)s1p, r1 = *(const f32x4*)(s1p + 4);
                h16x8 o;
#pragma unroll
                for (int e = 0; e < 4; ++e) { o[e] = (h16)((f0[e] + r0[e]) * (float)yv[e]); o[4 + e] = (h16)((f1[e] + r1[e]) * (float)yv[4 + e]); }
                *(h16x8*)(sy + (size_t)(row0 + tl) * D + blk * 128 + c0) = o;
            }
        }
        __syncthreads();
    }
}

DI void phase_lru_carry(PC p, int wid_) {
    int tidx = tid_from(wid_), bidx = blockIdx.x; asm volatile("" : "+v"(tidx), "+s"(bidx), "+s"(p));
    const int gt = bidx * NT + tidx;
    if (gt >= NB * 2 * D) return;
    const int b = gt >> 11, d = (gt >> 10) & 1, ch = gt & 1023;
    const f32x2* ag = (const f32x2*)(p->ws + WS_AGG) + (size_t)((b * 2 + d) * 36) * D + ch;
    float* cr = (float*)(p->ws + WS_AGG + 4608 * 1024) + (size_t)((b * 2 + d) * 36) * D + ch;
    f32x2 v[36];
#pragma unroll
    for (int s2 = 0; s2 < 36; ++s2) { const int cc = d == 0 ? s2 : (s2 < 4 ? 3 - s2 : 39 - s2); v[s2] = ag[(size_t)cc * D]; }
    float h = 0.f;
#pragma unroll
    for (int s2 = 0; s2 < 36; ++s2) { const int cc = d == 0 ? s2 : (s2 < 4 ? 3 - s2 : 39 - s2); cr[(size_t)cc * D] = h; h = v[s2][0] * h + v[s2][1]; }
}

typedef float f32x16 __attribute__((ext_vector_type(16)));
typedef short s16x4 __attribute__((ext_vector_type(4)));
DI h16x4 vtr4(const __attribute__((address_space(3))) unsigned char* ptr) {
    return __builtin_bit_cast(h16x4, __builtin_amdgcn_ds_read_tr16_b64_v4i16((__attribute__((address_space(3))) s16x4*)ptr));
}
DI void phase_attn(PC p, int l, unsigned char* lds, int wid_) {
    int tidx = tid_from(wid_), bidx = blockIdx.x; asm volatile("" : "+v"(tidx), "+s"(bidx), "+s"(p));
    constexpr int KS = 272, VS = 320, KBUF = 64 * KS, VBUF = 64 * VS;
    typedef __attribute__((address_space(3))) unsigned char lds_t;
    lds_t* Kl = (lds_t*)lds; lds_t* Vl = Kl + 2 * KBUF;
    const int tid = tidx, lane = tid & 63, wv = tid >> 6, g = wv >> 1, th = wv & 1, r32 = lane & 31, hi = lane >> 5;
    const h16* qkv = (const h16*)(p->ws + WS_UB);
    h16* o = (h16*)(p->ws + WS_SYB);
    const int j = l >> 1;
    const int nitems = 512 + (l == 3 ? 0 : 64);
    const int srow = tid >> 3, sc = tid & 7;
    const int vtoff = (4 * hi + ((lane & 15) >> 2)) * VS + (16 * ((lane >> 4) & 1) + 4 * (lane & 3)) * 2;
    for (int it = bidx; it < nitems; it += gridDim.x) {
        int b, kvh, q0 = 0, qrow0, jlo = 0, nband = 0;
        if (it < 512) { b = it >> 6; kvh = (it >> 5) & 1; q0 = (it & 31) * 64; qrow0 = b * SEQ + q0;
            jlo = q0 == 0 ? 2 : (q0 == 64 ? 1 : 0); const int jhi = q0 == SEQ - 64 ? 2 : (q0 == SEQ - 128 ? 3 : 4); nband = jhi - jlo + 1; }
        else { const int r = it - 512; b = r >> 3; kvh = (r >> 2) & 1; qrow0 = ML + b * CTXL + (r & 3) * 64; }
        const int nt = nband + 4, hq = kvh * 4 + g, qi = 32 * th + r32;
        const int bandrow0 = b * SEQ + q0 - 128 + 64 * jlo, ctxrow0 = ML + b * CTXL;
        h16x8 qf[8];
        { const h16* qp = qkv + (size_t)(qrow0 + qi) * QKVW + hq * HD + 8 * hi;
#pragma unroll
          for (int ks = 0; ks < 8; ++ks) qf[ks] = *(const h16x8*)(qp + 16 * ks); }
        float m = p->attn_sink[j * NH + hq] * LOG2E, lsum = hi == 0 ? 1.0f : 0.0f;
        f32x16 O[4];
#pragma unroll
        for (int dt = 0; dt < 4; ++dt)
#pragma unroll
            for (int r = 0; r < 16; ++r) O[dt][r] = 0.f;
        u32x4 st[4];
        { const int krow = (nband > 0 ? bandrow0 : ctxrow0) + srow; const h16* kp = qkv + (size_t)krow * QKVW + 1024 + kvh * HD + sc * 8;
          st[0] = *(const u32x4*)kp; st[1] = *(const u32x4*)(kp + 64); st[2] = *(const u32x4*)(kp + 256); st[3] = *(const u32x4*)(kp + 256 + 64); }
        *(__attribute__((address_space(3))) u32x4*)(Kl + srow * KS + sc * 16) = st[0]; *(__attribute__((address_space(3))) u32x4*)(Kl + srow * KS + sc * 16 + 128) = st[1];
        *(__attribute__((address_space(3))) u32x4*)(Vl + srow * VS + sc * 16) = st[2]; *(__attribute__((address_space(3))) u32x4*)(Vl + srow * VS + sc * 16 + 128) = st[3];
        __syncthreads();
        asm volatile("" : "+v"(qf[0]), "+v"(qf[1]), "+v"(qf[2]), "+v"(qf[3]), "+v"(qf[4]), "+v"(qf[5]), "+v"(qf[6]), "+v"(qf[7]));
#pragma unroll 1
        for (int i = 0; i < nt; ++i) {
            const int buf = i & 1;
            if (i + 1 < nt) { const int krow = (i + 1 < nband ? bandrow0 + 64 * (i + 1) : ctxrow0 + 64 * (i + 1 - nband)) + srow; const h16* kp = qkv + (size_t)krow * QKVW + 1024 + kvh * HD + sc * 8;
                st[0] = *(const u32x4*)kp; st[1] = *(const u32x4*)(kp + 64); st[2] = *(const u32x4*)(kp + 256); st[3] = *(const u32x4*)(kp + 256 + 64); }
            const lds_t* Kb = Kl + buf * KBUF; const lds_t* Vb = Vl + buf * VBUF;
            f32x16 s0, s1;
#pragma unroll
            for (int r = 0; r < 16; ++r) { s0[r] = 0.f; s1[r] = 0.f; }
            {
#define AT_KLOAD(dst, kq) { _Pragma("unroll") for (int u_ = 0; u_ < 2; ++u_) { \
                    dst[2 * u_] = *(const __attribute__((address_space(3))) h16x8*)(Kb + r32 * KS + (16 * (2 * (kq) + u_) + 8 * hi) * 2); \
                    dst[2 * u_ + 1] = *(const __attribute__((address_space(3))) h16x8*)(Kb + (32 + r32) * KS + (16 * (2 * (kq) + u_) + 8 * hi) * 2); } }
#define AT_KMMA(src, kq) { _Pragma("unroll") for (int u_ = 0; u_ < 2; ++u_) { \
                    s0 = __builtin_amdgcn_mfma_f32_32x32x16_f16(src[2 * u_], qf[2 * (kq) + u_], s0, 0, 0, 0); \
                    s1 = __builtin_amdgcn_mfma_f32_32x32x16_f16(src[2 * u_ + 1], qf[2 * (kq) + u_], s1, 0, 0, 0); } }
                h16x8 ka[4], kb[4];
                AT_KLOAD(ka, 0) AT_KLOAD(kb, 1)
                __builtin_amdgcn_sched_barrier(0);
                AT_KMMA(ka, 0) AT_KLOAD(ka, 2)
                __builtin_amdgcn_sched_barrier(0);
                AT_KMMA(kb, 1) AT_KLOAD(kb, 3)
                __builtin_amdgcn_sched_barrier(0);
                AT_KMMA(ka, 2) AT_KMMA(kb, 3)
#undef AT_KLOAD
#undef AT_KMMA
            }
            if (i < nband) { const int jt = jlo + i;
                if (jt == 0) {
#pragma unroll
                    for (int r = 0; r < 16; ++r) { const int kv = (r & 3) + 8 * (r >> 2) + 4 * hi; if (kv < qi) s0[r] = -1e30f; if (kv + 32 < qi) s1[r] = -1e30f; } }
                else if (jt == 4) {
#pragma unroll
                    for (int r = 0; r < 16; ++r) { const int kv = (r & 3) + 8 * (r >> 2) + 4 * hi; if (kv > qi) s0[r] = -1e30f; if (kv + 32 > qi) s1[r] = -1e30f; } }
            }
            float mx = fmaxf(s0[0], s1[0]);
#pragma unroll
            for (int r = 1; r < 16; ++r) mx = fmaxf(mx, fmaxf(s0[r], s1[r]));
            mx = fmaxf(mx, shx(mx, 32, lane));
            const float mnew = fmaxf(m, mx), alpha = __builtin_amdgcn_exp2f(m - mnew);
            m = mnew;
            float rs = 0.f;
#pragma unroll
            for (int r = 0; r < 16; ++r) { s0[r] = __builtin_amdgcn_exp2f(s0[r] - mnew); s1[r] = __builtin_amdgcn_exp2f(s1[r] - mnew); rs += s0[r] + s1[r]; }
            lsum = lsum * alpha + rs;
            if (!__all(alpha == 1.0f)) {
#pragma unroll
                for (int dt = 0; dt < 4; ++dt)
#pragma unroll
                    for (int r = 0; r < 16; ++r) O[dt][r] *= alpha;
            }
            h16x8 pf[2][2];
#pragma unroll
            for (int s2 = 0; s2 < 2; ++s2)
#pragma unroll
                for (int e = 0; e < 8; ++e) { pf[0][s2][e] = (h16)s0[8 * s2 + e]; pf[1][s2][e] = (h16)s1[8 * s2 + e]; }
            {
#define AT_VLOAD(dst, q4) { _Pragma("unroll") for (int dt = 0; dt < 4; ++dt) { const lds_t* vp = Vb + vtoff + (16 * (q4)) * VS + 64 * dt; dst[dt][0] = vtr4(vp); dst[dt][1] = vtr4(vp + 8 * VS); } }
#define AT_VMMA(src, q4) { _Pragma("unroll") for (int dt = 0; dt < 4; ++dt) { const h16x4 v0 = src[dt][0], v1 = src[dt][1]; \
                    const h16x8 va = {v0[0], v0[1], v0[2], v0[3], v1[0], v1[1], v1[2], v1[3]}; \
                    O[dt] = __builtin_amdgcn_mfma_f32_32x32x16_f16(va, pf[(q4) >> 1][(q4) & 1], O[dt], 0, 0, 0); } }
                h16x4 vf[4][2], vg[4][2];
                AT_VLOAD(vf, 0) AT_VLOAD(vg, 1)
                __builtin_amdgcn_sched_barrier(0);
                AT_VMMA(vf, 0) AT_VLOAD(vf, 2)
                __builtin_amdgcn_sched_barrier(0);
                AT_VMMA(vg, 1) AT_VLOAD(vg, 3)
                __builtin_amdgcn_sched_barrier(0);
                AT_VMMA(vf, 2) AT_VMMA(vg, 3)
#undef AT_VLOAD
#undef AT_VMMA
            }
            if (i + 1 < nt) { const int nb = buf ^ 1;
                *(__attribute__((address_space(3))) u32x4*)(Kl + nb * KBUF + srow * KS + sc * 16) = st[0]; *(__attribute__((address_space(3))) u32x4*)(Kl + nb * KBUF + srow * KS + sc * 16 + 128) = st[1];
                *(__attribute__((address_space(3))) u32x4*)(Vl + nb * VBUF + srow * VS + sc * 16) = st[2]; *(__attribute__((address_space(3))) u32x4*)(Vl + nb * VBUF + srow * VS + sc * 16 + 128) = st[3]; }
            __syncthreads();
        }
        const float ltot = lsum + shx(lsum, 32, lane), inv = 1.0f / ltot;
        h16* op = o + (size_t)(qrow0 + qi) * D + hq * HD + 4 * hi;
#pragma unroll
        for (int dt = 0; dt < 4; ++dt)
#pragma unroll
            for (int rq = 0; rq < 4; ++rq) {
                const h16x4 ov = {(h16)(O[dt][4 * rq] * inv), (h16)(O[dt][4 * rq + 1] * inv), (h16)(O[dt][4 * rq + 2] * inv), (h16)(O[dt][4 * rq + 3] * inv)};
                *(h16x4*)(op + 32 * dt + 8 * rq) = ov;
            }
    }
}

#define LAS __attribute__((address_space(3)))
#define XB_TMO      128
#define XB_XCNT(j)  (256  + 64 * (j))
#define XB_XSUB(j)  (1280 + 64 * (j))
#define XB_XGEN(j)  (2304 + 64 * (j))
#define XB_TOP      3328
#define XB_TOPGEN   3392
#define XCD_BAR_WORDS 3456
#define XB_SPIN_CAP (1u << 22)
DI unsigned xb_ld(unsigned* p)              { return __hip_atomic_load(p, __ATOMIC_RELAXED, __HIP_MEMORY_SCOPE_AGENT); }
DI unsigned xb_add(unsigned* p, unsigned v) { return __hip_atomic_fetch_add(p, v, __ATOMIC_RELAXED, __HIP_MEMORY_SCOPE_AGENT); }
DI unsigned xb_xcc_id() { return (unsigned)__builtin_amdgcn_s_getreg((3 << 11) | 20) & 0xFu; }
#define XB_SPIN(cond, bar) do { unsigned _sp = 0; while (cond) { __builtin_amdgcn_s_sleep(1); \
    if ((++_sp & 255u) == 0u) { if (xb_ld(&(bar)[XB_TMO])) break; if (_sp > XB_SPIN_CAP) { atomicAdd(&(bar)[XB_TMO], 1u); break; } } } } while (0)
struct XcdBarrier { unsigned* bar; unsigned x; volatile LAS unsigned* st; };
DI XcdBarrier xcd_barrier_post(unsigned* bar, volatile LAS unsigned* st) {
    XcdBarrier b; b.bar = bar; b.x = xb_xcc_id(); b.st = st;
    if (threadIdx.x == 0) (void)xb_add(&bar[XB_XCNT(b.x)], 1u);
    return b;
}
DI void xcd_barrier_complete(unsigned* bar, unsigned x, unsigned& nloc, unsigned& nx) {
    const unsigned G = gridDim.x * gridDim.y * gridDim.z;
    unsigned sum, cnt, mine, sp = 0u;
    for (;;) {
        sum = 0u; cnt = 0u; mine = 0u;
#pragma unroll
        for (unsigned j = 0; j < 16; ++j) { const unsigned c = xb_ld(&bar[XB_XCNT(j)]); sum += c; cnt += (c > 0u) ? 1u : 0u; mine = (j == x) ? c : mine; }
        if (sum == G) break;
        __builtin_amdgcn_s_sleep(1);
        if ((++sp & 255u) == 0u) { if (xb_ld(&bar[XB_TMO])) break; if (sp > XB_SPIN_CAP) { atomicAdd(&bar[XB_TMO], 1u); break; } }
    }
    nloc = mine > 0u ? mine : 1u; nx = cnt > 0u ? cnt : 1u;
}
DI void xcd_barrier(const XcdBarrier& b, int wid_) {
    asm volatile("s_waitcnt vmcnt(0)" ::: "memory");
    __syncthreads();
    if (tid_from(wid_) == 0) {
        unsigned* bar = b.bar;
        __builtin_amdgcn_s_waitcnt(0);
        unsigned nloc = b.st[0], nx = b.st[1];
        if (nloc == 0u) { xcd_barrier_complete(bar, b.x, nloc, nx); b.st[0] = nloc; b.st[1] = nx; }
        const unsigned old = xb_add(&bar[XB_XSUB(b.x)], 1u);
        const unsigned gen = old / nloc;
        if (old + 1u == (gen + 1u) * nloc) {
            __builtin_amdgcn_fence(__ATOMIC_RELEASE, "agent");
            asm volatile("s_waitcnt vmcnt(0)" ::: "memory");
            const unsigned og = xb_add(&bar[XB_TOP], 1u);
            const unsigned tg = og / nx;
            if (og + 1u == (tg + 1u) * nx) xb_add(&bar[XB_TOPGEN], 1u);
            else XB_SPIN(xb_ld(&bar[XB_TOPGEN]) == tg, bar);
            __builtin_amdgcn_fence(__ATOMIC_ACQUIRE, "agent");
            xb_add(&bar[XB_XGEN(b.x)], 1u);
            asm volatile("s_waitcnt vmcnt(0)" ::: "memory");
        } else {
            XB_SPIN(xb_ld(&bar[XB_XGEN(b.x)]) == gen, bar);
            __builtin_amdgcn_fence(__ATOMIC_ACQUIRE, "agent");
            asm volatile("s_waitcnt vmcnt(0)" ::: "memory");
        }
    }
    __syncthreads();
}
constexpr int CW_BAR = 4096;
constexpr int MISC_OFF = 147456 - 256;

#ifndef DUP_MASK
#define DUP_MASK 0
#endif
#define BAR(kind) xcd_barrier(bar, wid_)
#define REP(kind) for (int rep_ = 0; rep_ < (((DUP_MASK) >> (kind)) & 1) + 1; ++rep_)
template <int l> DI void run_layers(PC p, unsigned char* lds, const XcdBarrier& bar, int wid_) {
    const h16* hb = (const h16*)(p->ws + WS_HB);
    LAS unsigned char* l3 = (LAS unsigned char*)lds;
    const int G = gridDim.x, bid = blockIdx.x;
    const float* modp = (const float*)(p->ws + WS_MOD);
    {
        const int j = l >> 1;
        const pg8::Job nojob{0, 1, 0, 0, nullptr, nullptr, 0};
        if ((l & 1) == 0) {
            REP(2) { pg8::Sched S; S.init(pg8::Job{MT / 256, 8, 0, 0, (const char*)hb, (const char*)(p->ws + W_IN_T + (size_t)j * 2048 * D * 2), 0}, nojob, G, bid, D);
              pg8::EpiLruIn E{(h16*)(p->ws + WS_UB), (h16*)(p->ws + WS_UB) + (size_t)MT * D}; pg8::gemm_phase(l3, S, E, wid_);
              if (!rep_ && bid >= 64) conv_fill(p, lds, l, cv_p(l) + cv_prev(l) + (bid - 64) * FQ_A, FQ_A, wid_); BAR(2); }
#ifdef LRU_ABL
            phase_lru1<LRU_ABL>(p, j, lds, wid_); BAR(3);
#endif
            REP(3) { phase_lru1<0>(p, j, lds, wid_); BAR(3); phase_lru_carry(p, wid_); BAR(3); }
            REP(4) { phase_lru2(p, lds, wid_); BAR(4); }
        } else {
            REP(6) { pg8::Sched S; S.init(pg8::Job{MT / 256, 6, 0, 0, (const char*)hb, (const char*)(p->ws + W_QKV_T + (size_t)j * QKVW * D * 2), 0}, nojob, G, bid, D);
              pg8::EpiQKV E{(h16*)(p->ws + WS_UB), (const f32x2*)(p->ws + WS_ROPE)}; pg8::gemm_phase(l3, S, E, wid_);
              if (!rep_ && bid >= 176) conv_fill(p, lds, l, cv_p(l) + cv_prev(l) + (bid - 176) * FQ_A, FQ_A, wid_); BAR(6); }
            REP(7) { phase_attn(p, l, lds, wid_);
              if (!rep_ && l != DEPTH - 1 && bid >= 64) conv_fill(p, lds, l, cv_p(l) + cv_prev(l) + SEG_A_ATT + (bid - 64) * FQ_AT, FQ_AT, wid_); BAR(7); }
        }
        REP(5) {
#pragma unroll 1
            for (int part = 0; part < 3; ++part) {
                if (part == 2 && l == DEPTH - 1) break;
                const bool ctxp = (l < DEPTH - 1);
                const int gG = part == 0 ? G : (part == 1 && ctxp ? (G < 32 ? G : 32) : 0);
                const int gnM = part == 0 ? ML / 256 : (part == 1 && ctxp ? MC / 256 : 0), gpm0 = part == 0 ? 0 : ML / 256;
                if (gnM > 0 && bid < gG) {
                    pg8::Sched S; S.init(pg8::Job{gnM, 4, gpm0, 0, (const char*)(p->ws + WS_SYB), (const char*)(p->ws + ((l & 1) ? W_O_T : W_OUT_T) + (size_t)j * D * D * 2), 0}, nojob, gG, bid, D);
                    pg8::EpiResid E{(h16*)(p->ws + (rep_ ? WS_CSCR : WS_XRES)), modp + (size_t)l * 9 * 6144 + 2048}; pg8::gemm_phase(l3, S, E, wid_);
                } else if (part > 0 && !rep_) {
                    const int cu_lo = (part == 1 && ctxp) ? gG : 0;
                    phase_norm2(p, l, lds, cu_lo, G - cu_lo, part == 1 ? 0 : ML, part == 1 ? ML : MT, wid_);
                }
                BAR(5);
            }
        }
        REP(10) { phase_topk_gather(p, l, lds, wid_);
            if (!rep_ && bid >= 128) conv_fill(p, lds, l + 1, cv_p((l + 1) & 3) + (bid - 128) * FQ_T, FQ_T, wid_); BAR(10); }
        REP(11) {
#pragma unroll 1
            for (int part = 0; part < 3; ++part) {
                const bool last = (l == DEPTH - 1);
                if (part == 2 && last) break;
                const int tpe = last ? 8 : 9;
                const int m1n = part == 0 ? 128 : (part == 1 && !last ? 16 : 0), m1p = part == 0 ? 0 : 128;
                const int m2n = part == 0 ? 0 : (part == 1 ? (last ? 128 : 96) : 48), m2p = part == 1 ? 0 : 96;
                pg8::Sched S; S.init(pg8::Job{m1n, 8, m1p, tpe, (const char*)hb, (const char*)(p->ws + W_GU_T + (size_t)l * NE * 2048 * D * 2), (size_t)2048 * D * 2},
                                     pg8::Job{m2n, 4, m2p, tpe, (const char*)(p->ws + WS_ACT), (const char*)(p->ws + W_DN_T + (size_t)l * NE * D * FF * 2), (size_t)D * FF * 2}, G, bid, D);
                pg8::EpiMoeMix E{pg8::EpiMoe1{(h16*)(p->ws + WS_ACT), (const float*)(p->ws + WS_GV)}, pg8::EpiF16{(h16*)(p->ws + WS_YO), D}};
                pg8::gemm_phase_g(l3, S, E, (const int*)(p->ws + WS_ROWIDX), wid_);
                if (!rep_ && part == 2 && bid >= 192) conv_fill(p, lds, l + 1, cv_p((l + 1) & 3) + SEG_T + (bid - 192) * FQ_Z, FQ_Z, wid_);
                BAR(11);
            }
        }
        REP(13) { if (rep_) BAR(13); }
        phase_rowfin(p, l, lds, wid_);
        if (l < DEPTH - 1) BAR(1);
    }
    if constexpr (l + 1 < DEPTH) run_layers<l + 1>(p, lds, bar, wid_);
}
__global__ void __launch_bounds__(NT, 2) k_main(P p_unused) {
    PC p = (PC)__builtin_amdgcn_kernarg_segment_ptr();
    extern __shared__ __attribute__((aligned(16))) unsigned char lds[];
    volatile LAS unsigned* misc = (volatile LAS unsigned*)((LAS unsigned char*)lds + MISC_OFF);
    if (threadIdx.x < 64) misc[threadIdx.x] = 0u;
    __syncthreads();
    const XcdBarrier bar = xcd_barrier_post((unsigned*)(p->ws + WS_CTL) + CW_BAR, misc + 8);
    const int wid_ = __builtin_amdgcn_readfirstlane((int)threadIdx.x >> 6);
    REP(0) { phase_mod(p, lds, wid_); phase_convw(p, lds, wid_); BAR(0); }
    REP(1) { phase_rowfin(p, 255, lds, wid_); BAR(1); }
    run_layers<0>(p, lds, bar, wid_);
}
#undef REP
#undef BAR

extern "C" void kernel_launch(void* const* d_in, const int* in_sizes, int n_in, void* d_out, int out_size, void* d_ws, size_t ws_size, hipStream_t stream) {
    static int grid = 0;
    if (grid == 0) {
        if (n_in != 23 || out_size != ML * D || ws_size < WS_END) { fprintf(stderr, "kernel_launch: unexpected sizes n_in %d out %d ws %zu\n", n_in, out_size, ws_size); grid = -1; return; }
        int dev = 0, cus = 0, per_cu = 0;
        if (hipGetDevice(&dev) != hipSuccess || hipDeviceGetAttribute(&cus, hipDeviceAttributeMultiprocessorCount, dev) != hipSuccess) { grid = -1; return; }
        if (hipFuncSetAttribute((const void*)k_main, hipFuncAttributeMaxDynamicSharedMemorySize, LDS_BYTES) != hipSuccess) { fprintf(stderr, "hipFuncSetAttribute failed\n"); grid = -1; return; }
        if (hipOccupancyMaxActiveBlocksPerMultiprocessor(&per_cu, (const void*)k_main, NT, LDS_BYTES) != hipSuccess || per_cu < 1) { fprintf(stderr, "occupancy query says %d blocks/CU; not launching\n", per_cu); grid = -1; return; }
        (void)hipGetLastError();
        grid = cus;
    }
    if (grid < 0) return;
    P p{};
    const float** pp = (const float**)&p;
    for (int i = 0; i < 23; ++i) pp[i] = (const float*)d_in[i];
    p.out = (float*)d_out; p.ws = (unsigned char*)d_ws;
    (void)hipMemsetAsync((char*)d_ws + WS_CTL, 0, 1 * MiB, stream);
    hipLaunchKernelGGL(k_main, dim3(grid), dim3(NT), LDS_BYTES, stream, p);
}
```

```cpp
#include <hip/hip_runtime.h>
#include <stdint.h>
#include <stdio.h>

#define DI __device__ __forceinline__
typedef _Float16 h16;
typedef _Float16 h16x2 __attribute__((ext_vector_type(2)));
typedef _Float16 h16x4 __attribute__((ext_vector_type(4)));
typedef _Float16 h16x8 __attribute__((ext_vector_type(8)));
typedef float f32x2 __attribute__((ext_vector_type(2)));
typedef float f32x4 __attribute__((ext_vector_type(4)));
typedef unsigned u32x4 __attribute__((ext_vector_type(4)));
typedef unsigned long long u64;

constexpr int D = 1024, NB = 8, SEQ = 2048, CTXL = 256, DEPTH = 4;
constexpr int ML = NB * SEQ, MC = NB * CTXL, MT = ML + MC;
constexpr int NE = 16, FF = 1024, CAPL = 256, CAPC = 32;
constexpr int PPE = NB * CAPL + NB * CAPC;
constexpr int NPAIR = NE * PPE;
constexpr int NH = 8, HD = 128, NKV = 2, QKVW = 1536;
constexpr int NT = 512;
constexpr float EPS = 1e-6f;
constexpr float QSCALE = 0.08838834764831845f * 1.4426950408889634f;
constexpr float LOG2E = 1.4426950408889634f;

constexpr size_t MiB = 1u << 20;
constexpr size_t WS_CTL = 0;
constexpr size_t WS_MOD = 1 * MiB;
constexpr size_t WS_ROPE = 2 * MiB;
constexpr size_t WS_AFF = 3 * MiB;
constexpr size_t WS_INV = 5 * MiB;
constexpr size_t WS_ROWIDX = 7 * MiB;
constexpr size_t WS_GV = 8 * MiB;
constexpr size_t WS_AGG = 9 * MiB;
constexpr size_t WS_XRES = 16 * MiB;
constexpr size_t WS_HB = 88 * MiB;
constexpr size_t WS_UB = 124 * MiB;
constexpr size_t WS_SYB = 196 * MiB;
constexpr size_t WS_ACT = 232 * MiB;
constexpr size_t WS_YO = 304 * MiB;
constexpr size_t WS_CSCR = 376 * MiB;
constexpr size_t WS_W16 = 520 * MiB;
constexpr size_t WS_END = 1024 * MiB;

struct P {
    const float *x, *c, *ctx, *c_ctx, *ada_w, *ada_b, *norm1_g, *norm2_g;
    const float *lru_w_in, *lru_conv_w, *lru_conv_b, *lru_gate_w, *lru_gate_b, *lru_lambda, *lru_w_out;
    const float *attn_w_qkv, *attn_sink, *attn_w_o, *moe_router, *moe_w_gate, *moe_w_up, *moe_w_down, *final_g;
    float* out; unsigned char* ws;
};
typedef const P __attribute__((address_space(4)))* PC;
struct Prog { unsigned char kind[96]; unsigned char layer[96]; int n; int pad; };

enum Kind : unsigned char {
    K_MOD = 1, K_ROWFIN, K_NG_IN, K_EPI_IN, K_CONV, K_SCAN, K_NG_OUT, K_EPI_RES, K_NG_QKV, K_EPI_QKV, K_ATTN, K_NG_O,
    K_NORM2, K_TOPK, K_NG_MOE1, K_NG_MOE2, K_EPI_YO
};

DI int row_modr(int m) { return m < ML ? (m >> 11) : 8; }
DI float shx(float v, int m, int lane) { return __int_as_float(__builtin_amdgcn_ds_bpermute((lane ^ m) << 2, __float_as_int(v))); }
DI float wave_sum(float v, int lane) {
#pragma unroll
    for (int o = 1; o < 64; o <<= 1) v += shx(v, o, lane);
    return v;
}
DI float wave_max(float v, int lane) {
#pragma unroll
    for (int o = 1; o < 64; o <<= 1) v = fmaxf(v, shx(v, o, lane));
    return v;
}
DI float fast_exp(float x) { return __builtin_amdgcn_exp2f(x * LOG2E); }
DI float sigmoidf_(float x) { return __builtin_amdgcn_rcpf(1.0f + __builtin_amdgcn_exp2f(-LOG2E * x)); }
DI float siluf_(float x) { return x * sigmoidf_(x); }
DI float gelu_tanh(float x) {
    const float z2 = x * (1.5957691216057308f + 0.07135481627f * x * x);
    return x * __builtin_amdgcn_rcpf(1.0f + __builtin_amdgcn_exp2f(-LOG2E * z2));
}
DI int tid_from(int wid) { unsigned m = ~0u; asm volatile("" : "+s"(m), "+s"(wid)); return wid * 64 + (int)__builtin_amdgcn_mbcnt_hi(m, __builtin_amdgcn_mbcnt_lo(m, 0u)); }
DI float logsig8(float lam) {
    const float e = fast_exp(-lam);
    float l1p;
    if (e < 0.03f) l1p = e * (1.0f - e * (0.5f - e * (0.33333333f - e * (0.25f - e * 0.2f))));
    else l1p = __builtin_amdgcn_logf(1.0f + e) * 0.6931471805599453f;
    return -8.0f * l1p;
}
DI float neg_expm1(float z) {
    if (z > -0.25f) { const float p = z * (1.0f + z * (0.5f + z * (0.16666667f + z * (0.041666667f + z * (0.0083333333f + z * 0.0013888889f))))); return -p; }
    return 1.0f - fast_exp(z);
}
DI void lru_ab(float pr, float pi, float c8, float xb, float& a, float& bb) {
    const float r = sigmoidf_(pr), ig = sigmoidf_(pi);
    const float la = c8 * r;
    a = fast_exp(la);
    bb = sqrtf(neg_expm1(2.0f * la)) * (ig * xb);
}

DI void phase_mod(PC p, unsigned char* lds, int wid_) {
    int tidx = tid_from(wid_), bidx = blockIdx.x; asm volatile("" : "+v"(tidx), "+s"(bidx), "+s"(p));
    float* s = (float*)lds;
    float* red = s + 9 * 1024;
    const int tid = tidx;
    for (int i = tid; i < 9 * 1024; i += NT) { const int r = i >> 10, k = i & 1023; const float v = r < 8 ? p->c[r * 1024 + k] : p->c_ctx[k]; s[i] = siluf_(v); }
    __syncthreads();
    float* mod = (float*)(p->ws + WS_MOD);
    const int nchunk = DEPTH * 6144 / 32;
    const int kq = tid >> 3, cq = (tid & 7) * 4;
    for (int ch = bidx; ch < nchunk; ch += gridDim.x) {
        const int l = ch / 192, n0 = (ch % 192) * 32;
        const float* w = p->ada_w + (size_t)l * 1024 * 6144 + n0 + cq;
        f32x4 wv[16];
#pragma unroll
        for (int i = 0; i < 16; ++i) wv[i] = __builtin_nontemporal_load((const f32x4*)(w + (size_t)(kq + 64 * i) * 6144));
        f32x4 acc[9];
#pragma unroll
        for (int r = 0; r < 9; ++r) acc[r] = (f32x4){0.f, 0.f, 0.f, 0.f};
#pragma unroll
        for (int i = 0; i < 16; ++i)
#pragma unroll
            for (int r = 0; r < 9; ++r) acc[r] += wv[i] * s[r * 1024 + kq + 64 * i];
#pragma unroll
        for (int r = 0; r < 9; ++r) *(f32x4*)(red + (kq * 9 + r) * 32 + cq) = acc[r];
        __syncthreads();
        if (tid < 288) {
            const int r = tid >> 5, cc = tid & 31; float v = 0.f;
#pragma unroll 8
            for (int q = 0; q < 64; ++q) v += red[(q * 9 + r) * 32 + cc];
            mod[((size_t)l * 9 + r) * 6144 + n0 + cc] = v + p->ada_b[l * 6144 + n0 + cc];
        }
        __syncthreads();
    }
    if (bidx == gridDim.x - 1) {
        f32x2* tab = (f32x2*)(p->ws + WS_ROPE);
        for (int idx = tid; idx < 64 * 32; idx += NT) {
            const int pos = idx >> 5, i = idx & 31;
            double f = 1.0; for (int q = 0; q < i; ++q) f *= 0.74989420933245582730;
            const double xa = (double)pos * f;
            const double n = __builtin_rint(xa * 0.63661977236758134308);
            const double r = (xa - n * 1.5707963267948966192) - n * 6.123233995736766e-17;
            const double r2 = r * r;
            double sn = r * (1.0 + r2 * (-1.0 / 6 + r2 * (1.0 / 120 + r2 * (-1.0 / 5040 + r2 * (1.0 / 362880 + r2 * (-1.0 / 39916800 + r2 * (1.0 / 6227020800.0)))))));
            double cs = 1.0 + r2 * (-0.5 + r2 * (1.0 / 24 + r2 * (-1.0 / 720 + r2 * (1.0 / 40320 + r2 * (-1.0 / 3628800 + r2 * (1.0 / 479001600.0 + r2 * (-1.0 / 87178291200.0)))))));
            const int q = ((int)n) & 3;
            double cv, sv;
            if (q == 0) { cv = cs; sv = sn; } else if (q == 1) { cv = -sn; sv = cs; } else if (q == 2) { cv = -cs; sv = -sn; } else { cv = sn; sv = -cs; }
            tab[idx] = (f32x2){(float)cv, (float)sv};
        }
    }
}

DI void rowfin_finish(PC p, int l, bool pro, int m, f32x4 (&v)[4], int lane, const float* T) {
    h16* xres = (h16*)(p->ws + WS_XRES);
    h16* hb = (h16*)(p->ws + WS_HB);
    float ss = 0.f;
#pragma unroll
    for (int j = 0; j < 4; ++j) ss += (v[j][0] * v[j][0] + v[j][1] * v[j][1]) + (v[j][2] * v[j][2] + v[j][3] * v[j][3]);
    ss = wave_sum(ss, lane);
    const float rs = __builtin_amdgcn_rsqf(ss * (1.0f / D) + EPS);
    const float* tb = T + (size_t)row_modr(m) * 3 * D + 4 * lane;
    if (!pro && l == 3) {
#pragma unroll
        for (int j = 0; j < 4; ++j) { const f32x4 g = *(const f32x4*)(tb + 256 * j); *(f32x4*)(p->out + (size_t)m * D + 4 * lane + 256 * j) = v[j] * rs * g; }
    } else {
#pragma unroll
        for (int j = 0; j < 4; ++j) {
            const f32x4 g = *(const f32x4*)(tb + 256 * j), sh = *(const f32x4*)(tb + D + 256 * j);
            const f32x4 h = (v[j] * rs) * g + sh;
            *(h16x4*)(xres + (size_t)m * D + 4 * lane + 256 * j) = (h16x4){(h16)v[j][0], (h16)v[j][1], (h16)v[j][2], (h16)v[j][3]};
            *(h16x4*)(hb + (size_t)m * D + 4 * lane + 256 * j) = (h16x4){(h16)h[0], (h16)h[1], (h16)h[2], (h16)h[3]};
        }
    }
}
DI void phase_rowfin(PC p, int l  , unsigned char* lds, int wid_) {
    int tidx = tid_from(wid_), bidx = blockIdx.x; asm volatile("" : "+v"(tidx), "+s"(bidx), "+s"(p));
    const int lane = tidx & 63, wv = tidx >> 6;
    const int gw = bidx * 8 + wv, ngw = gridDim.x * 8;
    const bool pro = (l == 255);
    const h16* xres = (const h16*)(p->ws + WS_XRES);
    const float* mod = (const float*)(p->ws + WS_MOD);
    const int* inv = (const int*)(p->ws + WS_INV);
    const h16* yo = (const h16*)(p->ws + WS_YO);
    const int mend = (!pro && l == 3) ? ML : MT;
    float* T = (float*)lds;
    { const bool fin = (!pro && l == 3); const int nl = pro ? 0 : l + 1;
      for (int i = tidx; i < 9 * D; i += NT) { const int r = i >> 10, k = i & 1023;
          float g, sh, g2 = 0.f;
          if (fin) { g = p->final_g[k]; sh = 0.f; }
          else { const float* mb = mod + ((size_t)nl * 9 + r) * 6144; g = p->norm1_g[nl * D + k] * (1.0f + mb[1024 + k]); sh = mb[k]; }
          if (!pro) g2 = mod[((size_t)l * 9 + r) * 6144 + 5120 + k];
          T[(r * 3 + 0) * D + k] = g; T[(r * 3 + 1) * D + k] = sh; T[(r * 3 + 2) * D + k] = g2; }
      __syncthreads(); }
    f32x4 n0[4], n1[4]; h16x4 ny0[4], ny1[4]; int npe0 = -1, npe1 = -1, qpe0 = -1, qpe1 = -1;
#pragma unroll
    for (int j = 0; j < 4; ++j) { ny0[j] = (h16x4){0, 0, 0, 0}; ny1[j] = ny0[j]; }
#define RF_INV(M0, d0, d1) { const int a_ = (M0), b_ = (a_ + ngw) < mend ? a_ + ngw : a_; d0 = -1; d1 = -1; \
        if (!pro && a_ < mend) { d0 = lane < NE ? inv[a_ * NE + lane] : -1; d1 = lane < NE ? inv[b_ * NE + lane] : -1; } }
#define RF_LOAD(M0) { const int a_ = (M0), b_ = (a_ + ngw) < mend ? a_ + ngw : a_; \
        if (pro) { const float* s0_ = a_ < ML ? p->x + (size_t)a_ * D : p->ctx + (size_t)(a_ - ML) * D; const float* s1_ = b_ < ML ? p->x + (size_t)b_ * D : p->ctx + (size_t)(b_ - ML) * D; \
            _Pragma("unroll") for (int j = 0; j < 4; ++j) { n0[j] = *(const f32x4*)(s0_ + 4 * lane + 256 * j); n1[j] = *(const f32x4*)(s1_ + 4 * lane + 256 * j); } } \
        else { _Pragma("unroll") for (int j = 0; j < 4; ++j) { const h16x4 q0_ = *(const h16x4*)(xres + (size_t)a_ * D + 4 * lane + 256 * j), q1_ = *(const h16x4*)(xres + (size_t)b_ * D + 4 * lane + 256 * j); \
            n0[j] = (f32x4){(float)q0_[0], (float)q0_[1], (float)q0_[2], (float)q0_[3]}; n1[j] = (f32x4){(float)q1_[0], (float)q1_[1], (float)q1_[2], (float)q1_[3]}; } \
            const unsigned f0_ = (unsigned)__ballot(npe0 >= 0), f1_ = (unsigned)__ballot(npe1 >= 0); \
            const int r0_ = f0_ ? __builtin_amdgcn_readlane(npe0, __builtin_ctz(f0_ | 0x10000u)) : 0, r1_ = f1_ ? __builtin_amdgcn_readlane(npe1, __builtin_ctz(f1_ | 0x10000u)) : 0; \
            _Pragma("unroll") for (int j = 0; j < 4; ++j) { ny0[j] = *(const h16x4*)(yo + (size_t)r0_ * D + 4 * lane + 256 * j); ny1[j] = *(const h16x4*)(yo + (size_t)r1_ * D + 4 * lane + 256 * j); } } }
    if (gw < mend) { RF_INV(gw, npe0, npe1) RF_LOAD(gw) RF_INV(gw + 2 * ngw, qpe0, qpe1) }
    for (int m0 = gw; m0 < mend; m0 += 2 * ngw) {
        const bool has1 = (m0 + ngw) < mend; const int m1 = has1 ? m0 + ngw : m0;
        f32x4 v0[4], v1[4]; h16x4 yf0[4], yf1[4];
#pragma unroll
        for (int j = 0; j < 4; ++j) { v0[j] = n0[j]; v1[j] = n1[j]; yf0[j] = ny0[j]; yf1[j] = ny1[j]; }
        const int pe0 = npe0, pe1 = npe1;
        npe0 = qpe0; npe1 = qpe1;
        if (m0 + 2 * ngw < mend) { RF_LOAD(m0 + 2 * ngw) RF_INV(m0 + 4 * ngw, qpe0, qpe1) }
        if (!pro) {
            f32x4 a0[4], a1[4];
            unsigned k0 = (unsigned)__ballot(pe0 >= 0), k1 = (unsigned)__ballot(pe1 >= 0);
#pragma unroll
            for (int j = 0; j < 4; ++j) {
                a0[j] = k0 ? (f32x4){(float)yf0[j][0], (float)yf0[j][1], (float)yf0[j][2], (float)yf0[j][3]} : (f32x4){0.f, 0.f, 0.f, 0.f};
                a1[j] = k1 ? (f32x4){(float)yf1[j][0], (float)yf1[j][1], (float)yf1[j][2], (float)yf1[j][3]} : (f32x4){0.f, 0.f, 0.f, 0.f}; }
            k0 &= k0 - 1; k1 &= k1 - 1;
            while (k0 | k1) {
                const bool t0 = k0 != 0u, t1 = k1 != 0u;
                const int e0 = t0 ? __builtin_ctz(k0) : 0, e1 = t1 ? __builtin_ctz(k1) : 0;
                k0 &= k0 - 1; k1 &= k1 - 1;
                int pr0 = __builtin_amdgcn_readlane(pe0, e0), pr1 = __builtin_amdgcn_readlane(pe1, e1);
                pr0 = t0 ? pr0 : 0; pr1 = t1 ? pr1 : 0;
                const h16* y0p = yo + (size_t)pr0 * D + 4 * lane; const h16* y1p = yo + (size_t)pr1 * D + 4 * lane;
                h16x4 y0[4], y1[4];
#pragma unroll
                for (int j = 0; j < 4; ++j) { y0[j] = *(const h16x4*)(y0p + 256 * j); y1[j] = *(const h16x4*)(y1p + 256 * j); }
                if (t0) {
#pragma unroll
                    for (int j = 0; j < 4; ++j) a0[j] += (f32x4){(float)y0[j][0], (float)y0[j][1], (float)y0[j][2], (float)y0[j][3]}; }
                if (t1) {
#pragma unroll
                    for (int j = 0; j < 4; ++j) a1[j] += (f32x4){(float)y1[j][0], (float)y1[j][1], (float)y1[j][2], (float)y1[j][3]}; }
            }
            const float* g20 = T + ((size_t)row_modr(m0) * 3 + 2) * D + 4 * lane;
            const float* g21 = T + ((size_t)row_modr(m1) * 3 + 2) * D + 4 * lane;
#pragma unroll
            for (int j = 0; j < 4; ++j) { v0[j] += *(const f32x4*)(g20 + 256 * j) * a0[j]; v1[j] += *(const f32x4*)(g21 + 256 * j) * a1[j]; }
        }
        rowfin_finish(p, l, pro, m0, v0, lane, T);
        if (has1) rowfin_finish(p, l, pro, m1, v1, lane, T);
    }
#undef RF_INV
#undef RF_LOAD
}

DI void phase_norm2(PC p, int l, unsigned char* lds, int cu_lo, int ncu, int m_lo, int m_hi, int wid_) {
    int tidx = tid_from(wid_), bidx = blockIdx.x; asm volatile("" : "+v"(tidx), "+s"(bidx), "+s"(p));
    if (bidx < cu_lo || bidx >= cu_lo + ncu || m_lo >= m_hi) return;
    float* rt = (float*)lds;
    const float* rsrc = p->moe_router + (size_t)l * D * NE;
    for (int i = tidx; i < D * NE / 4; i += NT) { const f32x4 w = ((const f32x4*)rsrc)[i]; const int k = i >> 2, e4 = (i & 3) * 4;
        rt[(e4 + 0) * D + k] = w[0]; rt[(e4 + 1) * D + k] = w[1]; rt[(e4 + 2) * D + k] = w[2]; rt[(e4 + 3) * D + k] = w[3]; }
    float* T2 = rt + NE * D;
    for (int i = tidx; i < 9 * D; i += NT) { const int r = i >> 10, k = i & 1023; const float* mb = (const float*)(p->ws + WS_MOD) + ((size_t)l * 9 + r) * 6144 + 3072;
        T2[(r * 2 + 0) * D + k] = p->norm2_g[l * D + k] * (1.0f + mb[1024 + k]); T2[(r * 2 + 1) * D + k] = mb[k]; }
    __syncthreads();
    const int lane = tidx & 63, wv = tidx >> 6;
    const int gw = (bidx - cu_lo) * 8 + wv, ngw = ncu * 8;
    const h16* xres = (const h16*)(p->ws + WS_XRES);
    const float* mod = (const float*)(p->ws + WS_MOD);
    h16* hb = (h16*)(p->ws + WS_HB);
    float* aff = (float*)(p->ws + WS_AFF);
    const int mend = m_hi;
    for (int m0 = m_lo + gw; m0 < mend; m0 += 2 * ngw) {
        const bool has1 = (m0 + ngw) < mend; const int m1 = has1 ? m0 + ngw : m0;
        f32x4 v0[4], v1[4];
#pragma unroll
        for (int j = 0; j < 4; ++j) { const h16x4 q0_ = *(const h16x4*)(xres + (size_t)m0 * D + 4 * lane + 256 * j), q1_ = *(const h16x4*)(xres + (size_t)m1 * D + 4 * lane + 256 * j);
            v0[j] = (f32x4){(float)q0_[0], (float)q0_[1], (float)q0_[2], (float)q0_[3]}; v1[j] = (f32x4){(float)q1_[0], (float)q1_[1], (float)q1_[2], (float)q1_[3]}; }
        float ss0 = 0.f, ss1 = 0.f;
#pragma unroll
        for (int j = 0; j < 4; ++j) { ss0 += (v0[j][0] * v0[j][0] + v0[j][1] * v0[j][1]) + (v0[j][2] * v0[j][2] + v0[j][3] * v0[j][3]); ss1 += (v1[j][0] * v1[j][0] + v1[j][1] * v1[j][1]) + (v1[j][2] * v1[j][2] + v1[j][3] * v1[j][3]); }
#pragma unroll
        for (int o = 1; o < 64; o <<= 1) { ss0 += shx(ss0, o, lane); ss1 += shx(ss1, o, lane); }
        const float rs0 = __builtin_amdgcn_rsqf(ss0 * (1.0f / D) + EPS), rs1 = __builtin_amdgcn_rsqf(ss1 * (1.0f / D) + EPS);
        const float* tb0 = T2 + (size_t)row_modr(m0) * 2 * D + 4 * lane;
        const float* tb1 = T2 + (size_t)row_modr(m1) * 2 * D + 4 * lane;
#pragma unroll
        for (int j = 0; j < 4; ++j) {
            v0[j] = (v0[j] * rs0) * *(const f32x4*)(tb0 + 256 * j) + *(const f32x4*)(tb0 + D + 256 * j);
            v1[j] = (v1[j] * rs1) * *(const f32x4*)(tb1 + 256 * j) + *(const f32x4*)(tb1 + D + 256 * j);
            *(h16x4*)(hb + (size_t)m0 * D + 4 * lane + 256 * j) = (h16x4){(h16)v0[j][0], (h16)v0[j][1], (h16)v0[j][2], (h16)v0[j][3]};
            if (has1) *(h16x4*)(hb + (size_t)m1 * D + 4 * lane + 256 * j) = (h16x4){(h16)v1[j][0], (h16)v1[j][1], (h16)v1[j][2], (h16)v1[j][3]};
        }
        float lg0[NE], lg1[NE];
#pragma unroll
        for (int e = 0; e < NE; ++e) {
            float a0 = 0.f, a1 = 0.f;
#pragma unroll
            for (int j = 0; j < 4; ++j) { const f32x4 w = *(const f32x4*)(rt + e * D + 4 * lane + 256 * j);
                a0 += (v0[j][0] * w[0] + v0[j][1] * w[1]) + (v0[j][2] * w[2] + v0[j][3] * w[3]); a1 += (v1[j][0] * w[0] + v1[j][1] * w[1]) + (v1[j][2] * w[2] + v1[j][3] * w[3]); }
            lg0[e] = a0; lg1[e] = a1;
            if (e & 1) asm volatile("" ::: "memory");
        }
#define HALVE(N, BIT) { const bool up_ = (lane & (BIT)) != 0; _Pragma("unroll") for (int e = 0; e < (N); ++e) { \
            const float k0_ = up_ ? lg0[e + (N)] : lg0[e], s0_ = up_ ? lg0[e] : lg0[e + (N)]; lg0[e] = k0_ + shx(s0_, (BIT), lane); \
            const float k1_ = up_ ? lg1[e + (N)] : lg1[e], s1_ = up_ ? lg1[e] : lg1[e + (N)]; lg1[e] = k1_ + shx(s1_, (BIT), lane); } }
        HALVE(8, 32) HALVE(4, 16) HALVE(2, 8) HALVE(1, 4)
#undef HALVE
        float x0 = lg0[0], x1 = lg1[0];
        x0 += shx(x0, 2, lane); x1 += shx(x1, 2, lane); x0 += shx(x0, 1, lane); x1 += shx(x1, 1, lane);
        float mx0 = x0, mx1 = x1;
#pragma unroll
        for (int o = 4; o < 64; o <<= 1) { mx0 = fmaxf(mx0, shx(mx0, o, lane)); mx1 = fmaxf(mx1, shx(mx1, o, lane)); }
        const float p0 = __builtin_amdgcn_exp2f((x0 - mx0) * LOG2E), p1 = __builtin_amdgcn_exp2f((x1 - mx1) * LOG2E);
        float d0 = p0, d1 = p1;
#pragma unroll
        for (int o = 4; o < 64; o <<= 1) { d0 += shx(d0, o, lane); d1 += shx(d1, o, lane); }
        if ((lane & 3) == 0) { aff[(size_t)m0 * NE + (lane >> 2)] = p0 / d0; if (has1) aff[(size_t)m1 * NE + (lane >> 2)] = p1 / d1; }
    }
}

constexpr int LDS_BYTES = 147456;
constexpr size_t W_IN_T = WS_W16, W_OUT_T = WS_W16 + 8 * MiB, W_QKV_T = WS_W16 + 12 * MiB, W_O_T = WS_W16 + 18 * MiB, W_GATE16 = WS_W16 + 22 * MiB;
constexpr size_t W_GU_T = WS_W16 + 24 * MiB, W_DN_T = WS_W16 + 280 * MiB;
static_assert(W_DN_T + 128 * MiB <= WS_END, "ws map");

DI int map_row(int kind, int n) {
    if (kind == 1) { if (n >= 1280) return n; const int d = n & 127, hb = n - d, hh = d >> 6, e = d & 63; return hb + hh * 64 + 2 * (e & 31) + (e >> 5); }
    if (kind == 2) return 256 * (n >> 7) + (n & 127);
    if (kind == 3) return 256 * (n >> 7) + 128 + (n & 127);
    return n;
}
struct CvItem { const float* src; h16* dst; int K, N, kind, k0, n0; };
DI void cv_load(const CvItem& c, f32x4 (&ld)[8], int lane) {
#pragma unroll
    for (int i = 0; i < 8; ++i) ld[i] = __builtin_nontemporal_load((const f32x4*)(c.src + (size_t)(c.k0 + 8 * i + (lane >> 3)) * c.N + c.n0 + (lane & 7) * 4));
}
DI void cv_finish(const CvItem& c, const f32x4 (&ld)[8], float* scr, int lane) {
#pragma unroll
    for (int i = 0; i < 8; ++i) { float* d = scr + (8 * i + (lane >> 3)) * 33 + (lane & 7) * 4; d[0] = ld[i][0]; d[1] = ld[i][1]; d[2] = ld[i][2]; d[3] = ld[i][3]; }
    asm volatile("s_waitcnt lgkmcnt(0)" ::: "memory");
    const int cc = lane & 7;
#pragma unroll
    for (int j = 0; j < 4; ++j) { const int n = (lane >> 3) + 8 * j; const float* sp = scr + (8 * cc) * 33 + n;
        h16x8 o;
#pragma unroll
        for (int q = 0; q < 8; ++q) o[q] = (h16)sp[q * 33];
        __builtin_nontemporal_store(o, (h16x8*)(c.dst + (size_t)map_row(c.kind, c.n0 + n) * c.K + c.k0 + 8 * cc)); }
    asm volatile("s_waitcnt lgkmcnt(0)" ::: "memory");
}
constexpr int CV_DENSE = 5632, CV_PRE = 6144, CV_LAYER = 24576;
constexpr int FQ_A = 80, FQ_T = 24, FQ_Z = 96, FQ_AT = 44;
constexpr int SEG_T = 128 * FQ_T, SEG_Z = 64 * FQ_Z, SEG_PREV = SEG_T + SEG_Z, SEG_A_LRU = 192 * FQ_A, SEG_A_ATT = 80 * FQ_A, SEG_AT = 192 * FQ_AT;
DI constexpr int cv_prev(int L) { return L == 0 ? 0 : SEG_PREV; }
DI constexpr int cv_own(int L) { return (L & 1) ? SEG_A_ATT + (L == DEPTH - 1 ? 0 : SEG_AT) : SEG_A_LRU; }
DI constexpr int cv_p(int L) { return CV_LAYER - cv_prev(L) - cv_own(L); }
static_assert(cv_p(0) >= 0 && cv_p(1) >= 0 && cv_p(2) >= 0 && cv_p(3) >= 0, "filler plan");
DI CvItem cv_decode(PC p, int it) {
    constexpr int I_IN = 1024, I_SQ = 512, I_QKV = 768;
    CvItem c; int r = it, item;
    if (r >= CV_PRE) {
        r -= CV_PRE; const int mat = r / I_SQ, le = mat / 3, kind = mat % 3; item = r % I_SQ;
        c.K = D; c.N = FF;
        if (kind == 0) { c.src = p->moe_w_gate + (size_t)le * D * FF; c.dst = (h16*)(p->ws + W_GU_T) + (size_t)le * 2048 * D; c.kind = 2; }
        else if (kind == 1) { c.src = p->moe_w_up + (size_t)le * D * FF; c.dst = (h16*)(p->ws + W_GU_T) + (size_t)le * 2048 * D; c.kind = 3; }
        else { c.src = p->moe_w_down + (size_t)le * FF * D; c.dst = (h16*)(p->ws + W_DN_T) + (size_t)le * D * FF; c.kind = 0; }
    } else if (r >= CV_DENSE) { r -= CV_DENSE; const int mat = r >> 4; item = r & 15;
        c.src = p->lru_gate_w + (size_t)mat * 128 * 256; c.dst = (h16*)(p->ws + W_GATE16) + (size_t)mat * 256 * 128; c.K = 128; c.N = 256; c.kind = 0;
    } else if (r < 2 * I_IN) { const int j = r / I_IN; item = r % I_IN; c.src = p->lru_w_in + (size_t)j * D * 2048; c.dst = (h16*)(p->ws + W_IN_T) + (size_t)j * 2048 * D; c.K = D; c.N = 2048; c.kind = 0;
    } else if (r < 2 * I_IN + 2 * I_SQ) { r -= 2 * I_IN; const int j = r / I_SQ; item = r % I_SQ; c.src = p->lru_w_out + (size_t)j * D * D; c.dst = (h16*)(p->ws + W_OUT_T) + (size_t)j * D * D; c.K = D; c.N = D; c.kind = 0;
    } else if (r < 2 * I_IN + 2 * I_SQ + 2 * I_QKV) { r -= 2 * I_IN + 2 * I_SQ; const int j = r / I_QKV; item = r % I_QKV; c.src = p->attn_w_qkv + (size_t)j * D * QKVW; c.dst = (h16*)(p->ws + W_QKV_T) + (size_t)j * QKVW * D; c.K = D; c.N = QKVW; c.kind = 1;
    } else { r -= 2 * I_IN + 2 * I_SQ + 2 * I_QKV; const int j = r / I_SQ; item = r % I_SQ; c.src = p->attn_w_o + (size_t)j * D * D; c.dst = (h16*)(p->ws + W_O_T) + (size_t)j * D * D; c.K = D; c.N = D; c.kind = 0; }
    const int nblk = c.N / 32; c.k0 = 64 * (item / nblk); c.n0 = 32 * (item % nblk);
    return c;
}
#define CV_PIPE(COUNT, ITEM_OF) { const int cnt_ = (COUNT); if (cnt_ > 0) { CvItem ca_ = cv_decode(p, ITEM_OF(0)), cb_; f32x4 la_[8], lb_[8]; cv_load(ca_, la_, lane); \
        for (int k_ = 0; k_ < cnt_; k_ += 2) { \
            if (k_ + 1 < cnt_) { cb_ = cv_decode(p, ITEM_OF(k_ + 1)); cv_load(cb_, lb_, lane); } \
            cv_finish(ca_, la_, scr, lane); \
            if (k_ + 1 < cnt_) { if (k_ + 2 < cnt_) { ca_ = cv_decode(p, ITEM_OF(k_ + 2)); cv_load(ca_, la_, lane); } cv_finish(cb_, lb_, scr, lane); } } } }
DI void phase_convw(PC p, unsigned char* lds, int wid_) {
    int tidx = tid_from(wid_), bidx = blockIdx.x; asm volatile("" : "+v"(tidx), "+s"(bidx), "+s"(p));
    const int lane = tidx & 63, wv = tidx >> 6;
    float* scr = (float*)lds + wv * (64 * 33 + 16);
    const int gw = bidx * 8 + wv, ngw = gridDim.x * 8;
    if (gridDim.x != 256) {
#define IT_ALL(k) (gw + (k) * ngw)
        CV_PIPE((CV_PRE + 4 * CV_LAYER - gw + ngw - 1) / ngw, IT_ALL)
#undef IT_ALL
        return; }
    const int n0 = cv_p(0), n1 = cv_p(1), n2 = cv_p(2), n3 = cv_p(3), ntot = CV_PRE + n0 + n1 + n2 + n3;
    auto gmap = [&](int k) { int r = gw + k * ngw, g;
        if (r < CV_PRE + n0) g = r;
        else { r -= CV_PRE + n0; if (r < n1) g = CV_PRE + CV_LAYER + r; else { r -= n1; if (r < n2) g = CV_PRE + 2 * CV_LAYER + r; else g = CV_PRE + 3 * CV_LAYER + (r - n2); } }
        return g; };
    CV_PIPE(gw < ntot ? (ntot - gw + ngw - 1) / ngw : 0, gmap)
}
DI void conv_fill(PC p, unsigned char* lds, int l, int first, int quota, int wid_) {
    int tidx = tid_from(wid_), bidx = blockIdx.x; asm volatile("" : "+v"(tidx), "+s"(bidx), "+s"(p), "+s"(l));
    if (l >= DEPTH || gridDim.x != 256) return;
    const int lane = tidx & 63, wv = tidx >> 6;
    float* scr = (float*)lds + wv * (64 * 33 + 16);
    const int base = first;
    int cnt = 0; { const int lim = (CV_LAYER - base) < quota ? (CV_LAYER - base) : quota; cnt = lim > wv ? (lim - wv + 7) / 8 : 0; }
#define IT_FILL(k) (CV_PRE + l * CV_LAYER + base + wv + 8 * (k))
    CV_PIPE(cnt, IT_FILL)
#undef IT_FILL
}

namespace pg8 {
#define PG8_LAS __attribute__((address_space(3)))
constexpr int BM = 256, BK = 64, HALF = 128, HTB = HALF * BK * 2, STAGE_BYTES = 8 * HTB, NXCD = 8, WGM = 8;
DI int lds_byte(int r, int c) { const int st = (r >> 4) * 2 + (c >> 5), rr = r & 15, cc = c & 31, ob = rr * 64 + cc * 2; return st * 1024 + (ob ^ (((ob >> 9) & 1) << 5)); }
DI void stage_rc(int b, int& R, int& C) { const int st = b / 1024, sb = b % 1024, swz = sb ^ (((sb >> 9) & 1) << 5); R = (st >> 1) * 16 + swz / 64; C = (st & 1) * 32 + (swz % 64) / 2; }
DI int perm32(int rho) { const int n = rho >> 4, i = rho & 15; return 8 * (i >> 2) + 4 * n + (i & 3); }
struct Unit { int pm, pn, row0, e, job; };
struct Job { int nM, nN, pm0, TPE; const char* A; const char* Bt; size_t bstride; };
struct Sched {
    Job j0, j1; int n0, nwg, G, c, K;
    DI void init(const Job& a, const Job& b, int G_, int c_, int K_) { j0 = a; j1 = b; n0 = a.nM * a.nN; nwg = n0 + b.nM * b.nN; G = G_; c = c_; K = K_; }
    DI bool next(int i, Unit& u) const {
        const long L = (long)i * G + c; if (L >= nwg || c >= G) return false;
        const int job = L >= n0 ? 1 : 0; int wgid = job ? (int)L - n0 : (int)L;
        const int nM = job ? j1.nM : j0.nM, nN = job ? j1.nN : j0.nN, pm0 = job ? j1.pm0 : j0.pm0, TPE = job ? j1.TPE : j0.TPE, nw = nM * nN;
        { const int q = nw / NXCD, r = nw % NXCD, xcd = wgid % NXCD, off = wgid / NXCD; wgid = (xcd < r ? xcd * (q + 1) : r * (q + 1) + (xcd - r) * q) + off; }
        const int nig = WGM * nN, gid = wgid / nig, fm = gid * WGM, gsz = (nM - fm) < WGM ? (nM - fm) : WGM;
        u.pm = pm0 + fm + ((wgid % nig) % gsz); u.pn = (wgid % nig) / gsz; u.job = job;
        u.row0 = u.pm * 256; u.e = TPE ? (u.pm < 128 ? (u.pm >> 3) : (u.pm - 128)) : 0;
        return true;
    }
    DI const char* a_base(const Unit& u) const { return (u.job ? j1.A : j0.A) + (size_t)u.row0 * K * 2; }
    DI const char* b_base(const Unit& u) const { return (u.job ? j1.Bt : j0.Bt) + (size_t)u.e * (u.job ? j1.bstride : j0.bstride) + (size_t)u.pn * 256 * K * 2; }
};
DI u32x4 pack8(const f32x4 a, const f32x4 b) {
    const h16x8 o = {(h16)a[0], (h16)a[1], (h16)a[2], (h16)a[3], (h16)b[0], (h16)b[1], (h16)b[2], (h16)b[3]};
    return __builtin_bit_cast(u32x4, o);
}
struct EpiF16 {
    static constexpr bool PERM = true;
    h16* O; int ldc;
    DI void operator()(const f32x4 (&acc)[2][2][4][2], const Unit& u, int wr, int wc, int fr, int fq) const {
        const int row0 = u.row0 + wr * 64 + fr, col0 = u.pn * BM + wc * 32 + 8 * fq;
#pragma unroll
        for (int ai = 0; ai < 2; ++ai)
#pragma unroll
            for (int m = 0; m < 4; ++m) { h16* rowp = O + (size_t)(row0 + ai * HALF + m * 16) * ldc + col0;
#pragma unroll
                for (int bj = 0; bj < 2; ++bj) *(u32x4*)(rowp + bj * HALF) = pack8(acc[ai][bj][m][0], acc[ai][bj][m][1]); }
    }
};
struct EpiLruIn {
    static constexpr bool PERM = true;
    h16* yg; h16* xr;
    DI void operator()(const f32x4 (&acc)[2][2][4][2], const Unit& u, int wr, int wc, int fr, int fq) const {
        const int row0 = u.row0 + wr * 64 + fr; const bool act = u.pn < 4;
        h16* base = act ? yg : xr; const int col0 = (u.pn & 3) * BM + wc * 32 + 8 * fq;
#pragma unroll
        for (int ai = 0; ai < 2; ++ai)
#pragma unroll
            for (int m = 0; m < 4; ++m) { h16* rowp = base + (size_t)(row0 + ai * HALF + m * 16) * D + col0;
#pragma unroll
                for (int bj = 0; bj < 2; ++bj) { f32x4 v0 = acc[ai][bj][m][0], v1 = acc[ai][bj][m][1];
                    if (act) {
#pragma unroll
                        for (int q = 0; q < 4; ++q) { v0[q] = gelu_tanh(v0[q]); v1[q] = gelu_tanh(v1[q]); } }
                    *(u32x4*)(rowp + bj * HALF) = pack8(v0, v1); } }
    }
};
struct EpiResid {
    static constexpr bool PERM = true;
    h16* x; const float* gate;
    DI void operator()(const f32x4 (&acc)[2][2][4][2], const Unit& u, int wr, int wc, int fr, int fq) const {
        const float* gp = gate + (size_t)(u.pm < 64 ? (u.pm >> 3) : 8) * 6144;
        const int col0 = u.pn * BM + wc * 32 + 8 * fq;
        f32x4 gv[2][2];
#pragma unroll
        for (int bj = 0; bj < 2; ++bj)
#pragma unroll
            for (int n = 0; n < 2; ++n) gv[bj][n] = *(const f32x4*)(gp + col0 + bj * HALF + n * 4);
        h16x8 xo[2][4][2];
#pragma unroll
        for (int ai = 0; ai < 2; ++ai)
#pragma unroll
            for (int m = 0; m < 4; ++m)
#pragma unroll
                for (int bj = 0; bj < 2; ++bj) xo[ai][m][bj] = *(const h16x8*)(x + (size_t)(u.row0 + ai * HALF + wr * 64 + m * 16 + fr) * D + col0 + bj * HALF);
#pragma unroll
        for (int ai = 0; ai < 2; ++ai)
#pragma unroll
            for (int m = 0; m < 4; ++m) { h16* xp = x + (size_t)(u.row0 + ai * HALF + wr * 64 + m * 16 + fr) * D + col0;
#pragma unroll
                for (int bj = 0; bj < 2; ++bj) { f32x4 o0, o1;
#pragma unroll
                    for (int q = 0; q < 4; ++q) { o0[q] = (float)xo[ai][m][bj][q] + gv[bj][0][q] * acc[ai][bj][m][0][q]; o1[q] = (float)xo[ai][m][bj][4 + q] + gv[bj][1][q] * acc[ai][bj][m][1][q]; }
                    *(u32x4*)(xp + bj * HALF) = pack8(o0, o1); } }
    }
};
struct EpiQKV {
    static constexpr bool PERM = true;
    h16* qkv; const f32x2* tab;
    DI void operator()(const f32x4 (&acc)[2][2][4][2], const Unit& u, int wr, int wc, int fr, int fq) const {
        const int row0 = u.row0 + wr * 64 + fr, col0 = u.pn * BM + wc * 32 + 8 * fq;
        const bool rope = (u.pn < 5) && (u.pm < 64); const float sc = u.pn < 4 ? QSCALE : 1.0f;
        const int hh = wc >> 1, i0 = 16 * (wc & 1) + 4 * fq;
        f32x4 csa[2][4][2];
#pragma unroll
        for (int ai = 0; ai < 2; ++ai)
#pragma unroll
            for (int m = 0; m < 4; ++m) { const int row = row0 + ai * HALF + m * 16;
                csa[ai][m][0] = (f32x4){1.f, 0.f, 1.f, 0.f}; csa[ai][m][1] = csa[ai][m][0];
                if (rope) { const int t = row & 2047, pos = hh ? (t & 63) : (t >> 6); const f32x4* tp = (const f32x4*)(tab + pos * 32 + i0); csa[ai][m][0] = tp[0]; csa[ai][m][1] = tp[1]; } }
#pragma unroll
        for (int ai = 0; ai < 2; ++ai)
#pragma unroll
            for (int m = 0; m < 4; ++m) { const int row = row0 + ai * HALF + m * 16; h16* rowp = qkv + (size_t)row * QKVW + col0;
                const f32x4 cs0 = csa[ai][m][0], cs1 = csa[ai][m][1];
#pragma unroll
                for (int bj = 0; bj < 2; ++bj) { const f32x4 a = acc[ai][bj][m][0], b = acc[ai][bj][m][1]; f32x4 o0, o1;
                    o0[0] = (a[0] * cs0[0] - a[1] * cs0[1]) * sc; o0[1] = (a[0] * cs0[1] + a[1] * cs0[0]) * sc; o0[2] = (a[2] * cs0[2] - a[3] * cs0[3]) * sc; o0[3] = (a[2] * cs0[3] + a[3] * cs0[2]) * sc;
                    o1[0] = (b[0] * cs1[0] - b[1] * cs1[1]) * sc; o1[1] = (b[0] * cs1[1] + b[1] * cs1[0]) * sc; o1[2] = (b[2] * cs1[2] - b[3] * cs1[3]) * sc; o1[3] = (b[2] * cs1[3] + b[3] * cs1[2]) * sc;
                    *(u32x4*)(rowp + bj * HALF) = pack8(o0, o1); } }
    }
};
struct EpiMoe1 {
    static constexpr bool PERM = true;
    h16* act; const float* gvp;
    DI void operator()(const f32x4 (&acc)[2][2][4][2], const Unit& u, int wr, int wc, int fr, int fq) const {
        const int row0 = u.row0 + wr * 64 + fr, col0 = u.pn * HALF + wc * 32 + 8 * fq;
        float gq[2][4];
#pragma unroll
        for (int ai = 0; ai < 2; ++ai)
#pragma unroll
            for (int m = 0; m < 4; ++m) gq[ai][m] = gvp[row0 + ai * HALF + m * 16];
        f32x4 t0[2][4], t1[2][4];
#pragma unroll
        for (int ai = 0; ai < 2; ++ai)
#pragma unroll
            for (int m = 0; m < 4; ++m)
#pragma unroll
                for (int q = 0; q < 4; ++q) { t0[ai][m][q] = siluf_(acc[ai][0][m][0][q]) * acc[ai][1][m][0][q]; t1[ai][m][q] = siluf_(acc[ai][0][m][1][q]) * acc[ai][1][m][1][q]; }
        __builtin_amdgcn_sched_barrier(0);
#pragma unroll
        for (int ai = 0; ai < 2; ++ai)
#pragma unroll
            for (int m = 0; m < 4; ++m) { const int row = row0 + ai * HALF + m * 16; const float g = gq[ai][m]; f32x4 o0, o1;
#pragma unroll
                for (int q = 0; q < 4; ++q) { o0[q] = t0[ai][m][q] * g; o1[q] = t1[ai][m][q] * g; }
                *(u32x4*)(act + (size_t)row * FF + col0) = pack8(o0, o1); }
    }
};

struct EpiMoeMix {
    static constexpr bool PERM = true;
    EpiMoe1 e1; EpiF16 e2;
    DI void operator()(const f32x4 (&acc)[2][2][4][2], const Unit& u, int wr, int wc, int fr, int fq) const { if (u.job == 0) e1(acc, u, wr, wc, fr, fq); else e2(acc, u, wr, wc, fr, fq); }
};
template <class Epi>
DI void gemm_phase(PG8_LAS unsigned char* lds, const Sched& S, const Epi& E, int wid_) {
    const int tid = tid_from(wid_);
    const int wid = wid_, lane = tid & 63, wr = wid >> 2, wc = wid & 3, fr = lane & 15, fq = lane >> 4;
    const int K = S.K, nt = K / BK;
    unsigned voffA[2], voffB[2];
#pragma unroll
    for (int i = 0; i < 2; ++i) { int R, C; stage_rc(tid * 16 + i * 8192, R, C); const int Rb = Epi::PERM ? ((R & ~31) + perm32(R & 31)) : R;
        voffA[i] = (unsigned)(R * K + C) * 2u; voffB[i] = (unsigned)(Rb * K + C) * 2u; }
    const size_t kstep = (size_t)(BK * 2);
    const size_t hstep = (size_t)HALF * K * 2;
    const unsigned ldsw = (unsigned)wid * 1024u;
    const int aoff = lds_byte(wr * 64 + fr, fq * 8), boff = lds_byte(wc * 32 + fr, fq * 8);
#define PG8_SA(b, h) (((b) * 2 + (h)) * HTB)
#define PG8_SB(b, h) ((4 + (b) * 2 + (h)) * HTB)
#define PG8_STAGE(bufoff, gbase, voff) do { _Pragma("unroll") for (int _i = 0; _i < 2; ++_i) \
        __builtin_amdgcn_global_load_lds((const unsigned*)((const char*)(gbase) + (voff)[_i]), (PG8_LAS unsigned*)(lds + (bufoff) + ldsw + _i * 8192), 16, 0, 0); } while (0)
#define PG8_LDA(dst, b, h) do { _Pragma("unroll") for (int m = 0; m < 4; ++m) _Pragma("unroll") for (int k = 0; k < 2; ++k) dst[m][k] = *(const PG8_LAS h16x8*)(lds + PG8_SA(b, h) + aoff + m * 2048 + k * 1024); } while (0)
#define PG8_LDB(dst, b, h) do { _Pragma("unroll") for (int n = 0; n < 2; ++n) _Pragma("unroll") for (int k = 0; k < 2; ++k) dst[n][k] = *(const PG8_LAS h16x8*)(lds + PG8_SB(b, h) + boff + n * 2048 + k * 1024); } while (0)
#define PG8_MMA(ai, bj, At, Bt) do { __builtin_amdgcn_s_setprio(1); _Pragma("unroll") for (int m = 0; m < 4; ++m) _Pragma("unroll") for (int n = 0; n < 2; ++n) _Pragma("unroll") for (int k = 0; k < 2; ++k) \
        acc[ai][bj][m][n] = __builtin_amdgcn_mfma_f32_16x16x32_f16(Bt[n][k], At[m][k], acc[ai][bj][m][n], 0, 0, 0); __builtin_amdgcn_s_setprio(0); } while (0)
#define PG8_WAIT_V(n) asm volatile("s_waitcnt vmcnt(" #n ")" ::: "memory")
#define PG8_WAIT_L(n) asm volatile("s_waitcnt lgkmcnt(" #n ")" ::: "memory")
#define PG8_BAR __builtin_amdgcn_s_barrier()
#define PG8_SCHED __builtin_amdgcn_sched_barrier(0)
    Unit cur, nxt; int ui = 0;
    if (!S.next(0, cur)) return;
    f32x4 acc[2][2][4][2];
#pragma unroll
    for (int a = 0; a < 2; ++a)
#pragma unroll
        for (int b = 0; b < 2; ++b)
#pragma unroll
            for (int m = 0; m < 4; ++m)
#pragma unroll
                for (int n = 0; n < 2; ++n) acc[a][b][m][n] = (f32x4){0.f, 0.f, 0.f, 0.f};
    h16x8 At[4][2], B0[2][2], B1[2][2];
    const char* cA = S.a_base(cur); const char* cB = S.b_base(cur);
    PG8_STAGE(PG8_SB(0, 0), cB, voffB); PG8_STAGE(PG8_SB(0, 1), cB + hstep, voffB); PG8_STAGE(PG8_SA(0, 0), cA, voffA); PG8_STAGE(PG8_SA(0, 1), cA + hstep, voffA);
    if (wr == 1) PG8_BAR;
    PG8_WAIT_V(2); PG8_BAR;
    PG8_STAGE(PG8_SB(1, 0), cB + kstep, voffB); PG8_STAGE(PG8_SA(1, 0), cA + kstep, voffA); PG8_STAGE(PG8_SB(1, 1), cB + hstep + kstep, voffB);
    PG8_WAIT_V(6); PG8_BAR;
    for (;;) {
        const bool has_next = S.next(ui + 1, nxt);
        const char* nA = has_next ? S.a_base(nxt) : cA; const char* nB = has_next ? S.b_base(nxt) : cB;
        for (int t = 0; t < nt; t += 2) {
            const bool last = (t == nt - 2);
            const char* a1 = cA + (size_t)(t + 1) * kstep;
            const char* a2 = last ? nA : cA + (size_t)(t + 2) * kstep; const char* b2 = last ? nB : cB + (size_t)(t + 2) * kstep;
            const char* a3 = a2 + kstep; const char* b3 = b2 + kstep;
            PG8_LDB(B0, 0, 0); PG8_LDB(B1, 0, 1); PG8_SCHED; PG8_LDA(At, 0, 0); PG8_STAGE(PG8_SA(1, 1), a1 + hstep, voffA);
            PG8_WAIT_V(8); PG8_WAIT_L(0); PG8_BAR; PG8_MMA(0, 0, At, B0); PG8_MMA(0, 1, At, B1); PG8_BAR; PG8_SCHED;
            PG8_LDA(At, 0, 1); PG8_STAGE(PG8_SB(0, 0), b2, voffB); PG8_STAGE(PG8_SB(0, 1), b2 + hstep, voffB); PG8_STAGE(PG8_SA(0, 0), a2, voffA);
            PG8_WAIT_V(8); PG8_WAIT_L(0); PG8_BAR; PG8_MMA(1, 0, At, B0); PG8_MMA(1, 1, At, B1); PG8_BAR; PG8_SCHED;
            PG8_LDB(B0, 1, 0); PG8_LDB(B1, 1, 1); PG8_SCHED; PG8_LDA(At, 1, 0); PG8_STAGE(PG8_SA(0, 1), a2 + hstep, voffA);
            PG8_WAIT_V(8); PG8_WAIT_L(0); PG8_BAR; PG8_MMA(0, 0, At, B0); PG8_MMA(0, 1, At, B1); PG8_BAR; PG8_SCHED;
            PG8_LDA(At, 1, 1); PG8_STAGE(PG8_SB(1, 0), b3, voffB); PG8_STAGE(PG8_SB(1, 1), b3 + hstep, voffB); PG8_STAGE(PG8_SA(1, 0), a3, voffA);
            PG8_WAIT_V(8); PG8_WAIT_L(0); PG8_BAR; PG8_MMA(1, 0, At, B0); PG8_MMA(1, 1, At, B1); PG8_BAR; PG8_SCHED;
        }
        if (wr == 0) PG8_BAR;
        E(acc, cur, wr, wc, fr, fq);
        if (!has_next) break;
#pragma unroll
        for (int a = 0; a < 2; ++a)
#pragma unroll
            for (int b = 0; b < 2; ++b)
#pragma unroll
                for (int m = 0; m < 4; ++m)
#pragma unroll
                    for (int n = 0; n < 2; ++n) acc[a][b][m][n] = (f32x4){0.f, 0.f, 0.f, 0.f};
        cur = nxt; cA = nA; cB = nB; ++ui;
        if (wr == 1) PG8_BAR;
    }
    PG8_WAIT_V(0);
    PG8_BAR;
#undef PG8_SA
#undef PG8_SB
#undef PG8_STAGE
#undef PG8_LDA
#undef PG8_LDB
#undef PG8_MMA
#undef PG8_WAIT_V
#undef PG8_WAIT_L
#undef PG8_BAR
#undef PG8_SCHED
}
template <class Epi>
DI void gemm_phase_g(PG8_LAS unsigned char* lds, const Sched& S, const Epi& E, const int* gidx, int wid_) {
    const int tid = tid_from(wid_);
    const int wid = wid_, lane = tid & 63, wr = wid >> 2, wc = wid & 3, fr = lane & 15, fq = lane >> 4;
    const int K = S.K, nt = K / BK;
    unsigned voffB[2]; int R0, C0;
    stage_rc(tid * 16, R0, C0);
#pragma unroll
    for (int i = 0; i < 2; ++i) { int R, C; stage_rc(tid * 16 + i * 8192, R, C); const int Rb = Epi::PERM ? ((R & ~31) + perm32(R & 31)) : R; voffB[i] = (unsigned)(Rb * K + C) * 2u; }
    const unsigned cshift = (unsigned)C0 * 2u, rowb = (unsigned)K * 2u;
    const size_t kstep = (size_t)(BK * 2);
    const size_t hstep = (size_t)HALF * K * 2;
    const unsigned ldsw = (unsigned)wid * 1024u;
    const int aoff = lds_byte(wr * 64 + fr, fq * 8), boff = lds_byte(wc * 32 + fr, fq * 8);
#define PG8_SA(b, h) (((b) * 2 + (h)) * HTB)
#define PG8_SB(b, h) ((4 + (b) * 2 + (h)) * HTB)
#define PG8_STAGE(bufoff, gbase, voff) do { _Pragma("unroll") for (int _i = 0; _i < 2; ++_i) \
        __builtin_amdgcn_global_load_lds((const unsigned*)((const char*)(gbase) + (voff)[_i]), (PG8_LAS unsigned*)(lds + (bufoff) + ldsw + _i * 8192), 16, 0, 0); } while (0)
#define PG8_LDA(dst, b, h) do { _Pragma("unroll") for (int m = 0; m < 4; ++m) _Pragma("unroll") for (int k = 0; k < 2; ++k) dst[m][k] = *(const PG8_LAS h16x8*)(lds + PG8_SA(b, h) + aoff + m * 2048 + k * 1024); } while (0)
#define PG8_LDB(dst, b, h) do { _Pragma("unroll") for (int n = 0; n < 2; ++n) _Pragma("unroll") for (int k = 0; k < 2; ++k) dst[n][k] = *(const PG8_LAS h16x8*)(lds + PG8_SB(b, h) + boff + n * 2048 + k * 1024); } while (0)
#define PG8_MMA(ai, bj, At, Bt) do { __builtin_amdgcn_s_setprio(1); _Pragma("unroll") for (int m = 0; m < 4; ++m) _Pragma("unroll") for (int n = 0; n < 2; ++n) _Pragma("unroll") for (int k = 0; k < 2; ++k) \
        acc[ai][bj][m][n] = __builtin_amdgcn_mfma_f32_16x16x32_f16(Bt[n][k], At[m][k], acc[ai][bj][m][n], 0, 0, 0); __builtin_amdgcn_s_setprio(0); } while (0)
#define PG8_WAIT_V(n) asm volatile("s_waitcnt vmcnt(" #n ")" ::: "memory")
#define PG8_WAIT_L(n) asm volatile("s_waitcnt lgkmcnt(" #n ")" ::: "memory")
#define PG8_BAR __builtin_amdgcn_s_barrier()
#define PG8_SCHED __builtin_amdgcn_sched_barrier(0)
#define PG8_ROWOFF(u, o) do { _Pragma("unroll") for (int h_ = 0; h_ < 2; ++h_) _Pragma("unroll") for (int i_ = 0; i_ < 2; ++i_) { int row_ = (u).row0 + h_ * HALF + R0 + 64 * i_; \
        if ((u).job == 0 && gidx) row_ = gidx[row_]; (o)[h_][i_] = (unsigned)row_ * rowb + cshift; } } while (0)
    Unit cur, nxt; int ui = 0;
    if (!S.next(0, cur)) return;
    f32x4 acc[2][2][4][2];
#pragma unroll
    for (int a = 0; a < 2; ++a)
#pragma unroll
        for (int b = 0; b < 2; ++b)
#pragma unroll
            for (int m = 0; m < 4; ++m)
#pragma unroll
                for (int n = 0; n < 2; ++n) acc[a][b][m][n] = (f32x4){0.f, 0.f, 0.f, 0.f};
    h16x8 At[4][2], B0[2][2], B1[2][2];
    unsigned offA[2][2];
    PG8_ROWOFF(cur, offA);
    const char* cAj = cur.job ? S.j1.A : S.j0.A; const char* cB = S.b_base(cur);
    PG8_STAGE(PG8_SB(0, 0), cB, voffB); PG8_STAGE(PG8_SB(0, 1), cB + hstep, voffB); PG8_STAGE(PG8_SA(0, 0), cAj, offA[0]); PG8_STAGE(PG8_SA(0, 1), cAj, offA[1]);
    if (wr == 1) PG8_BAR;
    PG8_WAIT_V(2); PG8_BAR;
    PG8_STAGE(PG8_SB(1, 0), cB + kstep, voffB); PG8_STAGE(PG8_SA(1, 0), cAj + kstep, offA[0]); PG8_STAGE(PG8_SB(1, 1), cB + hstep + kstep, voffB);
    PG8_WAIT_V(6); PG8_BAR;
    for (;;) {
        const bool has_next = S.next(ui + 1, nxt);
        const char* nAj = has_next ? (nxt.job ? S.j1.A : S.j0.A) : cAj; const char* nB = has_next ? S.b_base(nxt) : cB;
        if (has_next) { unsigned offN[2][2]; PG8_ROWOFF(nxt, offN); *(PG8_LAS u32x4*)(lds + STAGE_BYTES + tid * 16) = (u32x4){offN[0][0], offN[0][1], offN[1][0], offN[1][1]}; }
        for (int t = 0; t < nt; t += 2) {
            const bool last = (t == nt - 2);
            const char* a1 = cAj + (size_t)(t + 1) * kstep;
            const char* b2 = last ? nB : cB + (size_t)(t + 2) * kstep; const char* b3 = b2 + kstep;
            PG8_LDB(B0, 0, 0); PG8_LDB(B1, 0, 1); PG8_SCHED; PG8_LDA(At, 0, 0); PG8_STAGE(PG8_SA(1, 1), a1, offA[1]);
            if (last) { if (has_next) { const u32x4 o_ = *(const PG8_LAS u32x4*)(lds + STAGE_BYTES + tid * 16); offA[0][0] = o_[0]; offA[0][1] = o_[1]; offA[1][0] = o_[2]; offA[1][1] = o_[3]; }
                cAj = nAj; }
            const char* a2 = last ? cAj : cAj + (size_t)(t + 2) * kstep; const char* a3 = a2 + kstep;
            PG8_WAIT_V(8); PG8_WAIT_L(0); PG8_BAR; PG8_MMA(0, 0, At, B0); PG8_MMA(0, 1, At, B1); PG8_BAR; PG8_SCHED;
            PG8_LDA(At, 0, 1); PG8_STAGE(PG8_SB(0, 0), b2, voffB); PG8_STAGE(PG8_SB(0, 1), b2 + hstep, voffB); PG8_STAGE(PG8_SA(0, 0), a2, offA[0]);
            PG8_WAIT_V(8); PG8_WAIT_L(0); PG8_BAR; PG8_MMA(1, 0, At, B0); PG8_MMA(1, 1, At, B1); PG8_BAR; PG8_SCHED;
            PG8_LDB(B0, 1, 0); PG8_LDB(B1, 1, 1); PG8_SCHED; PG8_LDA(At, 1, 0); PG8_STAGE(PG8_SA(0, 1), a2, offA[1]);
            PG8_WAIT_V(8); PG8_WAIT_L(0); PG8_BAR; PG8_MMA(0, 0, At, B0); PG8_MMA(0, 1, At, B1); PG8_BAR; PG8_SCHED;
            PG8_LDA(At, 1, 1); PG8_STAGE(PG8_SB(1, 0), b3, voffB); PG8_STAGE(PG8_SB(1, 1), b3 + hstep, voffB); PG8_STAGE(PG8_SA(1, 0), a3, offA[0]);
            PG8_WAIT_V(8); PG8_WAIT_L(0); PG8_BAR; PG8_MMA(1, 0, At, B0); PG8_MMA(1, 1, At, B1); PG8_BAR; PG8_SCHED;
        }
        if (wr == 0) PG8_BAR;
        E(acc, cur, wr, wc, fr, fq);
        if (!has_next) break;
#pragma unroll
        for (int a = 0; a < 2; ++a)
#pragma unroll
            for (int b = 0; b < 2; ++b)
#pragma unroll
                for (int m = 0; m < 4; ++m)
#pragma unroll
                    for (int n = 0; n < 2; ++n) acc[a][b][m][n] = (f32x4){0.f, 0.f, 0.f, 0.f};
        cur = nxt; cB = nB; ++ui;
        if (wr == 1) PG8_BAR;
    }
    PG8_WAIT_V(0);
    PG8_BAR;
#undef PG8_SA
#undef PG8_SB
#undef PG8_STAGE
#undef PG8_LDA
#undef PG8_LDB
#undef PG8_MMA
#undef PG8_WAIT_V
#undef PG8_WAIT_L
#undef PG8_BAR
#undef PG8_SCHED
#undef PG8_ROWOFF
}
}

DI void phase_topk_gather(PC p, int l, unsigned char* lds, int wid_) {
    int tidx = tid_from(wid_), bidx = blockIdx.x; asm volatile("" : "+v"(tidx), "+s"(bidx), "+s"(p));
    unsigned* hist = (unsigned*)lds;
    int* wtot = (int*)(lds + 4096);
    const float* aff = (const float*)(p->ws + WS_AFF);
    int* inv = (int*)(p->ws + WS_INV);
    float* gv = (float*)(p->ws + WS_GV);
    int* rowidx = (int*)(p->ws + WS_ROWIDX);
    const int nprob = (l == 3) ? 128 : 256;
    const int tid = tidx, wv = tid >> 6;
    const int lane = (int)__builtin_amdgcn_mbcnt_hi(~0u, __builtin_amdgcn_mbcnt_lo(~0u, 0u));
    for (int pb = bidx; pb < nprob; pb += gridDim.x) {
        const int s = pb >> 7, b = (pb >> 4) & 7, e = pb & 15;
        const int n = s ? CTXL : SEQ, cap = n >> 3;
        const int row0 = s ? ML + b * CTXL : b * SEQ;
        const bool wvalid = wv * 256 < n;
        const int m0 = row0 + wv * 256 + lane;
        unsigned v[4];
#pragma unroll
        for (int i = 0; i < 4; ++i) v[i] = wvalid ? __float_as_uint(aff[(size_t)(m0 + 64 * i) * NE + e]) : 0u;
        hist[tid] = 0u; hist[tid + 512] = 0u;
        __syncthreads();
        unsigned prefix = 0u; int need = cap;
#pragma unroll
        for (int ps = 0; ps < 4; ++ps) {
            const int shift = 24 - 8 * ps;
            unsigned* h = hist + ps * 256;
            if (wvalid) {
#pragma unroll
                for (int i = 0; i < 4; ++i) {
                    bool in = true;
                    if (ps > 0) in = ((v[i] ^ prefix) >> ((shift + 8) & 31)) == 0u;
                    if (in) atomicAdd(&h[(v[i] >> shift) & 255u], 1u);
                }
            }
            __syncthreads();
            const uint4 c = *(const uint4*)(h + lane * 4);
            const unsigned sl = c.x + c.y + c.z + c.w;
            unsigned S = sl;
#pragma unroll
            for (int d = 1; d < 64; d <<= 1) {
                const unsigned t = (unsigned)__builtin_amdgcn_ds_bpermute(((lane + d) & 63) * 4, (int)S);
                S += (lane + d < 64) ? t : 0u;
            }
            int a = (int)(S - sl), dsel = -1, nneed = 0;
            if (a < need && need <= a + (int)c.w) { dsel = 4 * lane + 3; nneed = need - a; } a += (int)c.w;
            if (a < need && need <= a + (int)c.z) { dsel = 4 * lane + 2; nneed = need - a; } a += (int)c.z;
            if (a < need && need <= a + (int)c.y) { dsel = 4 * lane + 1; nneed = need - a; } a += (int)c.y;
            if (a < need && need <= a + (int)c.x) { dsel = 4 * lane + 0; nneed = need - a; }
            const u64 bm = __ballot(dsel >= 0);
            const int srcl = (int)__builtin_ctzll(bm);
            dsel = __builtin_amdgcn_readlane(dsel, srcl); nneed = __builtin_amdgcn_readlane(nneed, srcl);
            prefix |= (unsigned)dsel << shift; need = nneed;
        }
        const unsigned T = prefix;
        u64 bg[4], bq[4];
        int wg = 0, wq = 0;
#pragma unroll
        for (int i = 0; i < 4; ++i) {
            bg[i] = __ballot(wvalid && v[i] > T); bq[i] = __ballot(wvalid && v[i] == T);
            wg += __builtin_popcountll(bg[i]); wq += __builtin_popcountll(bq[i]);
        }
        if (lane == 0) { wtot[wv * 2] = wg; wtot[wv * 2 + 1] = wq; }
        __syncthreads();
        int base_g = 0, base_q = 0, tot_g = 0;
#pragma unroll
        for (int w = 0; w < 8; ++w) {
            const int g_ = wtot[2 * w], q_ = wtot[2 * w + 1];
            tot_g += g_;
            if (w < wv) { base_g += g_; base_q += q_; }
        }
        const int pbase = s ? NE * NB * CAPL + e * NB * CAPC + b * CAPC : e * NB * CAPL + b * CAPL;
        if (wvalid) {
#pragma unroll
            for (int i = 0; i < 4; ++i) {
                const int m = m0 + 64 * i;
                int slot = -1;
                if (v[i] > T) slot = base_g + (int)__builtin_amdgcn_mbcnt_hi((unsigned)(bg[i] >> 32), __builtin_amdgcn_mbcnt_lo((unsigned)bg[i], 0u));
                else if (v[i] == T) {
                    const int r = base_q + (int)__builtin_amdgcn_mbcnt_hi((unsigned)(bq[i] >> 32), __builtin_amdgcn_mbcnt_lo((unsigned)bq[i], 0u));
                    if (r < need) slot = tot_g + r;
                }
                base_g += __builtin_popcountll(bg[i]); base_q += __builtin_popcountll(bq[i]);
                if (slot >= 0) { gv[pbase + slot] = __uint_as_float(v[i]); rowidx[pbase + slot] = m; inv[m * NE + e] = pbase + slot; }
                else inv[m * NE + e] = -1;
            }
        }
        __syncthreads();
    }
}
DI float fsig(float x) { return __builtin_amdgcn_rcpf(1.0f + __builtin_amdgcn_exp2f(-LOG2E * x)); }
DI f32x2 pk_fma(f32x2 a, f32x2 b, f32x2 c) { return __builtin_elementwise_fma(a, b, c); }
DI f32x2 pk_mul(f32x2 a, f32x2 b) { return a * b; }
DI f32x2 pk_add(f32x2 a, f32x2 b) { return a + b; }
DI f32x2 pk_one_minus_sq(f32x2 a, f32x2 one) { return __builtin_elementwise_fma(-a, a, one); }
DI void lru_ab_fast(float tr, float ti, float c8l, float xb, float& a, float& bb, float& la2) {
    const float r = __builtin_amdgcn_rcpf(1.0f + __builtin_amdgcn_exp2f(tr)), ig = __builtin_amdgcn_rcpf(1.0f + __builtin_amdgcn_exp2f(ti));
    la2 = c8l * r;
    a = __builtin_amdgcn_exp2f(la2);
    const float om = fmaxf(__builtin_fmaf(-a, a, 1.0f), 0.0f);
    bb = __builtin_amdgcn_sqrtf(om) * (ig * xb);
}
template <int MODE> DI void phase_lru1(PC p, int j, unsigned char* lds, int wid_) {
    int tidx = tid_from(wid_), bidx = blockIdx.x; asm volatile("" : "+v"(tidx), "+s"(bidx), "+s"(p));
    constexpr int XBS = 136;
    h16* XB = (h16*)lds;
    const int tid = tidx, lane = tid & 63, wv = tid >> 6, d = wv >> 2, w4 = wv & 3;
    unsigned* stg = (unsigned*)(lds + 17408) + wv * 512;
    const int blk = bidx & 7, nslot = gridDim.x >> 3;
    if (bidx >= nslot * 8) return;
    const h16* xr = (const h16*)(p->ws + WS_UB) + (size_t)MT * D;
    f32x2* agg = (f32x2*)(p->ws + WS_AGG);
    unsigned* ab16 = (unsigned*)(p->ws + WS_CSCR) + (size_t)d * MT * D + blk * 128 + 32 * w4 + (lane & 3) * 8;
    const h16* GT = (const h16*)(p->ws + W_GATE16) + (size_t)((j * 2 + d) * 8 + blk) * 256 * 128;
    h16x8 Bf[2][2][4];
#pragma unroll
    for (int ct = 0; ct < 2; ++ct)
#pragma unroll
        for (int g = 0; g < 2; ++g)
#pragma unroll
            for (int ks = 0; ks < 4; ++ks) Bf[ct][g][ks] = *(const h16x8*)(GT + (size_t)(g * 128 + 32 * w4 + 16 * ct + (lane & 15)) * 128 + ks * 32 + 8 * (lane >> 4));
    float gbr[2], gbi[2], c8[2];
    f32x2 nl2 = {-LOG2E, -LOG2E}, one2 = {1.0f, 1.0f}, k1024 = {1024.0f, 1024.0f};
    asm volatile("" : "+v"(nl2), "+v"(one2), "+v"(k1024));
#pragma unroll
    for (int ct = 0; ct < 2; ++ct) { const int chl = 32 * w4 + 16 * ct + (lane & 15);
        gbr[ct] = -LOG2E * p->lru_gate_b[((j * 2 + d) * 8 + blk) * 256 + chl]; gbi[ct] = -LOG2E * p->lru_gate_b[((j * 2 + d) * 8 + blk) * 256 + 128 + chl];
        c8[ct] = LOG2E * logsig8(p->lru_lambda[(j * 2 + d) * D + blk * 128 + chl]); }
    const float* cw = p->lru_conv_w + (size_t)j * 4 * D + blk * 128; const float* cb = p->lru_conv_b + (size_t)j * D + blk * 128;
    const bool rev = d != 0;
    const bool first16 = rev ? ((lane >> 4) & 1) != 0 : ((lane >> 4) & 1) == 0;
    const bool first32 = rev ? (lane >> 5) != 0 : (lane >> 5) == 0;
    const int c0 = (tid & 15) * 8, tl0 = tid >> 4;
    h16x8 pre[2][4];
#define LRU_ROWS(q_, row0_, t0_, ns_) const int b_##q_ = (q_) / 36, c_##q_ = (q_) % 36; \
        const int row0_ = c_##q_ < 4 ? ML + b_##q_ * CTXL + c_##q_ * 64 : b_##q_ * SEQ + (c_##q_ - 4) * 64, t0_ = c_##q_ < 4 ? c_##q_ * 64 : (c_##q_ - 4) * 64, ns_ = c_##q_ < 4 ? CTXL : SEQ;
#define LRU_CONV_LOAD(row0_, t0_, ns_) { _Pragma("unroll") for (int rep = 0; rep < 2; ++rep) _Pragma("unroll") for (int k = 0; k < 4; ++k) { \
            const int tl = tl0 + 32 * rep, tt = (t0_) + tl + k - 1; \
            pre[rep][k] = (tt >= 0 && tt < (ns_)) ? *(const h16x8*)(xr + (size_t)((row0_) + tl + k - 1) * D + blk * 128 + c0) : (h16x8){0, 0, 0, 0, 0, 0, 0, 0}; } }
#define LRU_CONV_STORE() { _Pragma("unroll") for (int rep = 0; rep < 2; ++rep) { float acc[8]; \
            { const f32x4 b0 = *(const f32x4*)(cb + c0), b1 = *(const f32x4*)(cb + c0 + 4); acc[0] = b0[0]; acc[1] = b0[1]; acc[2] = b0[2]; acc[3] = b0[3]; acc[4] = b1[0]; acc[5] = b1[1]; acc[6] = b1[2]; acc[7] = b1[3]; } \
            _Pragma("unroll") for (int k = 0; k < 4; ++k) { const f32x4 w0 = *(const f32x4*)(cw + k * D + c0), w1 = *(const f32x4*)(cw + k * D + c0 + 4); \
                _Pragma("unroll") for (int e = 0; e < 4; ++e) { acc[e] += w0[e] * (float)pre[rep][k][e]; acc[4 + e] += w1[e] * (float)pre[rep][k][4 + e]; } } \
            h16x8 o; _Pragma("unroll") for (int e = 0; e < 8; ++e) o[e] = (h16)acc[e]; \
            *(h16x8*)(XB + (tl0 + 32 * rep) * XBS + c0) = o; } }
    int q = bidx >> 3;
    if (q < NB * 36) { LRU_ROWS(q, r0a, t0a, nsa) LRU_CONV_LOAD(r0a, t0a, nsa) LRU_CONV_STORE() }
    for (; q < NB * 36; q += nslot) {
        const int b = q / 36, c = q % 36;
        const int row0 = c < 4 ? ML + b * CTXL + c * 64 : b * SEQ + (c - 4) * 64;
        __syncthreads();
        const int qn = q + nslot; const bool hasn = qn < NB * 36;
        if (hasn) { LRU_ROWS(qn, r0n, t0n, nsn) LRU_CONV_LOAD(r0n, t0n, nsn) }
        float Ac[2] = {1.f, 1.f}, Hc[2] = {0.f, 0.f};
#pragma unroll 1
        for (int k = 0; k < 4; ++k) {
            const int sc = rev ? 3 - k : k;
            f32x4 acc[2][2];
#pragma unroll
            for (int ct = 0; ct < 2; ++ct)
#pragma unroll
                for (int g = 0; g < 2; ++g) acc[ct][g] = (f32x4){0.f, 0.f, 0.f, 0.f};
#pragma unroll
            for (int ks = 0; ks < 4; ++ks) {
                const h16x8 af = *(const h16x8*)(XB + (sc * 16 + (lane & 15)) * XBS + ks * 32 + 8 * (lane >> 4));
#pragma unroll
                for (int ct = 0; ct < 2; ++ct)
#pragma unroll
                    for (int g = 0; g < 2; ++g) acc[ct][g] = __builtin_amdgcn_mfma_f32_16x16x32_f16(af, Bf[ct][g][ks], acc[ct][g], 0, 0, 0);
            }
#pragma unroll
            for (int ct = 0; ct < 2; ++ct) { const int chl = 32 * w4 + 16 * ct + (lane & 15);
                float av[4], bv[4];
                {
                    const f32x2 gbr2 = {gbr[ct], gbr[ct]}, gbi2 = {gbi[ct], gbi[ct]}, c82 = {c8[ct], c8[ct]};
#pragma unroll
                    for (int h = 0; h < 2; ++h) {
                        const f32x2 ar = {acc[ct][0][2 * h], acc[ct][0][2 * h + 1]}, ai = {acc[ct][1][2 * h], acc[ct][1][2 * h + 1]};
                        const f32x2 tr = pk_fma(ar, nl2, gbr2), ti = pk_fma(ai, nl2, gbi2);
                        const f32x2 er = {__builtin_amdgcn_exp2f(tr[0]), __builtin_amdgcn_exp2f(tr[1])}, ei = {__builtin_amdgcn_exp2f(ti[0]), __builtin_amdgcn_exp2f(ti[1])};
                        const f32x2 dr = pk_add(er, one2), di = pk_add(ei, one2);
                        const f32x2 rr = {__builtin_amdgcn_rcpf(dr[0]), __builtin_amdgcn_rcpf(dr[1])}, ig = {__builtin_amdgcn_rcpf(di[0]), __builtin_amdgcn_rcpf(di[1])};
                        const f32x2 la = pk_mul(rr, c82);
                        const f32x2 a2 = {__builtin_amdgcn_exp2f(la[0]), __builtin_amdgcn_exp2f(la[1])};
                        const f32x2 om = pk_one_minus_sq(a2, one2);
                        const f32x2 sq = {__builtin_amdgcn_sqrtf(__builtin_fabsf(om[0])), __builtin_amdgcn_sqrtf(__builtin_fabsf(om[1]))};
                        const int tk = 4 * (lane >> 4) + 2 * h;
                        const f32x2 xb2 = {(float)XB[(sc * 16 + tk) * XBS + chl], (float)XB[(sc * 16 + tk + 1) * XBS + chl]};
                        const f32x2 bb = pk_mul(sq, pk_mul(ig, xb2)), lk = pk_mul(la, k1024);
#pragma unroll
                        for (int e = 0; e < 2; ++e) { const h16x2 pk = {(h16)lk[e], (h16)bb[e]};
                            stg[(tk + e) * 32 + 16 * ct + (lane & 15)] = __builtin_bit_cast(unsigned, pk); av[2 * h + e] = a2[e]; bv[2 * h + e] = bb[e]; }
                    }
                }
                float A, H;
                if (!rev) { A = av[0]; H = bv[0];
#pragma unroll
                    for (int r = 1; r < 4; ++r) { H = av[r] * H + bv[r]; A *= av[r]; } }
                else { A = av[3]; H = bv[3];
#pragma unroll
                    for (int r = 2; r >= 0; --r) { H = av[r] * H + bv[r]; A *= av[r]; } }
                { const float Ao = shx(A, 16, lane), Ho = shx(H, 16, lane); const float Hn = first16 ? Ao * H + Ho : A * Ho + H; A *= Ao; H = Hn; }
                { const float Ao = shx(A, 32, lane), Ho = shx(H, 32, lane); const float Hn = first32 ? Ao * H + Ho : A * Ho + H; A *= Ao; H = Hn; }
                Hc[ct] = A * Hc[ct] + H; Ac[ct] *= A;
            }
            asm volatile("s_waitcnt lgkmcnt(0)" ::: "memory"); __builtin_amdgcn_wave_barrier();
            { const int tk = lane >> 2; const u32x4 s0 = *(const u32x4*)(stg + tk * 32 + (lane & 3) * 8), s1 = *(const u32x4*)(stg + tk * 32 + (lane & 3) * 8 + 4);
              unsigned* dst = ab16 + (size_t)(row0 + sc * 16 + tk) * D; *(u32x4*)dst = s0; *(u32x4*)(dst + 4) = s1; }
            asm volatile("s_waitcnt lgkmcnt(0)" ::: "memory"); __builtin_amdgcn_wave_barrier();
        }
        if ((lane >> 4) == 0) {
#pragma unroll
            for (int ct = 0; ct < 2; ++ct) agg[(size_t)((b * 2 + d) * 36 + c) * D + blk * 128 + 32 * w4 + 16 * ct + (lane & 15)] = (f32x2){Ac[ct], Hc[ct]};
        }
        __syncthreads();
        if (hasn) LRU_CONV_STORE()
    }
#undef LRU_ROWS
#undef LRU_CONV_LOAD
#undef LRU_CONV_STORE
}

DI void phase_lru2(PC p, unsigned char* lds, int wid_) {
    int tidx = tid_from(wid_), bidx = blockIdx.x; asm volatile("" : "+v"(tidx), "+s"(bidx), "+s"(p));
    const int tid = tidx, half = tid >> 8, t8 = tid & 255, sd = t8 >> 7, sch = t8 & 127;
    float* SH = (float*)lds + (size_t)half * (2 * 64 * 128);
    const int blk = bidx & 7, nslot = gridDim.x >> 3;
    if (bidx >= nslot * 8) return;
    const unsigned* ab = (const unsigned*)(p->ws + WS_CSCR);
    const float* carry = (const float*)(p->ws + WS_AGG + 4608 * 1024);
    const h16* yg = (const h16*)(p->ws + WS_UB);
    h16* sy = (h16*)(p->ws + WS_SYB);
    for (int q0 = bidx >> 3; q0 < NB * 36; q0 += 2 * nslot) {
        const int q = q0 + half * nslot; const bool live = q < NB * 36;
        const int qq = live ? q : q0, b = qq / 36, c = qq % 36;
        const int row0 = c < 4 ? ML + b * CTXL + c * 64 : b * SEQ + (c - 4) * 64;
        const unsigned* src = ab + (size_t)sd * MT * D + (size_t)row0 * D + blk * 128 + sch;
        unsigned pk[64];
#pragma unroll
        for (int t = 0; t < 64; ++t) pk[t] = src[(size_t)(sd == 0 ? t : 63 - t) * D];
        h16x8 ygv[4];
#pragma unroll
        for (int rep = 0; rep < 4; ++rep) { const int idx = t8 + rep * 256; ygv[rep] = *(const h16x8*)(yg + (size_t)(row0 + (idx >> 4)) * D + blk * 128 + (idx & 15) * 8); }
        float h = carry[(size_t)((b * 2 + sd) * 36 + c) * D + blk * 128 + sch];
        float* sw = SH + (size_t)sd * 64 * 128 + sch;
#pragma unroll
        for (int t = 0; t < 64; ++t) { const h16x2 v = __builtin_bit_cast(h16x2, pk[t]); const float a = __builtin_amdgcn_exp2f((float)v[0] * (1.0f / 1024.0f));
            h = a * h + (float)v[1]; sw[(sd == 0 ? t : 63 - t) * 128] = h; }
        __syncthreads();
        if (live) {
#pragma unroll
            for (int rep = 0; rep < 4; ++rep) {
                const int idx = t8 + rep * 256, tl = idx >> 4, c0 = (idx & 15) * 8;
                const h16x8 yv = ygv[rep];
                const float* s0p = SH + tl * 128 + c0; const float* s1p = s0p + 64 * 128;
                const f32x4 f0 = *(const f32x4*)s0p, f1 = *(const f32x4*)(s0p + 4), r0 = *(const f32x4*)s1p, r1 = *(const f32x4*)(s1p + 4);
                h16x8 o;
#pragma unroll
                for (int e = 0; e < 4; ++e) { o[e] = (h16)((f0[e] + r0[e]) * (float)yv[e]); o[4 + e] = (h16)((f1[e] + r1[e]) * (float)yv[4 + e]); }
                *(h16x8*)(sy + (size_t)(row0 + tl) * D + blk * 128 + c0) = o;
            }
        }
        __syncthreads();
    }
}

DI void phase_lru_carry(PC p, int wid_) {
    int tidx = tid_from(wid_), bidx = blockIdx.x; asm volatile("" : "+v"(tidx), "+s"(bidx), "+s"(p));
    const int gt = bidx * NT + tidx;
    if (gt >= NB * 2 * D) return;
    const int b = gt >> 11, d = (gt >> 10) & 1, ch = gt & 1023;
    const f32x2* ag = (const f32x2*)(p->ws + WS_AGG) + (size_t)((b * 2 + d) * 36) * D + ch;
    float* cr = (float*)(p->ws + WS_AGG + 4608 * 1024) + (size_t)((b * 2 + d) * 36) * D + ch;
    f32x2 v[36];
#pragma unroll
    for (int s2 = 0; s2 < 36; ++s2) { const int cc = d == 0 ? s2 : (s2 < 4 ? 3 - s2 : 39 - s2); v[s2] = ag[(size_t)cc * D]; }
    float h = 0.f;
#pragma unroll
    for (int s2 = 0; s2 < 36; ++s2) { const int cc = d == 0 ? s2 : (s2 < 4 ? 3 - s2 : 39 - s2); cr[(size_t)cc * D] = h; h = v[s2][0] * h + v[s2][1]; }
}

typedef float f32x16 __attribute__((ext_vector_type(16)));
typedef short s16x4 __attribute__((ext_vector_type(4)));
DI h16x4 vtr4(const __attribute__((address_space(3))) unsigned char* ptr) {
    return __builtin_bit_cast(h16x4, __builtin_amdgcn_ds_read_tr16_b64_v4i16((__attribute__((address_space(3))) s16x4*)ptr));
}
DI void phase_attn(PC p, int l, unsigned char* lds, int wid_) {
    int tidx = tid_from(wid_), bidx = blockIdx.x; asm volatile("" : "+v"(tidx), "+s"(bidx), "+s"(p));
    constexpr int KS = 272, VS = 320, KBUF = 64 * KS, VBUF = 64 * VS;
    typedef __attribute__((address_space(3))) unsigned char lds_t;
    lds_t* Kl = (lds_t*)lds; lds_t* Vl = Kl + 2 * KBUF;
    const int tid = tidx, lane = tid & 63, wv = tid >> 6, g = wv >> 1, th = wv & 1, r32 = lane & 31, hi = lane >> 5;
    const h16* qkv = (const h16*)(p->ws + WS_UB);
    h16* o = (h16*)(p->ws + WS_SYB);
    const int j = l >> 1;
    const int nitems = 512 + (l == 3 ? 0 : 64);
    const int srow = tid >> 3, sc = tid & 7;
    const int vtoff = (4 * hi + ((lane & 15) >> 2)) * VS + (16 * ((lane >> 4) & 1) + 4 * (lane & 3)) * 2;
    for (int it = bidx; it < nitems; it += gridDim.x) {
        int b, kvh, q0 = 0, qrow0, jlo = 0, nband = 0;
        if (it < 512) { b = it >> 6; kvh = (it >> 5) & 1; q0 = (it & 31) * 64; qrow0 = b * SEQ + q0;
            jlo = q0 == 0 ? 2 : (q0 == 64 ? 1 : 0); const int jhi = q0 == SEQ - 64 ? 2 : (q0 == SEQ - 128 ? 3 : 4); nband = jhi - jlo + 1; }
        else { const int r = it - 512; b = r >> 3; kvh = (r >> 2) & 1; qrow0 = ML + b * CTXL + (r & 3) * 64; }
        const int nt = nband + 4, hq = kvh * 4 + g, qi = 32 * th + r32;
        const int bandrow0 = b * SEQ + q0 - 128 + 64 * jlo, ctxrow0 = ML + b * CTXL;
        h16x8 qf[8];
        { const h16* qp = qkv + (size_t)(qrow0 + qi) * QKVW + hq * HD + 8 * hi;
#pragma unroll
          for (int ks = 0; ks < 8; ++ks) qf[ks] = *(const h16x8*)(qp + 16 * ks); }
        float m = p->attn_sink[j * NH + hq] * LOG2E, lsum = hi == 0 ? 1.0f : 0.0f;
        f32x16 O[4];
#pragma unroll
        for (int dt = 0; dt < 4; ++dt)
#pragma unroll
            for (int r = 0; r < 16; ++r) O[dt][r] = 0.f;
        u32x4 st[4];
        { const int krow = (nband > 0 ? bandrow0 : ctxrow0) + srow; const h16* kp = qkv + (size_t)krow * QKVW + 1024 + kvh * HD + sc * 8;
          st[0] = *(const u32x4*)kp; st[1] = *(const u32x4*)(kp + 64); st[2] = *(const u32x4*)(kp + 256); st[3] = *(const u32x4*)(kp + 256 + 64); }
        *(__attribute__((address_space(3))) u32x4*)(Kl + srow * KS + sc * 16) = st[0]; *(__attribute__((address_space(3))) u32x4*)(Kl + srow * KS + sc * 16 + 128) = st[1];
        *(__attribute__((address_space(3))) u32x4*)(Vl + srow * VS + sc * 16) = st[2]; *(__attribute__((address_space(3))) u32x4*)(Vl + srow * VS + sc * 16 + 128) = st[3];
        __syncthreads();
        asm volatile("" : "+v"(qf[0]), "+v"(qf[1]), "+v"(qf[2]), "+v"(qf[3]), "+v"(qf[4]), "+v"(qf[5]), "+v"(qf[6]), "+v"(qf[7]));
#pragma unroll 1
        for (int i = 0; i < nt; ++i) {
            const int buf = i & 1;
            if (i + 1 < nt) { const int krow = (i + 1 < nband ? bandrow0 + 64 * (i + 1) : ctxrow0 + 64 * (i + 1 - nband)) + srow; const h16* kp = qkv + (size_t)krow * QKVW + 1024 + kvh * HD + sc * 8;
                st[0] = *(const u32x4*)kp; st[1] = *(const u32x4*)(kp + 64); st[2] = *(const u32x4*)(kp + 256); st[3] = *(const u32x4*)(kp + 256 + 64); }
            const lds_t* Kb = Kl + buf * KBUF; const lds_t* Vb = Vl + buf * VBUF;
            f32x16 s0, s1;
#pragma unroll
            for (int r = 0; r < 16; ++r) { s0[r] = 0.f; s1[r] = 0.f; }
            {
#define AT_KLOAD(dst, kq) { _Pragma("unroll") for (int u_ = 0; u_ < 2; ++u_) { \
                    dst[2 * u_] = *(const __attribute__((address_space(3))) h16x8*)(Kb + r32 * KS + (16 * (2 * (kq) + u_) + 8 * hi) * 2); \
                    dst[2 * u_ + 1] = *(const __attribute__((address_space(3))) h16x8*)(Kb + (32 + r32) * KS + (16 * (2 * (kq) + u_) + 8 * hi) * 2); } }
#define AT_KMMA(src, kq) { _Pragma("unroll") for (int u_ = 0; u_ < 2; ++u_) { \
                    s0 = __builtin_amdgcn_mfma_f32_32x32x16_f16(src[2 * u_], qf[2 * (kq) + u_], s0, 0, 0, 0); \
                    s1 = __builtin_amdgcn_mfma_f32_32x32x16_f16(src[2 * u_ + 1], qf[2 * (kq) + u_], s1, 0, 0, 0); } }
                h16x8 ka[4], kb[4];
                AT_KLOAD(ka, 0) AT_KLOAD(kb, 1)
                __builtin_amdgcn_sched_barrier(0);
                AT_KMMA(ka, 0) AT_KLOAD(ka, 2)
                __builtin_amdgcn_sched_barrier(0);
                AT_KMMA(kb, 1) AT_KLOAD(kb, 3)
                __builtin_amdgcn_sched_barrier(0);
                AT_KMMA(ka, 2) AT_KMMA(kb, 3)
#undef AT_KLOAD
#undef AT_KMMA
            }
            if (i < nband) { const int jt = jlo + i;
                if (jt == 0) {
#pragma unroll
                    for (int r = 0; r < 16; ++r) { const int kv = (r & 3) + 8 * (r >> 2) + 4 * hi; if (kv < qi) s0[r] = -1e30f; if (kv + 32 < qi) s1[r] = -1e30f; } }
                else if (jt == 4) {
#pragma unroll
                    for (int r = 0; r < 16; ++r) { const int kv = (r & 3) + 8 * (r >> 2) + 4 * hi; if (kv > qi) s0[r] = -1e30f; if (kv + 32 > qi) s1[r] = -1e30f; } }
            }
            float mx = fmaxf(s0[0], s1[0]);
#pragma unroll
            for (int r = 1; r < 16; ++r) mx = fmaxf(mx, fmaxf(s0[r], s1[r]));
            mx = fmaxf(mx, shx(mx, 32, lane));
            const float mnew = fmaxf(m, mx), alpha = __builtin_amdgcn_exp2f(m - mnew);
            m = mnew;
            float rs = 0.f;
#pragma unroll
            for (int r = 0; r < 16; ++r) { s0[r] = __builtin_amdgcn_exp2f(s0[r] - mnew); s1[r] = __builtin_amdgcn_exp2f(s1[r] - mnew); rs += s0[r] + s1[r]; }
            lsum = lsum * alpha + rs;
            if (!__all(alpha == 1.0f)) {
#pragma unroll
                for (int dt = 0; dt < 4; ++dt)
#pragma unroll
                    for (int r = 0; r < 16; ++r) O[dt][r] *= alpha;
            }
            h16x8 pf[2][2];
#pragma unroll
            for (int s2 = 0; s2 < 2; ++s2)
#pragma unroll
                for (int e = 0; e < 8; ++e) { pf[0][s2][e] = (h16)s0[8 * s2 + e]; pf[1][s2][e] = (h16)s1[8 * s2 + e]; }
            {
#define AT_VLOAD(dst, q4) { _Pragma("unroll") for (int dt = 0; dt < 4; ++dt) { const lds_t* vp = Vb + vtoff + (16 * (q4)) * VS + 64 * dt; dst[dt][0] = vtr4(vp); dst[dt][1] = vtr4(vp + 8 * VS); } }
#define AT_VMMA(src, q4) { _Pragma("unroll") for (int dt = 0; dt < 4; ++dt) { const h16x4 v0 = src[dt][0], v1 = src[dt][1]; \
                    const h16x8 va = {v0[0], v0[1], v0[2], v0[3], v1[0], v1[1], v1[2], v1[3]}; \
                    O[dt] = __builtin_amdgcn_mfma_f32_32x32x16_f16(va, pf[(q4) >> 1][(q4) & 1], O[dt], 0, 0, 0); } }
                h16x4 vf[4][2], vg[4][2];
                AT_VLOAD(vf, 0) AT_VLOAD(vg, 1)
                __builtin_amdgcn_sched_barrier(0);
                AT_VMMA(vf, 0) AT_VLOAD(vf, 2)
                __builtin_amdgcn_sched_barrier(0);
                AT_VMMA(vg, 1) AT_VLOAD(vg, 3)
                __builtin_amdgcn_sched_barrier(0);
                AT_VMMA(vf, 2) AT_VMMA(vg, 3)
#undef AT_VLOAD
#undef AT_VMMA
            }
            if (i + 1 < nt) { const int nb = buf ^ 1;
                *(__attribute__((address_space(3))) u32x4*)(Kl + nb * KBUF + srow * KS + sc * 16) = st[0]; *(__attribute__((address_space(3))) u32x4*)(Kl + nb * KBUF + srow * KS + sc * 16 + 128) = st[1];
                *(__attribute__((address_space(3))) u32x4*)(Vl + nb * VBUF + srow * VS + sc * 16) = st[2]; *(__attribute__((address_space(3))) u32x4*)(Vl + nb * VBUF + srow * VS + sc * 16 + 128) = st[3]; }
            __syncthreads();
        }
        const float ltot = lsum + shx(lsum, 32, lane), inv = 1.0f / ltot;
        h16* op = o + (size_t)(qrow0 + qi) * D + hq * HD + 4 * hi;
#pragma unroll
        for (int dt = 0; dt < 4; ++dt)
#pragma unroll
            for (int rq = 0; rq < 4; ++rq) {
                const h16x4 ov = {(h16)(O[dt][4 * rq] * inv), (h16)(O[dt][4 * rq + 1] * inv), (h16)(O[dt][4 * rq + 2] * inv), (h16)(O[dt][4 * rq + 3] * inv)};
                *(h16x4*)(op + 32 * dt + 8 * rq) = ov;
            }
    }
}

#define LAS __attribute__((address_space(3)))
#define XB_TMO      128
#define XB_XCNT(j)  (256  + 64 * (j))
#define XB_XSUB(j)  (1280 + 64 * (j))
#define XB_XGEN(j)  (2304 + 64 * (j))
#define XB_TOP      3328
#define XB_TOPGEN   3392
#define XCD_BAR_WORDS 3456
#define XB_SPIN_CAP (1u << 22)
DI unsigned xb_ld(unsigned* p)              { return __hip_atomic_load(p, __ATOMIC_RELAXED, __HIP_MEMORY_SCOPE_AGENT); }
DI unsigned xb_add(unsigned* p, unsigned v) { return __hip_atomic_fetch_add(p, v, __ATOMIC_RELAXED, __HIP_MEMORY_SCOPE_AGENT); }
DI unsigned xb_xcc_id() { return (unsigned)__builtin_amdgcn_s_getreg((3 << 11) | 20) & 0xFu; }
#define XB_SPIN(cond, bar) do { unsigned _sp = 0; while (cond) { __builtin_amdgcn_s_sleep(1); \
    if ((++_sp & 255u) == 0u) { if (xb_ld(&(bar)[XB_TMO])) break; if (_sp > XB_SPIN_CAP) { atomicAdd(&(bar)[XB_TMO], 1u); break; } } } } while (0)
struct XcdBarrier { unsigned* bar; unsigned x; volatile LAS unsigned* st; };
DI XcdBarrier xcd_barrier_post(unsigned* bar, volatile LAS unsigned* st) {
    XcdBarrier b; b.bar = bar; b.x = xb_xcc_id(); b.st = st;
    if (threadIdx.x == 0) (void)xb_add(&bar[XB_XCNT(b.x)], 1u);
    return b;
}
DI void xcd_barrier_complete(unsigned* bar, unsigned x, unsigned& nloc, unsigned& nx) {
    const unsigned G = gridDim.x * gridDim.y * gridDim.z;
    unsigned sum, cnt, mine, sp = 0u;
    for (;;) {
        sum = 0u; cnt = 0u; mine = 0u;
#pragma unroll
        for (unsigned j = 0; j < 16; ++j) { const unsigned c = xb_ld(&bar[XB_XCNT(j)]); sum += c; cnt += (c > 0u) ? 1u : 0u; mine = (j == x) ? c : mine; }
        if (sum == G) break;
        __builtin_amdgcn_s_sleep(1);
        if ((++sp & 255u) == 0u) { if (xb_ld(&bar[XB_TMO])) break; if (sp > XB_SPIN_CAP) { atomicAdd(&bar[XB_TMO], 1u); break; } }
    }
    nloc = mine > 0u ? mine : 1u; nx = cnt > 0u ? cnt : 1u;
}
DI void xcd_barrier(const XcdBarrier& b, int wid_) {
    asm volatile("s_waitcnt vmcnt(0)" ::: "memory");
    __syncthreads();
    if (tid_from(wid_) == 0) {
        unsigned* bar = b.bar;
        __builtin_amdgcn_s_waitcnt(0);
        unsigned nloc = b.st[0], nx = b.st[1];
        if (nloc == 0u) { xcd_barrier_complete(bar, b.x, nloc, nx); b.st[0] = nloc; b.st[1] = nx; }
        const unsigned old = xb_add(&bar[XB_XSUB(b.x)], 1u);
        const unsigned gen = old / nloc;
        if (old + 1u == (gen + 1u) * nloc) {
            __builtin_amdgcn_fence(__ATOMIC_RELEASE, "agent");
            asm volatile("s_waitcnt vmcnt(0)" ::: "memory");
            const unsigned og = xb_add(&bar[XB_TOP], 1u);
            const unsigned tg = og / nx;
            if (og + 1u == (tg + 1u) * nx) xb_add(&bar[XB_TOPGEN], 1u);
            else XB_SPIN(xb_ld(&bar[XB_TOPGEN]) == tg, bar);
            __builtin_amdgcn_fence(__ATOMIC_ACQUIRE, "agent");
            xb_add(&bar[XB_XGEN(b.x)], 1u);
            asm volatile("s_waitcnt vmcnt(0)" ::: "memory");
        } else {
            XB_SPIN(xb_ld(&bar[XB_XGEN(b.x)]) == gen, bar);
            __builtin_amdgcn_fence(__ATOMIC_ACQUIRE, "agent");
            asm volatile("s_waitcnt vmcnt(0)" ::: "memory");
        }
    }
    __syncthreads();
}
constexpr int CW_BAR = 4096;
constexpr int MISC_OFF = 147456 - 256;

#ifndef DUP_MASK
#define DUP_MASK 0
#endif
#define BAR(kind) xcd_barrier(bar, wid_)
#define REP(kind) for (int rep_ = 0; rep_ < (((DUP_MASK) >> (kind)) & 1) + 1; ++rep_)
template <int l> DI void run_layers(PC p, unsigned char* lds, const XcdBarrier& bar, int wid_) {
    const h16* hb = (const h16*)(p->ws + WS_HB);
    LAS unsigned char* l3 = (LAS unsigned char*)lds;
    const int G = gridDim.x, bid = blockIdx.x;
    const float* modp = (const float*)(p->ws + WS_MOD);
    {
        const int j = l >> 1;
        const pg8::Job nojob{0, 1, 0, 0, nullptr, nullptr, 0};
        if ((l & 1) == 0) {
            REP(2) { pg8::Sched S; S.init(pg8::Job{MT / 256, 8, 0, 0, (const char*)hb, (const char*)(p->ws + W_IN_T + (size_t)j * 2048 * D * 2), 0}, nojob, G, bid, D);
              pg8::EpiLruIn E{(h16*)(p->ws + WS_UB), (h16*)(p->ws + WS_UB) + (size_t)MT * D}; pg8::gemm_phase(l3, S, E, wid_);
              if (!rep_ && bid >= 64) conv_fill(p, lds, l, cv_p(l) + cv_prev(l) + (bid - 64) * FQ_A, FQ_A, wid_); BAR(2); }
#ifdef LRU_ABL
            phase_lru1<LRU_ABL>(p, j, lds, wid_); BAR(3);
#endif
            REP(3) { phase_lru1<0>(p, j, lds, wid_); BAR(3); phase_lru_carry(p, wid_); BAR(3); }
            REP(4) { phase_lru2(p, lds, wid_); BAR(4); }
        } else {
            REP(6) { pg8::Sched S; S.init(pg8::Job{MT / 256, 6, 0, 0, (const char*)hb, (const char*)(p->ws + W_QKV_T + (size_t)j * QKVW * D * 2), 0}, nojob, G, bid, D);
              pg8::EpiQKV E{(h16*)(p->ws + WS_UB), (const f32x2*)(p->ws + WS_ROPE)}; pg8::gemm_phase(l3, S, E, wid_);
              if (!rep_ && bid >= 176) conv_fill(p, lds, l, cv_p(l) + cv_prev(l) + (bid - 176) * FQ_A, FQ_A, wid_); BAR(6); }
            REP(7) { phase_attn(p, l, lds, wid_);
              if (!rep_ && l != DEPTH - 1 && bid >= 64) conv_fill(p, lds, l, cv_p(l) + cv_prev(l) + SEG_A_ATT + (bid - 64) * FQ_AT, FQ_AT, wid_); BAR(7); }
        }
        REP(5) {
#pragma unroll 1
            for (int part = 0; part < 3; ++part) {
                if (part == 2 && l == DEPTH - 1) break;
                const bool ctxp = (l < DEPTH - 1);
                const int gG = part == 0 ? G : (part == 1 && ctxp ? (G < 32 ? G : 32) : 0);
                const int gnM = part == 0 ? ML / 256 : (part == 1 && ctxp ? MC / 256 : 0), gpm0 = part == 0 ? 0 : ML / 256;
                if (gnM > 0 && bid < gG) {
                    pg8::Sched S; S.init(pg8::Job{gnM, 4, gpm0, 0, (const char*)(p->ws + WS_SYB), (const char*)(p->ws + ((l & 1) ? W_O_T : W_OUT_T) + (size_t)j * D * D * 2), 0}, nojob, gG, bid, D);
                    pg8::EpiResid E{(h16*)(p->ws + (rep_ ? WS_CSCR : WS_XRES)), modp + (size_t)l * 9 * 6144 + 2048}; pg8::gemm_phase(l3, S, E, wid_);
                } else if (part > 0 && !rep_) {
                    const int cu_lo = (part == 1 && ctxp) ? gG : 0;
                    phase_norm2(p, l, lds, cu_lo, G - cu_lo, part == 1 ? 0 : ML, part == 1 ? ML : MT, wid_);
                }
                BAR(5);
            }
        }
        REP(10) { phase_topk_gather(p, l, lds, wid_);
            if (!rep_ && bid >= 128) conv_fill(p, lds, l + 1, cv_p((l + 1) & 3) + (bid - 128) * FQ_T, FQ_T, wid_); BAR(10); }
        REP(11) {
#pragma unroll 1
            for (int part = 0; part < 3; ++part) {
                const bool last = (l == DEPTH - 1);
                if (part == 2 && last) break;
                const int tpe = last ? 8 : 9;
                const int m1n = part == 0 ? 128 : (part == 1 && !last ? 16 : 0), m1p = part == 0 ? 0 : 128;
                const int m2n = part == 0 ? 0 : (part == 1 ? (last ? 128 : 96) : 48), m2p = part == 1 ? 0 : 96;
                pg8::Sched S; S.init(pg8::Job{m1n, 8, m1p, tpe, (const char*)hb, (const char*)(p->ws + W_GU_T + (size_t)l * NE * 2048 * D * 2), (size_t)2048 * D * 2},
                                     pg8::Job{m2n, 4, m2p, tpe, (const char*)(p->ws + WS_ACT), (const char*)(p->ws + W_DN_T + (size_t)l * NE * D * FF * 2), (size_t)D * FF * 2}, G, bid, D);
                pg8::EpiMoeMix E{pg8::EpiMoe1{(h16*)(p->ws + WS_ACT), (const float*)(p->ws + WS_GV)}, pg8::EpiF16{(h16*)(p->ws + WS_YO), D}};
                pg8::gemm_phase_g(l3, S, E, (const int*)(p->ws + WS_ROWIDX), wid_);
                if (!rep_ && part == 2 && bid >= 192) conv_fill(p, lds, l + 1, cv_p((l + 1) & 3) + SEG_T + (bid - 192) * FQ_Z, FQ_Z, wid_);
                BAR(11);
            }
        }
        REP(13) { if (rep_) BAR(13); }
        phase_rowfin(p, l, lds, wid_);
        if (l < DEPTH - 1) BAR(1);
    }
    if constexpr (l + 1 < DEPTH) run_layers<l + 1>(p, lds, bar, wid_);
}
__global__ void __launch_bounds__(NT, 2) k_main(P p_unused) {
    PC p = (PC)__builtin_amdgcn_kernarg_segment_ptr();
    extern __shared__ __attribute__((aligned(16))) unsigned char lds[];
    volatile LAS unsigned* misc = (volatile LAS unsigned*)((LAS unsigned char*)lds + MISC_OFF);
    if (threadIdx.x < 64) misc[threadIdx.x] = 0u;
    __syncthreads();
    const XcdBarrier bar = xcd_barrier_post((unsigned*)(p->ws + WS_CTL) + CW_BAR, misc + 8);
    const int wid_ = __builtin_amdgcn_readfirstlane((int)threadIdx.x >> 6);
    REP(0) { phase_mod(p, lds, wid_); phase_convw(p, lds, wid_); BAR(0); }
    REP(1) { phase_rowfin(p, 255, lds, wid_); BAR(1); }
    run_layers<0>(p, lds, bar, wid_);
}
#undef REP
#undef BAR

extern "C" void kernel_launch(void* const* d_in, const int* in_sizes, int n_in, void* d_out, int out_size, void* d_ws, size_t ws_size, hipStream_t stream) {
    static int grid = 0;
    if (grid == 0) {
        if (n_in != 23 || out_size != ML * D || ws_size < WS_END) { fprintf(stderr, "kernel_launch: unexpected sizes n_in %d out %d ws %zu\n", n_in, out_size, ws_size); grid = -1; return; }
        int dev = 0, cus = 0, per_cu = 0;
        if (hipGetDevice(&dev) != hipSuccess || hipDeviceGetAttribute(&cus, hipDeviceAttributeMultiprocessorCount, dev) != hipSuccess) { grid = -1; return; }
        if (hipFuncSetAttribute((const void*)k_main, hipFuncAttributeMaxDynamicSharedMemorySize, LDS_BYTES) != hipSuccess) { fprintf(stderr, "hipFuncSetAttribute failed\n"); grid = -1; return; }
        if (hipOccupancyMaxActiveBlocksPerMultiprocessor(&per_cu, (const void*)k_main, NT, LDS_BYTES) != hipSuccess || per_cu < 1) { fprintf(stderr, "occupancy query says %d blocks/CU; not launching\n", per_cu); grid = -1; return; }
        (void)hipGetLastError();
        grid = cus;
    }
    if (grid < 0) return;
    P p{};
    const float** pp = (const float**)&p;
    for (int i = 0; i < 23; ++i) pp[i] = (const float*)d_in[i];
    p.out = (float*)d_out; p.ws = (unsigned char*)d_ws;
    (void)hipMemsetAsync((char*)d_ws + WS_CTL, 0, 1 * MiB, stream);
    hipLaunchKernelGGL(k_main, dim3(grid), dim3(NT), LDS_BYTES, stream, p);
}
```

```cpp
#include <hip/hip_runtime.h>
#include <stdint.h>
#include <stdio.h>

#define DI __device__ __forceinline__
typedef _Float16 h16;
typedef _Float16 h16x2 __attribute__((ext_vector_type(2)));
typedef _Float16 h16x4 __attribute__((ext_vector_type(4)));
typedef _Float16 h16x8 __attribute__((ext_vector_type(8)));
typedef float f32x2 __attribute__((ext_vector_type(2)));
typedef float f32x4 __attribute__((ext_vector_type(4)));
typedef unsigned u32x4 __attribute__((ext_vector_type(4)));
typedef unsigned long long u64;

constexpr int D = 1024, NB = 8, SEQ = 2048, CTXL = 256, DEPTH = 4;
constexpr int ML = NB * SEQ, MC = NB * CTXL, MT = ML + MC;
constexpr int NE = 16, FF = 1024, CAPL = 256, CAPC = 32;
constexpr int PPE = NB * CAPL + NB * CAPC;
constexpr int NPAIR = NE * PPE;
constexpr int NH = 8, HD = 128, NKV = 2, QKVW = 1536;
constexpr int NT = 512;
constexpr float EPS = 1e-6f;
constexpr float QSCALE = 0.08838834764831845f * 1.4426950408889634f;
constexpr float LOG2E = 1.4426950408889634f;

constexpr size_t MiB = 1u << 20;
constexpr size_t WS_CTL = 0;
constexpr size_t WS_MOD = 1 * MiB;
constexpr size_t WS_ROPE = 2 * MiB;
constexpr size_t WS_AFF = 3 * MiB;
constexpr size_t WS_INV = 5 * MiB;
constexpr size_t WS_ROWIDX = 7 * MiB;
constexpr size_t WS_GV = 8 * MiB;
constexpr size_t WS_AGG = 9 * MiB;
constexpr size_t WS_XRES = 16 * MiB;
constexpr size_t WS_HB = 88 * MiB;
constexpr size_t WS_UB = 124 * MiB;
constexpr size_t WS_SYB = 196 * MiB;
constexpr size_t WS_ACT = 232 * MiB;
constexpr size_t WS_YO = 304 * MiB;
constexpr size_t WS_CSCR = 376 * MiB;
constexpr size_t WS_W16 = 520 * MiB;
constexpr size_t WS_END = 1024 * MiB;

struct P {
    const float *x, *c, *ctx, *c_ctx, *ada_w, *ada_b, *norm1_g, *norm2_g;
    const float *lru_w_in, *lru_conv_w, *lru_conv_b, *lru_gate_w, *lru_gate_b, *lru_lambda, *lru_w_out;
    const float *attn_w_qkv, *attn_sink, *attn_w_o, *moe_router, *moe_w_gate, *moe_w_up, *moe_w_down, *final_g;
    float* out; unsigned char* ws;
};
typedef const P __attribute__((address_space(4)))* PC;
struct Prog { unsigned char kind[96]; unsigned char layer[96]; int n; int pad; };

enum Kind : unsigned char {
    K_MOD = 1, K_ROWFIN, K_NG_IN, K_EPI_IN, K_CONV, K_SCAN, K_NG_OUT, K_EPI_RES, K_NG_QKV, K_EPI_QKV, K_ATTN, K_NG_O,
    K_NORM2, K_TOPK, K_NG_MOE1, K_NG_MOE2, K_EPI_YO
};

DI int row_modr(int m) { return m < ML ? (m >> 11) : 8; }
DI float shx(float v, int m, int lane) { return __int_as_float(__builtin_amdgcn_ds_bpermute((lane ^ m) << 2, __float_as_int(v))); }
DI float wave_sum(float v, int lane) {
#pragma unroll
    for (int o = 1; o < 64; o <<= 1) v += shx(v, o, lane);
    return v;
}
DI float wave_max(float v, int lane) {
#pragma unroll
    for (int o = 1; o < 64; o <<= 1) v = fmaxf(v, shx(v, o, lane));
    return v;
}
DI float fast_exp(float x) { return __builtin_amdgcn_exp2f(x * LOG2E); }
DI float sigmoidf_(float x) { return __builtin_amdgcn_rcpf(1.0f + __builtin_amdgcn_exp2f(-LOG2E * x)); }
DI float siluf_(float x) { return x * sigmoidf_(x); }
DI float gelu_tanh(float x) {
    const float z2 = x * (1.5957691216057308f + 0.07135481627f * x * x);
    return x * __builtin_amdgcn_rcpf(1.0f + __builtin_amdgcn_exp2f(-LOG2E * z2));
}
DI int tid_from(int wid) { unsigned m = ~0u; asm volatile("" : "+s"(m), "+s"(wid)); return wid * 64 + (int)__builtin_amdgcn_mbcnt_hi(m, __builtin_amdgcn_mbcnt_lo(m, 0u)); }
DI float logsig8(float lam) {
    const float e = fast_exp(-lam);
    float l1p;
    if (e < 0.03f) l1p = e * (1.0f - e * (0.5f - e * (0.33333333f - e * (0.25f - e * 0.2f))));
    else l1p = __builtin_amdgcn_logf(1.0f + e) * 0.6931471805599453f;
    return -8.0f * l1p;
}
DI float neg_expm1(float z) {
    if (z > -0.25f) { const float p = z * (1.0f + z * (0.5f + z * (0.16666667f + z * (0.041666667f + z * (0.0083333333f + z * 0.0013888889f))))); return -p; }
    return 1.0f - fast_exp(z);
}
DI void lru_ab(float pr, float pi, float c8, float xb, float& a, float& bb) {
    const float r = sigmoidf_(pr), ig = sigmoidf_(pi);
    const float la = c8 * r;
    a = fast_exp(la);
    bb = sqrtf(neg_expm1(2.0f * la)) * (ig * xb);
}

DI void phase_mod(PC p, unsigned char* lds, int wid_) {
    int tidx = tid_from(wid_), bidx = blockIdx.x; asm volatile("" : "+v"(tidx), "+s"(bidx), "+s"(p));
    float* s = (float*)lds;
    float* red = s + 9 * 1024;
    const int tid = tidx;
    for (int i = tid; i < 9 * 1024; i += NT) { const int r = i >> 10, k = i & 1023; const float v = r < 8 ? p->c[r * 1024 + k] : p->c_ctx[k]; s[i] = siluf_(v); }
    __syncthreads();
    float* mod = (float*)(p->ws + WS_MOD);
    const int nchunk = DEPTH * 6144 / 32;
    const int kq = tid >> 3, cq = (tid & 7) * 4;
    for (int ch = bidx; ch < nchunk; ch += gridDim.x) {
        const int l = ch / 192, n0 = (ch % 192) * 32;
        const float* w = p->ada_w + (size_t)l * 1024 * 6144 + n0 + cq;
        f32x4 wv[16];
#pragma unroll
        for (int i = 0; i < 16; ++i) wv[i] = __builtin_nontemporal_load((const f32x4*)(w + (size_t)(kq + 64 * i) * 6144));
        f32x4 acc[9];
#pragma unroll
        for (int r = 0; r < 9; ++r) acc[r] = (f32x4){0.f, 0.f, 0.f, 0.f};
#pragma unroll
        for (int i = 0; i < 16; ++i)
#pragma unroll
            for (int r = 0; r < 9; ++r) acc[r] += wv[i] * s[r * 1024 + kq + 64 * i];
#pragma unroll
        for (int r = 0; r < 9; ++r) *(f32x4*)(red + (kq * 9 + r) * 32 + cq) = acc[r];
        __syncthreads();
        if (tid < 288) {
            const int r = tid >> 5, cc = tid & 31; float v = 0.f;
#pragma unroll 8
            for (int q = 0; q < 64; ++q) v += red[(q * 9 + r) * 32 + cc];
            mod[((size_t)l * 9 + r) * 6144 + n0 + cc] = v + p->ada_b[l * 6144 + n0 + cc];
        }
        __syncthreads();
    }
    if (bidx == gridDim.x - 1) {
        f32x2* tab = (f32x2*)(p->ws + WS_ROPE);
        for (int idx = tid; idx < 64 * 32; idx += NT) {
            const int pos = idx >> 5, i = idx & 31;
            double f = 1.0; for (int q = 0; q < i; ++q) f *= 0.74989420933245582730;
            const double xa = (double)pos * f;
            const double n = __builtin_rint(xa * 0.63661977236758134308);
            const double r = (xa - n * 1.5707963267948966192) - n * 6.123233995736766e-17;
            const double r2 = r * r;
            double sn = r * (1.0 + r2 * (-1.0 / 6 + r2 * (1.0 / 120 + r2 * (-1.0 / 5040 + r2 * (1.0 / 362880 + r2 * (-1.0 / 39916800 + r2 * (1.0 / 6227020800.0)))))));
            double cs = 1.0 + r2 * (-0.5 + r2 * (1.0 / 24 + r2 * (-1.0 / 720 + r2 * (1.0 / 40320 + r2 * (-1.0 / 3628800 + r2 * (1.0 / 479001600.0 + r2 * (-1.0 / 87178291200.0)))))));
            const int q = ((int)n) & 3;
            double cv, sv;
            if (q == 0) { cv = cs; sv = sn; } else if (q == 1) { cv = -sn; sv = cs; } else if (q == 2) { cv = -cs; sv = -sn; } else { cv = sn; sv = -cs; }
            tab[idx] = (f32x2){(float)cv, (float)sv};
        }
    }
}

DI void rowfin_finish(PC p, int l, bool pro, int m, f32x4 (&v)[4], int lane, const float* T) {
    h16* xres = (h16*)(p->ws + WS_XRES);
    h16* hb = (h16*)(p->ws + WS_HB);
    float ss = 0.f;
#pragma unroll
    for (int j = 0; j < 4; ++j) ss += (v[j][0] * v[j][0] + v[j][1] * v[j][1]) + (v[j][2] * v[j][2] + v[j][3] * v[j][3]);
    ss = wave_sum(ss, lane);
    const float rs = __builtin_amdgcn_rsqf(ss * (1.0f / D) + EPS);
    const float* tb = T + (size_t)row_modr(m) * 3 * D + 4 * lane;
    if (!pro && l == 3) {
#pragma unroll
        for (int j = 0; j < 4; ++j) { const f32x4 g = *(const f32x4*)(tb + 256 * j); *(f32x4*)(p->out + (size_t)m * D + 4 * lane + 256 * j) = v[j] * rs * g; }
    } else {
#pragma unroll
        for (int j = 0; j < 4; ++j) {
            const f32x4 g = *(const f32x4*)(tb + 256 * j), sh = *(const f32x4*)(tb + D + 256 * j);
            const f32x4 h = (v[j] * rs) * g + sh;
            *(h16x4*)(xres + (size_t)m * D + 4 * lane + 256 * j) = (h16x4){(h16)v[j][0], (h16)v[j][1], (h16)v[j][2], (h16)v[j][3]};
            *(h16x4*)(hb + (size_t)m * D + 4 * lane + 256 * j) = (h16x4){(h16)h[0], (h16)h[1], (h16)h[2], (h16)h[3]};
        }
    }
}
DI void phase_rowfin(PC p, int l  , unsigned char* lds, int wid_) {
    int tidx = tid_from(wid_), bidx = blockIdx.x; asm volatile("" : "+v"(tidx), "+s"(bidx), "+s"(p));
    const int lane = tidx & 63, wv = tidx >> 6;
    const int gw = bidx * 8 + wv, ngw = gridDim.x * 8;
    const bool pro = (l == 255);
    const h16* xres = (const h16*)(p->ws + WS_XRES);
    const float* mod = (const float*)(p->ws + WS_MOD);
    const int* inv = (const int*)(p->ws + WS_INV);
    const h16* yo = (const h16*)(p->ws + WS_YO);
    const int mend = (!pro && l == 3) ? ML : MT;
    float* T = (float*)lds;
    { const bool fin = (!pro && l == 3); const int nl = pro ? 0 : l + 1;
      for (int i = tidx; i < 9 * D; i += NT) { const int r = i >> 10, k = i & 1023;
          float g, sh, g2 = 0.f;
          if (fin) { g = p->final_g[k]; sh = 0.f; }
          else { const float* mb = mod + ((size_t)nl * 9 + r) * 6144; g = p->norm1_g[nl * D + k] * (1.0f + mb[1024 + k]); sh = mb[k]; }
          if (!pro) g2 = mod[((size_t)l * 9 + r) * 6144 + 5120 + k];
          T[(r * 3 + 0) * D + k] = g; T[(r * 3 + 1) * D + k] = sh; T[(r * 3 + 2) * D + k] = g2; }
      __syncthreads(); }
    f32x4 n0[4], n1[4]; h16x4 ny0[4], ny1[4]; int npe0 = -1, npe1 = -1, qpe0 = -1, qpe1 = -1;
#pragma unroll
    for (int j = 0; j < 4; ++j) { ny0[j] = (h16x4){0, 0, 0, 0}; ny1[j] = ny0[j]; }
#define RF_INV(M0, d0, d1) { const int a_ = (M0), b_ = (a_ + ngw) < mend ? a_ + ngw : a_; d0 = -1; d1 = -1; \
        if (!pro && a_ < mend) { d0 = lane < NE ? inv[a_ * NE + lane] : -1; d1 = lane < NE ? inv[b_ * NE + lane] : -1; } }
#define RF_LOAD(M0) { const int a_ = (M0), b_ = (a_ + ngw) < mend ? a_ + ngw : a_; \
        if (pro) { const float* s0_ = a_ < ML ? p->x + (size_t)a_ * D : p->ctx + (size_t)(a_ - ML) * D; const float* s1_ = b_ < ML ? p->x + (size_t)b_ * D : p->ctx + (size_t)(b_ - ML) * D; \
            _Pragma("unroll") for (int j = 0; j < 4; ++j) { n0[j] = *(const f32x4*)(s0_ + 4 * lane + 256 * j); n1[j] = *(const f32x4*)(s1_ + 4 * lane + 256 * j); } } \
        else { _Pragma("unroll") for (int j = 0; j < 4; ++j) { const h16x4 q0_ = *(const h16x4*)(xres + (size_t)a_ * D + 4 * lane + 256 * j), q1_ = *(const h16x4*)(xres + (size_t)b_ * D + 4 * lane + 256 * j); \
            n0[j] = (f32x4){(float)q0_[0], (float)q0_[1], (float)q0_[2], (float)q0_[3]}; n1[j] = (f32x4){(float)q1_[0], (float)q1_[1], (float)q1_[2], (float)q1_[3]}; } \
            const unsigned f0_ = (unsigned)__ballot(npe0 >= 0), f1_ = (unsigned)__ballot(npe1 >= 0); \
            const int r0_ = f0_ ? __builtin_amdgcn_readlane(npe0, __builtin_ctz(f0_ | 0x10000u)) : 0, r1_ = f1_ ? __builtin_amdgcn_readlane(npe1, __builtin_ctz(f1_ | 0x10000u)) : 0; \
            _Pragma("unroll") for (int j = 0; j < 4; ++j) { ny0[j] = *(const h16x4*)(yo + (size_t)r0_ * D + 4 * lane + 256 * j); ny1[j] = *(const h16x4*)(yo + (size_t)r1_ * D + 4 * lane + 256 * j); } } }
    if (gw < mend) { RF_INV(gw, npe0, npe1) RF_LOAD(gw) RF_INV(gw + 2 * ngw, qpe0, qpe1) }
    for (int m0 = gw; m0 < mend; m0 += 2 * ngw) {
        const bool has1 = (m0 + ngw) < mend; const int m1 = has1 ? m0 + ngw : m0;
        f32x4 v0[4], v1[4]; h16x4 yf0[4], yf1[4];
#pragma unroll
        for (int j = 0; j < 4; ++j) { v0[j] = n0[j]; v1[j] = n1[j]; yf0[j] = ny0[j]; yf1[j] = ny1[j]; }
        const int pe0 = npe0, pe1 = npe1;
        npe0 = qpe0; npe1 = qpe1;
        if (m0 + 2 * ngw < mend) { RF_LOAD(m0 + 2 * ngw) RF_INV(m0 + 4 * ngw, qpe0, qpe1) }
        if (!pro) {
            f32x4 a0[4], a1[4];
            unsigned k0 = (unsigned)__ballot(pe0 >= 0), k1 = (unsigned)__ballot(pe1 >= 0);
#pragma unroll
            for (int j = 0; j < 4; ++j) {
                a0[j] = k0 ? (f32x4){(float)yf0[j][0], (float)yf0[j][1], (float)yf0[j][2], (float)yf0[j][3]} : (f32x4){0.f, 0.f, 0.f, 0.f};
                a1[j] = k1 ? (f32x4){(float)yf1[j][0], (float)yf1[j][1], (float)yf1[j][2], (float)yf1[j][3]} : (f32x4){0.f, 0.f, 0.f, 0.f}; }
            k0 &= k0 - 1; k1 &= k1 - 1;
            while (k0 | k1) {
                const bool t0 = k0 != 0u, t1 = k1 != 0u;
                const int e0 = t0 ? __builtin_ctz(k0) : 0, e1 = t1 ? __builtin_ctz(k1) : 0;
                k0 &= k0 - 1; k1 &= k1 - 1;
                int pr0 = __builtin_amdgcn_readlane(pe0, e0), pr1 = __builtin_amdgcn_readlane(pe1, e1);
                pr0 = t0 ? pr0 : 0; pr1 = t1 ? pr1 : 0;
                const h16* y0p = yo + (size_t)pr0 * D + 4 * lane; const h16* y1p = yo + (size_t)pr1 * D + 4 * lane;
                h16x4 y0[4], y1[4];
#pragma unroll
                for (int j = 0; j < 4; ++j) { y0[j] = *(const h16x4*)(y0p + 256 * j); y1[j] = *(const h16x4*)(y1p + 256 * j); }
                if (t0) {
#pragma unroll
                    for (int j = 0; j < 4; ++j) a0[j] += (f32x4){(float)y0[j][0], (float)y0[j][1], (float)y0[j][2], (float)y0[j][3]}; }
                if (t1) {
#pragma unroll
                    for (int j = 0; j < 4; ++j) a1[j] += (f32x4){(float)y1[j][0], (float)y1[j][1], (float)y1[j][2], (float)y1[j][3]}; }
            }
            const float* g20 = T + ((size_t)row_modr(m0) * 3 + 2) * D + 4 * lane;
            const float* g21 = T + ((size_t)row_modr(m1) * 3 + 2) * D + 4 * lane;
#pragma unroll
            for (int j = 0; j < 4; ++j) { v0[j] += *(const f32x4*)(g20 + 256 * j) * a0[j]; v1[j] += *(const f32x4*)(g21 + 256 * j) * a1[j]; }
        }
        rowfin_finish(p, l, pro, m0, v0, lane, T);
        if (has1) rowfin_finish(p, l, pro, m1, v1, lane, T);
    }
#undef RF_INV
#undef RF_LOAD
}

DI void phase_norm2(PC p, int l, unsigned char* lds, int cu_lo, int ncu, int m_lo, int m_hi, int wid_) {
    int tidx = tid_from(wid_), bidx = blockIdx.x; asm volatile("" : "+v"(tidx), "+s"(bidx), "+s"(p));
    if (bidx < cu_lo || bidx >= cu_lo + ncu || m_lo >= m_hi) return;
    float* rt = (float*)lds;
    const float* rsrc = p->moe_router + (size_t)l * D * NE;
    for (int i = tidx; i < D * NE / 4; i += NT) { const f32x4 w = ((const f32x4*)rsrc)[i]; const int k = i >> 2, e4 = (i & 3) * 4;
        rt[(e4 + 0) * D + k] = w[0]; rt[(e4 + 1) * D + k] = w[1]; rt[(e4 + 2) * D + k] = w[2]; rt[(e4 + 3) * D + k] = w[3]; }
    float* T2 = rt + NE * D;
    for (int i = tidx; i < 9 * D; i += NT) { const int r = i >> 10, k = i & 1023; const float* mb = (const float*)(p->ws + WS_MOD) + ((size_t)l * 9 + r) * 6144 + 3072;
        T2[(r * 2 + 0) * D + k] = p->norm2_g[l * D + k] * (1.0f + mb[1024 + k]); T2[(r * 2 + 1) * D + k] = mb[k]; }
    __syncthreads();
    const int lane = tidx & 63, wv = tidx >> 6;
    const int gw = (bidx - cu_lo) * 8 + wv, ngw = ncu * 8;
    const h16* xres = (const h16*)(p->ws + WS_XRES);
    const float* mod = (const float*)(p->ws + WS_MOD);
    h16* hb = (h16*)(p->ws + WS_HB);
    float* aff = (float*)(p->ws + WS_AFF);
    const int mend = m_hi;
    for (int m0 = m_lo + gw; m0 < mend; m0 += 2 * ngw) {
        const bool has1 = (m0 + ngw) < mend; const int m1 = has1 ? m0 + ngw : m0;
        f32x4 v0[4], v1[4];
#pragma unroll
        for (int j = 0; j < 4; ++j) { const h16x4 q0_ = *(const h16x4*)(xres + (size_t)m0 * D + 4 * lane + 256 * j), q1_ = *(const h16x4*)(xres + (size_t)m1 * D + 4 * lane + 256 * j);
            v0[j] = (f32x4){(float)q0_[0], (float)q0_[1], (float)q0_[2], (float)q0_[3]}; v1[j] = (f32x4){(float)q1_[0], (float)q1_[1], (float)q1_[2], (float)q1_[3]}; }
        float ss0 = 0.f, ss1 = 0.f;
#pragma unroll
        for (int j = 0; j < 4; ++j) { ss0 += (v0[j][0] * v0[j][0] + v0[j][1] * v0[j][1]) + (v0[j][2] * v0[j][2] + v0[j][3] * v0[j][3]); ss1 += (v1[j][0] * v1[j][0] + v1[j][1] * v1[j][1]) + (v1[j][2] * v1[j][2] + v1[j][3] * v1[j][3]); }
#pragma unroll
        for (int o = 1; o < 64; o <<= 1) { ss0 += shx(ss0, o, lane); ss1 += shx(ss1, o, lane); }
        const float rs0 = __builtin_amdgcn_rsqf(ss0 * (1.0f / D) + EPS), rs1 = __builtin_amdgcn_rsqf(ss1 * (1.0f / D) + EPS);
        const float* tb0 = T2 + (size_t)row_modr(m0) * 2 * D + 4 * lane;
        const float* tb1 = T2 + (size_t)row_modr(m1) * 2 * D + 4 * lane;
#pragma unroll
        for (int j = 0; j < 4; ++j) {
            v0[j] = (v0[j] * rs0) * *(const f32x4*)(tb0 + 256 * j) + *(const f32x4*)(tb0 + D + 256 * j);
            v1[j] = (v1[j] * rs1) * *(const f32x4*)(tb1 + 256 * j) + *(const f32x4*)(tb1 + D + 256 * j);
            *(h16x4*)(hb + (size_t)m0 * D + 4 * lane + 256 * j) = (h16x4){(h16)v0[j][0], (h16)v0[j][1], (h16)v0[j][2], (h16)v0[j][3]};
            if (has1) *(h16x4*)(hb + (size_t)m1 * D + 4 * lane + 256 * j) = (h16x4){(h16)v1[j][0], (h16)v1[j][1], (h16)v1[j][2], (h16)v1[j][3]};
        }
        float lg0[NE], lg1[NE];
#pragma unroll
        for (int e = 0; e < NE; ++e) {
            float a0 = 0.f, a1 = 0.f;
#pragma unroll
            for (int j = 0; j < 4; ++j) { const f32x4 w = *(const f32x4*)(rt + e * D + 4 * lane + 256 * j);
                a0 += (v0[j][0] * w[0] + v0[j][1] * w[1]) + (v0[j][2] * w[2] + v0[j][3] * w[3]); a1 += (v1[j][0] * w[0] + v1[j][1] * w[1]) + (v1[j][2] * w[2] + v1[j][3] * w[3]); }
            lg0[e] = a0; lg1[e] = a1;
            if (e & 1) asm volatile("" ::: "memory");
        }
#define HALVE(N, BIT) { const bool up_ = (lane & (BIT)) != 0; _Pragma("unroll") for (int e = 0; e < (N); ++e) { \
            const float k0_ = up_ ? lg0[e + (N)] : lg0[e], s0_ = up_ ? lg0[e] : lg0[e + (N)]; lg0[e] = k0_ + shx(s0_, (BIT), lane); \
            const float k1_ = up_ ? lg1[e + (N)] : lg1[e], s1_ = up_ ? lg1[e] : lg1[e + (N)]; lg1[e] = k1_ + shx(s1_, (BIT), lane); } }
        HALVE(8, 32) HALVE(4, 16) HALVE(2, 8) HALVE(1, 4)
#undef HALVE
        float x0 = lg0[0], x1 = lg1[0];
        x0 += shx(x0, 2, lane); x1 += shx(x1, 2, lane); x0 += shx(x0, 1, lane); x1 += shx(x1, 1, lane);
        float mx0 = x0, mx1 = x1;
#pragma unroll
        for (int o = 4; o < 64; o <<= 1) { mx0 = fmaxf(mx0, shx(mx0, o, lane)); mx1 = fmaxf(mx1, shx(mx1, o, lane)); }
        const float p0 = __builtin_amdgcn_exp2f((x0 - mx0) * LOG2E), p1 = __builtin_amdgcn_exp2f((x1 - mx1) * LOG2E);
        float d0 = p0, d1 = p1;
#pragma unroll
        for (int o = 4; o < 64; o <<= 1) { d0 += shx(d0, o, lane); d1 += shx(d1, o, lane); }
        if ((lane & 3) == 0) { aff[(size_t)m0 * NE + (lane >> 2)] = p0 / d0; if (has1) aff[(size_t)m1 * NE + (lane >> 2)] = p1 / d1; }
    }
}

constexpr int LDS_BYTES = 147456;
constexpr size_t W_IN_T = WS_W16, W_OUT_T = WS_W16 + 8 * MiB, W_QKV_T = WS_W16 + 12 * MiB, W_O_T = WS_W16 + 18 * MiB, W_GATE16 = WS_W16 + 22 * MiB;
constexpr size_t W_GU_T = WS_W16 + 24 * MiB, W_DN_T = WS_W16 + 280 * MiB;
static_assert(W_DN_T + 128 * MiB <= WS_END, "ws map");

DI int map_row(int kind, int n) {
    if (kind == 1) { if (n >= 1280) return n; const int d = n & 127, hb = n - d, hh = d >> 6, e = d & 63; return hb + hh * 64 + 2 * (e & 31) + (e >> 5); }
    if (kind == 2) return 256 * (n >> 7) + (n & 127);
    if (kind == 3) return 256 * (n >> 7) + 128 + (n & 127);
    return n;
}
struct CvItem { const float* src; h16* dst; int K, N, kind, k0, n0; };
DI void cv_load(const CvItem& c, f32x4 (&ld)[8], int lane) {
#pragma unroll
    for (int i = 0; i < 8; ++i) ld[i] = __builtin_nontemporal_load((const f32x4*)(c.src + (size_t)(c.k0 + 8 * i + (lane >> 3)) * c.N + c.n0 + (lane & 7) * 4));
}
DI void cv_finish(const CvItem& c, const f32x4 (&ld)[8], float* scr, int lane) {
#pragma unroll
    for (int i = 0; i < 8; ++i) { float* d = scr + (8 * i + (lane >> 3)) * 33 + (lane & 7) * 4; d[0] = ld[i][0]; d[1] = ld[i][1]; d[2] = ld[i][2]; d[3] = ld[i][3]; }
    asm volatile("s_waitcnt lgkmcnt(0)" ::: "memory");
    const int cc = lane & 7;
#pragma unroll
    for (int j = 0; j < 4; ++j) { const int n = (lane >> 3) + 8 * j; const float* sp = scr + (8 * cc) * 33 + n;
        h16x8 o;
#pragma unroll
        for (int q = 0; q < 8; ++q) o[q] = (h16)sp[q * 33];
        __builtin_nontemporal_store(o, (h16x8*)(c.dst + (size_t)map_row(c.kind, c.n0 + n) * c.K + c.k0 + 8 * cc)); }
    asm volatile("s_waitcnt lgkmcnt(0)" ::: "memory");
}
constexpr int CV_DENSE = 5632, CV_PRE = 6144, CV_LAYER = 24576;
constexpr int FQ_A = 80, FQ_T = 24, FQ_Z = 96, FQ_AT = 44;
constexpr int SEG_T = 128 * FQ_T, SEG_Z = 64 * FQ_Z, SEG_PREV = SEG_T + SEG_Z, SEG_A_LRU = 192 * FQ_A, SEG_A_ATT = 80 * FQ_A, SEG_AT = 192 * FQ_AT;
DI constexpr int cv_prev(int L) { return L == 0 ? 0 : SEG_PREV; }
DI constexpr int cv_own(int L) { return (L & 1) ? SEG_A_ATT + (L == DEPTH - 1 ? 0 : SEG_AT) : SEG_A_LRU; }
DI constexpr int cv_p(int L) { return CV_LAYER - cv_prev(L) - cv_own(L); }
static_assert(cv_p(0) >= 0 && cv_p(1) >= 0 && cv_p(2) >= 0 && cv_p(3) >= 0, "filler plan");
DI CvItem cv_decode(PC p, int it) {
    constexpr int I_IN = 1024, I_SQ = 512, I_QKV = 768;
    CvItem c; int r = it, item;
    if (r >= CV_PRE) {
        r -= CV_PRE; const int mat = r / I_SQ, le = mat / 3, kind = mat % 3; item = r % I_SQ;
        c.K = D; c.N = FF;
        if (kind == 0) { c.src = p->moe_w_gate + (size_t)le * D * FF; c.dst = (h16*)(p->ws + W_GU_T) + (size_t)le * 2048 * D; c.kind = 2; }
        else if (kind == 1) { c.src = p->moe_w_up + (size_t)le * D * FF; c.dst = (h16*)(p->ws + W_GU_T) + (size_t)le * 2048 * D; c.kind = 3; }
        else { c.src = p->moe_w_down + (size_t)le * FF * D; c.dst = (h16*)(p->ws + W_DN_T) + (size_t)le * D * FF; c.kind = 0; }
    } else if (r >= CV_DENSE) { r -= CV_DENSE; const int mat = r >> 4; item = r & 15;
        c.src = p->lru_gate_w + (size_t)mat * 128 * 256; c.dst = (h16*)(p->ws + W_GATE16) + (size_t)mat * 256 * 128; c.K = 128; c.N = 256; c.kind = 0;
    } else if (r < 2 * I_IN) { const int j = r / I_IN; item = r % I_IN; c.src = p->lru_w_in + (size_t)j * D * 2048; c.dst = (h16*)(p->ws + W_IN_T) + (size_t)j * 2048 * D; c.K = D; c.N = 2048; c.kind = 0;
    } else if (r < 2 * I_IN + 2 * I_SQ) { r -= 2 * I_IN; const int j = r / I_SQ; item = r % I_SQ; c.src = p->lru_w_out + (size_t)j * D * D; c.dst = (h16*)(p->ws + W_OUT_T) + (size_t)j * D * D; c.K = D; c.N = D; c.kind = 0;
    } else if (r < 2 * I_IN + 2 * I_SQ + 2 * I_QKV) { r -= 2 * I_IN + 2 * I_SQ; const int j = r / I_QKV; item = r % I_QKV; c.src = p->attn_w_qkv + (size_t)j * D * QKVW; c.dst = (h16*)(p->ws + W_QKV_T) + (size_t)j * QKVW * D; c.K = D; c.N = QKVW; c.kind = 1;
    } else { r -= 2 * I_IN + 2 * I_SQ + 2 * I_QKV; const int j = r / I_SQ; item = r % I_SQ; c.src = p->attn_w_o + (size_t)j * D * D; c.dst = (h16*)(p->ws + W_O_T) + (size_t)j * D * D; c.K = D; c.N = D; c.kind = 0; }
    const int nblk = c.N / 32; c.k0 = 64 * (item / nblk); c.n0 = 32 * (item % nblk);
    return c;
}
#define CV_PIPE(COUNT, ITEM_OF) { const int cnt_ = (COUNT); if (cnt_ > 0) { CvItem ca_ = cv_decode(p, ITEM_OF(0)), cb_; f32x4 la_[8], lb_[8]; cv_load(ca_, la_, lane); \
        for (int k_ = 0; k_ < cnt_; k_ += 2) { \
            if (k_ + 1 < cnt_) { cb_ = cv_decode(p, ITEM_OF(k_ + 1)); cv_load(cb_, lb_, lane); } \
            cv_finish(ca_, la_, scr, lane); \
            if (k_ + 1 < cnt_) { if (k_ + 2 < cnt_) { ca_ = cv_decode(p, ITEM_OF(k_ + 2)); cv_load(ca_, la_, lane); } cv_finish(cb_, lb_, scr, lane); } } } }
DI void phase_convw(PC p, unsigned char* lds, int wid_) {
    int tidx = tid_from(wid_), bidx = blockIdx.x; asm volatile("" : "+v"(tidx), "+s"(bidx), "+s"(p));
    const int lane = tidx & 63, wv = tidx >> 6;
    float* scr = (float*)lds + wv * (64 * 33 + 16);
    const int gw = bidx * 8 + wv, ngw = gridDim.x * 8;
    if (gridDim.x != 256) {
#define IT_ALL(k) (gw + (k) * ngw)
        CV_PIPE((CV_PRE + 4 * CV_LAYER - gw + ngw - 1) / ngw, IT_ALL)
#undef IT_ALL
        return; }
    const int n0 = cv_p(0), n1 = cv_p(1), n2 = cv_p(2), n3 = cv_p(3), ntot = CV_PRE + n0 + n1 + n2 + n3;
    auto gmap = [&](int k) { int r = gw + k * ngw, g;
        if (r < CV_PRE + n0) g = r;
        else { r -= CV_PRE + n0; if (r < n1) g = CV_PRE + CV_LAYER + r; else { r -= n1; if (r < n2) g = CV_PRE + 2 * CV_LAYER + r; else g = CV_PRE + 3 * CV_LAYER + (r - n2); } }
        return g; };
    CV_PIPE(gw < ntot ? (ntot - gw + ngw - 1) / ngw : 0, gmap)
}
DI void conv_fill(PC p, unsigned char* lds, int l, int first, int quota, int wid_) {
    int tidx = tid_from(wid_), bidx = blockIdx.x; asm volatile("" : "+v"(tidx), "+s"(bidx), "+s"(p), "+s"(l));
    if (l >= DEPTH || gridDim.x != 256) return;
    const int lane = tidx & 63, wv = tidx >> 6;
    float* scr = (float*)lds + wv * (64 * 33 + 16);
    const int base = first;
    int cnt = 0; { const int lim = (CV_LAYER - base) < quota ? (CV_LAYER - base) : quota; cnt = lim > wv ? (lim - wv + 7) / 8 : 0; }
#define IT_FILL(k) (CV_PRE + l * CV_LAYER + base + wv + 8 * (k))
    CV_PIPE(cnt, IT_FILL)
#undef IT_FILL
}

namespace pg8 {
#define PG8_LAS __attribute__((address_space(3)))
constexpr int BM = 256, BK = 64, HALF = 128, HTB = HALF * BK * 2, STAGE_BYTES = 8 * HTB, NXCD = 8, WGM = 8;
DI int lds_byte(int r, int c) { const int st = (r >> 4) * 2 + (c >> 5), rr = r & 15, cc = c & 31, ob = rr * 64 + cc * 2; return st * 1024 + (ob ^ (((ob >> 9) & 1) << 5)); }
DI void stage_rc(int b, int& R, int& C) { const int st = b / 1024, sb = b % 1024, swz = sb ^ (((sb >> 9) & 1) << 5); R = (st >> 1) * 16 + swz / 64; C = (st & 1) * 32 + (swz % 64) / 2; }
DI int perm32(int rho) { const int n = rho >> 4, i = rho & 15; return 8 * (i >> 2) + 4 * n + (i & 3); }
struct Unit { int pm, pn, row0, e, job; };
struct Job { int nM, nN, pm0, TPE; const char* A; const char* Bt; size_t bstride; };
struct Sched {
    Job j0, j1; int n0, nwg, G, c, K;
    DI void init(const Job& a, const Job& b, int G_, int c_, int K_) { j0 = a; j1 = b; n0 = a.nM * a.nN; nwg = n0 + b.nM * b.nN; G = G_; c = c_; K = K_; }
    DI bool next(int i, Unit& u) const {
        const long L = (long)i * G + c; if (L >= nwg || c >= G) return false;
        const int job = L >= n0 ? 1 : 0; int wgid = job ? (int)L - n0 : (int)L;
        const int nM = job ? j1.nM : j0.nM, nN = job ? j1.nN : j0.nN, pm0 = job ? j1.pm0 : j0.pm0, TPE = job ? j1.TPE : j0.TPE, nw = nM * nN;
        { const int q = nw / NXCD, r = nw % NXCD, xcd = wgid % NXCD, off = wgid / NXCD; wgid = (xcd < r ? xcd * (q + 1) : r * (q + 1) + (xcd - r) * q) + off; }
        const int nig = WGM * nN, gid = wgid / nig, fm = gid * WGM, gsz = (nM - fm) < WGM ? (nM - fm) : WGM;
        u.pm = pm0 + fm + ((wgid % nig) % gsz); u.pn = (wgid % nig) / gsz; u.job = job;
        u.row0 = u.pm * 256; u.e = TPE ? (u.pm < 128 ? (u.pm >> 3) : (u.pm - 128)) : 0;
        return true;
    }
    DI const char* a_base(const Unit& u) const { return (u.job ? j1.A : j0.A) + (size_t)u.row0 * K * 2; }
    DI const char* b_base(const Unit& u) const { return (u.job ? j1.Bt : j0.Bt) + (size_t)u.e * (u.job ? j1.bstride : j0.bstride) + (size_t)u.pn * 256 * K * 2; }
};
DI u32x4 pack8(const f32x4 a, const f32x4 b) {
    const h16x8 o = {(h16)a[0], (h16)a[1], (h16)a[2], (h16)a[3], (h16)b[0], (h16)b[1], (h16)b[2], (h16)b[3]};
    return __builtin_bit_cast(u32x4, o);
}
struct EpiF16 {
    static constexpr bool PERM = true;
    h16* O; int ldc;
    DI void operator()(const f32x4 (&acc)[2][2][4][2], const Unit& u, int wr, int wc, int fr, int fq) const {
        const int row0 = u.row0 + wr * 64 + fr, col0 = u.pn * BM + wc * 32 + 8 * fq;
#pragma unroll
        for (int ai = 0; ai < 2; ++ai)
#pragma unroll
            for (int m = 0; m < 4; ++m) { h16* rowp = O + (size_t)(row0 + ai * HALF + m * 16) * ldc + col0;
#pragma unroll
                for (int bj = 0; bj < 2; ++bj) *(u32x4*)(rowp + bj * HALF) = pack8(acc[ai][bj][m][0], acc[ai][bj][m][1]); }
    }
};
struct EpiLruIn {
    static constexpr bool PERM = true;
    h16* yg; h16* xr;
    DI void operator()(const f32x4 (&acc)[2][2][4][2], const Unit& u, int wr, int wc, int fr, int fq) const {
        const int row0 = u.row0 + wr * 64 + fr; const bool act = u.pn < 4;
        h16* base = act ? yg : xr; const int col0 = (u.pn & 3) * BM + wc * 32 + 8 * fq;
#pragma unroll
        for (int ai = 0; ai < 2; ++ai)
#pragma unroll
            for (int m = 0; m < 4; ++m) { h16* rowp = base + (size_t)(row0 + ai * HALF + m * 16) * D + col0;
#pragma unroll
                for (int bj = 0; bj < 2; ++bj) { f32x4 v0 = acc[ai][bj][m][0], v1 = acc[ai][bj][m][1];
                    if (act) {
#pragma unroll
                        for (int q = 0; q < 4; ++q) { v0[q] = gelu_tanh(v0[q]); v1[q] = gelu_tanh(v1[q]); } }
                    *(u32x4*)(rowp + bj * HALF) = pack8(v0, v1); } }
    }
};
struct EpiResid {
    static constexpr bool PERM = true;
    h16* x; const float* gate;
    DI void operator()(const f32x4 (&acc)[2][2][4][2], const Unit& u, int wr, int wc, int fr, int fq) const {
        const float* gp = gate + (size_t)(u.pm < 64 ? (u.pm >> 3) : 8) * 6144;
        const int col0 = u.pn * BM + wc * 32 + 8 * fq;
        f32x4 gv[2][2];
#pragma unroll
        for (int bj = 0; bj < 2; ++bj)
#pragma unroll
            for (int n = 0; n < 2; ++n) gv[bj][n] = *(const f32x4*)(gp + col0 + bj * HALF + n * 4);
        h16x8 xo[2][4][2];
#pragma unroll
        for (int ai = 0; ai < 2; ++ai)
#pragma unroll
            for (int m = 0; m < 4; ++m)
#pragma unroll
                for (int bj = 0; bj < 2; ++bj) xo[ai][m][bj] = *(const h16x8*)(x + (size_t)(u.row0 + ai * HALF + wr * 64 + m * 16 + fr) * D + col0 + bj * HALF);
#pragma unroll
        for (int ai = 0; ai < 2; ++ai)
#pragma unroll
            for (int m = 0; m < 4; ++m) { h16* xp = x + (size_t)(u.row0 + ai * HALF + wr * 64 + m * 16 + fr) * D + col0;
#pragma unroll
                for (int bj = 0; bj < 2; ++bj) { f32x4 o0, o1;
#pragma unroll
                    for (int q = 0; q < 4; ++q) { o0[q] = (float)xo[ai][m][bj][q] + gv[bj][0][q] * acc[ai][bj][m][0][q]; o1[q] = (float)xo[ai][m][bj][4 + q] + gv[bj][1][q] * acc[ai][bj][m][1][q]; }
                    *(u32x4*)(xp + bj * HALF) = pack8(o0, o1); } }
    }
};
struct EpiQKV {
    static constexpr bool PERM = true;
    h16* qkv; const f32x2* tab;
    DI void operator()(const f32x4 (&acc)[2][2][4][2], const Unit& u, int wr, int wc, int fr, int fq) const {
        const int row0 = u.row0 + wr * 64 + fr, col0 = u.pn * BM + wc * 32 + 8 * fq;
        const bool rope = (u.pn < 5) && (u.pm < 64); const float sc = u.pn < 4 ? QSCALE : 1.0f;
        const int hh = wc >> 1, i0 = 16 * (wc & 1) + 4 * fq;
        f32x4 csa[2][4][2];
#pragma unroll
        for (int ai = 0; ai < 2; ++ai)
#pragma unroll
            for (int m = 0; m < 4; ++m) { const int row = row0 + ai * HALF + m * 16;
                csa[ai][m][0] = (f32x4){1.f, 0.f, 1.f, 0.f}; csa[ai][m][1] = csa[ai][m][0];
                if (rope) { const int t = row & 2047, pos = hh ? (t & 63) : (t >> 6); const f32x4* tp = (const f32x4*)(tab + pos * 32 + i0); csa[ai][m][0] = tp[0]; csa[ai][m][1] = tp[1]; } }
#pragma unroll
        for (int ai = 0; ai < 2; ++ai)
#pragma unroll
            for (int m = 0; m < 4; ++m) { const int row = row0 + ai * HALF + m * 16; h16* rowp = qkv + (size_t)row * QKVW + col0;
                const f32x4 cs0 = csa[ai][m][0], cs1 = csa[ai][m][1];
#pragma unroll
                for (int bj = 0; bj < 2; ++bj) { const f32x4 a = acc[ai][bj][m][0], b = acc[ai][bj][m][1]; f32x4 o0, o1;
                    o0[0] = (a[0] * cs0[0] - a[1] * cs0[1]) * sc; o0[1] = (a[0] * cs0[1] + a[1] * cs0[0]) * sc; o0[2] = (a[2] * cs0[2] - a[3] * cs0[3]) * sc; o0[3] = (a[2] * cs0[3] + a[3] * cs0[2]) * sc;
                    o1[0] = (b[0] * cs1[0] - b[1] * cs1[1]) * sc; o1[1] = (b[0] * cs1[1] + b[1] * cs1[0]) * sc; o1[2] = (b[2] * cs1[2] - b[3] * cs1[3]) * sc; o1[3] = (b[2] * cs1[3] + b[3] * cs1[2]) * sc;
                    *(u32x4*)(rowp + bj * HALF) = pack8(o0, o1); } }
    }
};
struct EpiMoe1 {
    static constexpr bool PERM = true;
    h16* act; const float* gvp;
    DI void operator()(const f32x4 (&acc)[2][2][4][2], const Unit& u, int wr, int wc, int fr, int fq) const {
        const int row0 = u.row0 + wr * 64 + fr, col0 = u.pn * HALF + wc * 32 + 8 * fq;
        float gq[2][4];
#pragma unroll
        for (int ai = 0; ai < 2; ++ai)
#pragma unroll
            for (int m = 0; m < 4; ++m) gq[ai][m] = gvp[row0 + ai * HALF + m * 16];
        f32x4 t0[2][4], t1[2][4];
#pragma unroll
        for (int ai = 0; ai < 2; ++ai)
#pragma unroll
            for (int m = 0; m < 4; ++m)
#pragma unroll
                for (int q = 0; q < 4; ++q) { t0[ai][m][q] = siluf_(acc[ai][0][m][0][q]) * acc[ai][1][m][0][q]; t1[ai][m][q] = siluf_(acc[ai][0][m][1][q]) * acc[ai][1][m][1][q]; }
        __builtin_amdgcn_sched_barrier(0);
#pragma unroll
        for (int ai = 0; ai < 2; ++ai)
#pragma unroll
            for (int m = 0; m < 4; ++m) { const int row = row0 + ai * HALF + m * 16; const float g = gq[ai][m]; f32x4 o0, o1;
#pragma unroll
                for (int q = 0; q < 4; ++q) { o0[q] = t0[ai][m][q] * g; o1[q] = t1[ai][m][q] * g; }
                *(u32x4*)(act + (size_t)row * FF + col0) = pack8(o0, o1); }
    }
};

struct EpiMoeMix {
    static constexpr bool PERM = true;
    EpiMoe1 e1; EpiF16 e2;
    DI void operator()(const f32x4 (&acc)[2][2][4][2], const Unit& u, int wr, int wc, int fr, int fq) const { if (u.job == 0) e1(acc, u, wr, wc, fr, fq); else e2(acc, u, wr, wc, fr, fq); }
};
template <class Epi>
DI void gemm_phase(PG8_LAS unsigned char* lds, const Sched& S, const Epi& E, int wid_) {
    const int tid = tid_from(wid_);
    const int wid = wid_, lane = tid & 63, wr = wid >> 2, wc = wid & 3, fr = lane & 15, fq = lane >> 4;
    const int K = S.K, nt = K / BK;
    unsigned voffA[2], voffB[2];
#pragma unroll
    for (int i = 0; i < 2; ++i) { int R, C; stage_rc(tid * 16 + i * 8192, R, C); const int Rb = Epi::PERM ? ((R & ~31) + perm32(R & 31)) : R;
        voffA[i] = (unsigned)(R * K + C) * 2u; voffB[i] = (unsigned)(Rb * K + C) * 2u; }
    const size_t kstep = (size_t)(BK * 2);
    const size_t hstep = (size_t)HALF * K * 2;
    const unsigned ldsw = (unsigned)wid * 1024u;
    const int aoff = lds_byte(wr * 64 + fr, fq * 8), boff = lds_byte(wc * 32 + fr, fq * 8);
#define PG8_SA(b, h) (((b) * 2 + (h)) * HTB)
#define PG8_SB(b, h) ((4 + (b) * 2 + (h)) * HTB)
#define PG8_STAGE(bufoff, gbase, voff) do { _Pragma("unroll") for (int _i = 0; _i < 2; ++_i) \
        __builtin_amdgcn_global_load_lds((const unsigned*)((const char*)(gbase) + (voff)[_i]), (PG8_LAS unsigned*)(lds + (bufoff) + ldsw + _i * 8192), 16, 0, 0); } while (0)
#define PG8_LDA(dst, b, h) do { _Pragma("unroll") for (int m = 0; m < 4; ++m) _Pragma("unroll") for (int k = 0; k < 2; ++k) dst[m][k] = *(const PG8_LAS h16x8*)(lds + PG8_SA(b, h) + aoff + m * 2048 + k * 1024); } while (0)
#define PG8_LDB(dst, b, h) do { _Pragma("unroll") for (int n = 0; n < 2; ++n) _Pragma("unroll") for (int k = 0; k < 2; ++k) dst[n][k] = *(const PG8_LAS h16x8*)(lds + PG8_SB(b, h) + boff + n * 2048 + k * 1024); } while (0)
#define PG8_MMA(ai, bj, At, Bt) do { __builtin_amdgcn_s_setprio(1); _Pragma("unroll") for (int m = 0; m < 4; ++m) _Pragma("unroll") for (int n = 0; n < 2; ++n) _Pragma("unroll") for (int k = 0; k < 2; ++k) \
        acc[ai][bj][m][n] = __builtin_amdgcn_mfma_f32_16x16x32_f16(Bt[n][k], At[m][k], acc[ai][bj][m][n], 0, 0, 0); __builtin_amdgcn_s_setprio(0); } while (0)
#define PG8_WAIT_V(n) asm volatile("s_waitcnt vmcnt(" #n ")" ::: "memory")
#define PG8_WAIT_L(n) asm volatile("s_waitcnt lgkmcnt(" #n ")" ::: "memory")
#define PG8_BAR __builtin_amdgcn_s_barrier()
#define PG8_SCHED __builtin_amdgcn_sched_barrier(0)
    Unit cur, nxt; int ui = 0;
    if (!S.next(0, cur)) return;
    f32x4 acc[2][2][4][2];
#pragma unroll
    for (int a = 0; a < 2; ++a)
#pragma unroll
        for (int b = 0; b < 2; ++b)
#pragma unroll
            for (int m = 0; m < 4; ++m)
#pragma unroll
                for (int n = 0; n < 2; ++n) acc[a][b][m][n] = (f32x4){0.f, 0.f, 0.f, 0.f};
    h16x8 At[4][2], B0[2][2], B1[2][2];
    const char* cA = S.a_base(cur); const char* cB = S.b_base(cur);
    PG8_STAGE(PG8_SB(0, 0), cB, voffB); PG8_STAGE(PG8_SB(0, 1), cB + hstep, voffB); PG8_STAGE(PG8_SA(0, 0), cA, voffA); PG8_STAGE(PG8_SA(0, 1), cA + hstep, voffA);
    if (wr == 1) PG8_BAR;
    PG8_WAIT_V(2); PG8_BAR;
    PG8_STAGE(PG8_SB(1, 0), cB + kstep, voffB); PG8_STAGE(PG8_SA(1, 0), cA + kstep, voffA); PG8_STAGE(PG8_SB(1, 1), cB + hstep + kstep, voffB);
    PG8_WAIT_V(6); PG8_BAR;
    for (;;) {
        const bool has_next = S.next(ui + 1, nxt);
        const char* nA = has_next ? S.a_base(nxt) : cA; const char* nB = has_next ? S.b_base(nxt) : cB;
        for (int t = 0; t < nt; t += 2) {
            const bool last = (t == nt - 2);
            const char* a1 = cA + (size_t)(t + 1) * kstep;
            const char* a2 = last ? nA : cA + (size_t)(t + 2) * kstep; const char* b2 = last ? nB : cB + (size_t)(t + 2) * kstep;
            const char* a3 = a2 + kstep; const char* b3 = b2 + kstep;
            PG8_LDB(B0, 0, 0); PG8_LDB(B1, 0, 1); PG8_SCHED; PG8_LDA(At, 0, 0); PG8_STAGE(PG8_SA(1, 1), a1 + hstep, voffA);
            PG8_WAIT_V(8); PG8_WAIT_L(0); PG8_BAR; PG8_MMA(0, 0, At, B0); PG8_MMA(0, 1, At, B1); PG8_BAR; PG8_SCHED;
            PG8_LDA(At, 0, 1); PG8_STAGE(PG8_SB(0, 0), b2, voffB); PG8_STAGE(PG8_SB(0, 1), b2 + hstep, voffB); PG8_STAGE(PG8_SA(0, 0), a2, voffA);
            PG8_WAIT_V(8); PG8_WAIT_L(0); PG8_BAR; PG8_MMA(1, 0, At, B0); PG8_MMA(1, 1, At, B1); PG8_BAR; PG8_SCHED;
            PG8_LDB(B0, 1, 0); PG8_LDB(B1, 1, 1); PG8_SCHED; PG8_LDA(At, 1, 0); PG8_STAGE(PG8_SA(0, 1), a2 + hstep, voffA);
            PG8_WAIT_V(8); PG8_WAIT_L(0); PG8_BAR; PG8_MMA(0, 0, At, B0); PG8_MMA(0, 1, At, B1); PG8_BAR; PG8_SCHED;
            PG8_LDA(At, 1, 1); PG8_STAGE(PG8_SB(1, 0), b3, voffB); PG8_STAGE(PG8_SB(1, 1), b3 + hstep, voffB); PG8_STAGE(PG8_SA(1, 0), a3, voffA);
            PG8_WAIT_V(8); PG8_WAIT_L(0); PG8_BAR; PG8_MMA(1, 0, At, B0); PG8_MMA(1, 1, At, B1); PG8_BAR; PG8_SCHED;
        }
        if (wr == 0) PG8_BAR;
        E(acc, cur, wr, wc, fr, fq);
        if (!has_next) break;
        {
            h16x8 z8 = {0, 0, 0, 0, 0, 0, 0, 0}; asm volatile("" : "+v"(z8));
#pragma unroll
            for (int a = 0; a < 2; ++a)
#pragma unroll
                for (int b = 0; b < 2; ++b)
#pragma unroll
                    for (int m = 0; m < 4; ++m)
#pragma unroll
                        for (int n = 0; n < 2; ++n) acc[a][b][m][n] = __builtin_amdgcn_mfma_f32_16x16x32_f16(z8, z8, (f32x4){0.f, 0.f, 0.f, 0.f}, 0, 0, 0);
        }
        cur = nxt; cA = nA; cB = nB; ++ui;
        if (wr == 1) PG8_BAR;
    }
    PG8_WAIT_V(0);
    PG8_BAR;
#undef PG8_SA
#undef PG8_SB
#undef PG8_STAGE
#undef PG8_LDA
#undef PG8_LDB
#undef PG8_MMA
#undef PG8_WAIT_V
#undef PG8_WAIT_L
#undef PG8_BAR
#undef PG8_SCHED
}
template <class Epi>
DI void gemm_phase_g(PG8_LAS unsigned char* lds, const Sched& S, const Epi& E, const int* gidx, int wid_) {
    const int tid = tid_from(wid_);
    const int wid = wid_, lane = tid & 63, wr = wid >> 2, wc = wid & 3, fr = lane & 15, fq = lane >> 4;
    const int K = S.K, nt = K / BK;
    unsigned voffB[2]; int R0, C0;
    stage_rc(tid * 16, R0, C0);
#pragma unroll
    for (int i = 0; i < 2; ++i) { int R, C; stage_rc(tid * 16 + i * 8192, R, C); const int Rb = Epi::PERM ? ((R & ~31) + perm32(R & 31)) : R; voffB[i] = (unsigned)(Rb * K + C) * 2u; }
    const unsigned cshift = (unsigned)C0 * 2u, rowb = (unsigned)K * 2u;
    const size_t kstep = (size_t)(BK * 2);
    const size_t hstep = (size_t)HALF * K * 2;
    const unsigned ldsw = (unsigned)wid * 1024u;
    const int aoff = lds_byte(wr * 64 + fr, fq * 8), boff = lds_byte(wc * 32 + fr, fq * 8);
#define PG8_SA(b, h) (((b) * 2 + (h)) * HTB)
#define PG8_SB(b, h) ((4 + (b) * 2 + (h)) * HTB)
#define PG8_STAGE(bufoff, gbase, voff) do { _Pragma("unroll") for (int _i = 0; _i < 2; ++_i) \
        __builtin_amdgcn_global_load_lds((const unsigned*)((const char*)(gbase) + (voff)[_i]), (PG8_LAS unsigned*)(lds + (bufoff) + ldsw + _i * 8192), 16, 0, 0); } while (0)
#define PG8_LDA(dst, b, h) do { _Pragma("unroll") for (int m = 0; m < 4; ++m) _Pragma("unroll") for (int k = 0; k < 2; ++k) dst[m][k] = *(const PG8_LAS h16x8*)(lds + PG8_SA(b, h) + aoff + m * 2048 + k * 1024); } while (0)
#define PG8_LDB(dst, b, h) do { _Pragma("unroll") for (int n = 0; n < 2; ++n) _Pragma("unroll") for (int k = 0; k < 2; ++k) dst[n][k] = *(const PG8_LAS h16x8*)(lds + PG8_SB(b, h) + boff + n * 2048 + k * 1024); } while (0)
#define PG8_MMA(ai, bj, At, Bt) do { __builtin_amdgcn_s_setprio(1); _Pragma("unroll") for (int m = 0; m < 4; ++m) _Pragma("unroll") for (int n = 0; n < 2; ++n) _Pragma("unroll") for (int k = 0; k < 2; ++k) \
        acc[ai][bj][m][n] = __builtin_amdgcn_mfma_f32_16x16x32_f16(Bt[n][k], At[m][k], acc[ai][bj][m][n], 0, 0, 0); __builtin_amdgcn_s_setprio(0); } while (0)
#define PG8_WAIT_V(n) asm volatile("s_waitcnt vmcnt(" #n ")" ::: "memory")
#define PG8_WAIT_L(n) asm volatile("s_waitcnt lgkmcnt(" #n ")" ::: "memory")
#define PG8_BAR __builtin_amdgcn_s_barrier()
#define PG8_SCHED __builtin_amdgcn_sched_barrier(0)
#define PG8_ROWOFF(u, o) do { _Pragma("unroll") for (int h_ = 0; h_ < 2; ++h_) _Pragma("unroll") for (int i_ = 0; i_ < 2; ++i_) { int row_ = (u).row0 + h_ * HALF + R0 + 64 * i_; \
        if ((u).job == 0 && gidx) row_ = gidx[row_]; (o)[h_][i_] = (unsigned)row_ * rowb + cshift; } } while (0)
    Unit cur, nxt; int ui = 0;
    if (!S.next(0, cur)) return;
    f32x4 acc[2][2][4][2];
#pragma unroll
    for (int a = 0; a < 2; ++a)
#pragma unroll
        for (int b = 0; b < 2; ++b)
#pragma unroll
            for (int m = 0; m < 4; ++m)
#pragma unroll
                for (int n = 0; n < 2; ++n) acc[a][b][m][n] = (f32x4){0.f, 0.f, 0.f, 0.f};
    h16x8 At[4][2], B0[2][2], B1[2][2];
    unsigned offA[2][2];
    PG8_ROWOFF(cur, offA);
    const char* cAj = cur.job ? S.j1.A : S.j0.A; const char* cB = S.b_base(cur);
    PG8_STAGE(PG8_SB(0, 0), cB, voffB); PG8_STAGE(PG8_SB(0, 1), cB + hstep, voffB); PG8_STAGE(PG8_SA(0, 0), cAj, offA[0]); PG8_STAGE(PG8_SA(0, 1), cAj, offA[1]);
    if (wr == 1) PG8_BAR;
    PG8_WAIT_V(2); PG8_BAR;
    PG8_STAGE(PG8_SB(1, 0), cB + kstep, voffB); PG8_STAGE(PG8_SA(1, 0), cAj + kstep, offA[0]); PG8_STAGE(PG8_SB(1, 1), cB + hstep + kstep, voffB);
    PG8_WAIT_V(6); PG8_BAR;
    for (;;) {
        const bool has_next = S.next(ui + 1, nxt);
        const char* nAj = has_next ? (nxt.job ? S.j1.A : S.j0.A) : cAj; const char* nB = has_next ? S.b_base(nxt) : cB;
        if (has_next) { unsigned offN[2][2]; PG8_ROWOFF(nxt, offN); *(PG8_LAS u32x4*)(lds + STAGE_BYTES + tid * 16) = (u32x4){offN[0][0], offN[0][1], offN[1][0], offN[1][1]}; }
        for (int t = 0; t < nt; t += 2) {
            const bool last = (t == nt - 2);
            const char* a1 = cAj + (size_t)(t + 1) * kstep;
            const char* b2 = last ? nB : cB + (size_t)(t + 2) * kstep; const char* b3 = b2 + kstep;
            PG8_LDB(B0, 0, 0); PG8_LDB(B1, 0, 1); PG8_SCHED; PG8_LDA(At, 0, 0); PG8_STAGE(PG8_SA(1, 1), a1, offA[1]);
            if (last) { if (has_next) { const u32x4 o_ = *(const PG8_LAS u32x4*)(lds + STAGE_BYTES + tid * 16); offA[0][0] = o_[0]; offA[0][1] = o_[1]; offA[1][0] = o_[2]; offA[1][1] = o_[3]; }
                cAj = nAj; }
            const char* a2 = last ? cAj : cAj + (size_t)(t + 2) * kstep; const char* a3 = a2 + kstep;
            PG8_WAIT_V(8); PG8_WAIT_L(0); PG8_BAR; PG8_MMA(0, 0, At, B0); PG8_MMA(0, 1, At, B1); PG8_BAR; PG8_SCHED;
            PG8_LDA(At, 0, 1); PG8_STAGE(PG8_SB(0, 0), b2, voffB); PG8_STAGE(PG8_SB(0, 1), b2 + hstep, voffB); PG8_STAGE(PG8_SA(0, 0), a2, offA[0]);
            PG8_WAIT_V(8); PG8_WAIT_L(0); PG8_BAR; PG8_MMA(1, 0, At, B0); PG8_MMA(1, 1, At, B1); PG8_BAR; PG8_SCHED;
            PG8_LDB(B0, 1, 0); PG8_LDB(B1, 1, 1); PG8_SCHED; PG8_LDA(At, 1, 0); PG8_STAGE(PG8_SA(0, 1), a2, offA[1]);
            PG8_WAIT_V(8); PG8_WAIT_L(0); PG8_BAR; PG8_MMA(0, 0, At, B0); PG8_MMA(0, 1, At, B1); PG8_BAR; PG8_SCHED;
            PG8_LDA(At, 1, 1); PG8_STAGE(PG8_SB(1, 0), b3, voffB); PG8_STAGE(PG8_SB(1, 1), b3 + hstep, voffB); PG8_STAGE(PG8_SA(1, 0), a3, offA[0]);
            PG8_WAIT_V(8); PG8_WAIT_L(0); PG8_BAR; PG8_MMA(1, 0, At, B0); PG8_MMA(1, 1, At, B1); PG8_BAR; PG8_SCHED;
        }
        if (wr == 0) PG8_BAR;
        E(acc, cur, wr, wc, fr, fq);
        if (!has_next) break;
        {
            h16x8 z8 = {0, 0, 0, 0, 0, 0, 0, 0}; asm volatile("" : "+v"(z8));
#pragma unroll
            for (int a = 0; a < 2; ++a)
#pragma unroll
                for (int b = 0; b < 2; ++b)
#pragma unroll
                    for (int m = 0; m < 4; ++m)
#pragma unroll
                        for (int n = 0; n < 2; ++n) acc[a][b][m][n] = __builtin_amdgcn_mfma_f32_16x16x32_f16(z8, z8, (f32x4){0.f, 0.f, 0.f, 0.f}, 0, 0, 0);
        }
        cur = nxt; cB = nB; ++ui;
        if (wr == 1) PG8_BAR;
    }
    PG8_WAIT_V(0);
    PG8_BAR;
#undef PG8_SA
#undef PG8_SB
#undef PG8_STAGE
#undef PG8_LDA
#undef PG8_LDB
#undef PG8_MMA
#undef PG8_WAIT_V
#undef PG8_WAIT_L
#undef PG8_BAR
#undef PG8_SCHED
#undef PG8_ROWOFF
}
}

DI void phase_topk_gather(PC p, int l, unsigned char* lds, int wid_) {
    int tidx = tid_from(wid_), bidx = blockIdx.x; asm volatile("" : "+v"(tidx), "+s"(bidx), "+s"(p));
    unsigned* hist = (unsigned*)lds;
    int* wtot = (int*)(lds + 4096);
    const float* aff = (const float*)(p->ws + WS_AFF);
    int* inv = (int*)(p->ws + WS_INV);
    float* gv = (float*)(p->ws + WS_GV);
    int* rowidx = (int*)(p->ws + WS_ROWIDX);
    const int nprob = (l == 3) ? 128 : 256;
    const int tid = tidx, wv = tid >> 6;
    const int lane = (int)__builtin_amdgcn_mbcnt_hi(~0u, __builtin_amdgcn_mbcnt_lo(~0u, 0u));
    for (int pb = bidx; pb < nprob; pb += gridDim.x) {
        const int s = pb >> 7, b = (pb >> 4) & 7, e = pb & 15;
        const int n = s ? CTXL : SEQ, cap = n >> 3;
        const int row0 = s ? ML + b * CTXL : b * SEQ;
        const bool wvalid = wv * 256 < n;
        const int m0 = row0 + wv * 256 + lane;
        unsigned v[4];
#pragma unroll
        for (int i = 0; i < 4; ++i) v[i] = wvalid ? __float_as_uint(aff[(size_t)(m0 + 64 * i) * NE + e]) : 0u;
        hist[tid] = 0u; hist[tid + 512] = 0u;
        __syncthreads();
        unsigned prefix = 0u; int need = cap;
#pragma unroll
        for (int ps = 0; ps < 4; ++ps) {
            const int shift = 24 - 8 * ps;
            unsigned* h = hist + ps * 256;
            if (wvalid) {
#pragma unroll
                for (int i = 0; i < 4; ++i) {
                    bool in = true;
                    if (ps > 0) in = ((v[i] ^ prefix) >> ((shift + 8) & 31)) == 0u;
                    if (in) atomicAdd(&h[(v[i] >> shift) & 255u], 1u);
                }
            }
            __syncthreads();
            const uint4 c = *(const uint4*)(h + lane * 4);
            const unsigned sl = c.x + c.y + c.z + c.w;
            unsigned S = sl;
#pragma unroll
            for (int d = 1; d < 64; d <<= 1) {
                const unsigned t = (unsigned)__builtin_amdgcn_ds_bpermute(((lane + d) & 63) * 4, (int)S);
                S += (lane + d < 64) ? t : 0u;
            }
            int a = (int)(S - sl), dsel = -1, nneed = 0;
            if (a < need && need <= a + (int)c.w) { dsel = 4 * lane + 3; nneed = need - a; } a += (int)c.w;
            if (a < need && need <= a + (int)c.z) { dsel = 4 * lane + 2; nneed = need - a; } a += (int)c.z;
            if (a < need && need <= a + (int)c.y) { dsel = 4 * lane + 1; nneed = need - a; } a += (int)c.y;
            if (a < need && need <= a + (int)c.x) { dsel = 4 * lane + 0; nneed = need - a; }
            const u64 bm = __ballot(dsel >= 0);
            const int srcl = (int)__builtin_ctzll(bm);
            dsel = __builtin_amdgcn_readlane(dsel, srcl); nneed = __builtin_amdgcn_readlane(nneed, srcl);
            prefix |= (unsigned)dsel << shift; need = nneed;
        }
        const unsigned T = prefix;
        u64 bg[4], bq[4];
        int wg = 0, wq = 0;
#pragma unroll
        for (int i = 0; i < 4; ++i) {
            bg[i] = __ballot(wvalid && v[i] > T); bq[i] = __ballot(wvalid && v[i] == T);
            wg += __builtin_popcountll(bg[i]); wq += __builtin_popcountll(bq[i]);
        }
        if (lane == 0) { wtot[wv * 2] = wg; wtot[wv * 2 + 1] = wq; }
        __syncthreads();
        int base_g = 0, base_q = 0, tot_g = 0;
#pragma unroll
        for (int w = 0; w < 8; ++w) {
            const int g_ = wtot[2 * w], q_ = wtot[2 * w + 1];
            tot_g += g_;
            if (w < wv) { base_g += g_; base_q += q_; }
        }
        const int pbase = s ? NE * NB * CAPL + e * NB * CAPC + b * CAPC : e * NB * CAPL + b * CAPL;
        if (wvalid) {
#pragma unroll
            for (int i = 0; i < 4; ++i) {
                const int m = m0 + 64 * i;
                int slot = -1;
                if (v[i] > T) slot = base_g + (int)__builtin_amdgcn_mbcnt_hi((unsigned)(bg[i] >> 32), __builtin_amdgcn_mbcnt_lo((unsigned)bg[i], 0u));
                else if (v[i] == T) {
                    const int r = base_q + (int)__builtin_amdgcn_mbcnt_hi((unsigned)(bq[i] >> 32), __builtin_amdgcn_mbcnt_lo((unsigned)bq[i], 0u));
                    if (r < need) slot = tot_g + r;
                }
                base_g += __builtin_popcountll(bg[i]); base_q += __builtin_popcountll(bq[i]);
                if (slot >= 0) { gv[pbase + slot] = __uint_as_float(v[i]); rowidx[pbase + slot] = m; inv[m * NE + e] = pbase + slot; }
                else inv[m * NE + e] = -1;
            }
        }
        __syncthreads();
    }
}
DI float fsig(float x) { return __builtin_amdgcn_rcpf(1.0f + __builtin_amdgcn_exp2f(-LOG2E * x)); }
DI f32x2 pk_fma(f32x2 a, f32x2 b, f32x2 c) { return __builtin_elementwise_fma(a, b, c); }
DI f32x2 pk_mul(f32x2 a, f32x2 b) { return a * b; }
DI f32x2 pk_add(f32x2 a, f32x2 b) { return a + b; }
DI f32x2 pk_one_minus_sq(f32x2 a, f32x2 one) { return __builtin_elementwise_fma(-a, a, one); }
DI void lru_ab_fast(float tr, float ti, float c8l, float xb, float& a, float& bb, float& la2) {
    const float r = __builtin_amdgcn_rcpf(1.0f + __builtin_amdgcn_exp2f(tr)), ig = __builtin_amdgcn_rcpf(1.0f + __builtin_amdgcn_exp2f(ti));
    la2 = c8l * r;
    a = __builtin_amdgcn_exp2f(la2);
    const float om = fmaxf(__builtin_fmaf(-a, a, 1.0f), 0.0f);
    bb = __builtin_amdgcn_sqrtf(om) * (ig * xb);
}
template <int MODE> DI void phase_lru1(PC p, int j, unsigned char* lds, int wid_) {
    int tidx = tid_from(wid_), bidx = blockIdx.x; asm volatile("" : "+v"(tidx), "+s"(bidx), "+s"(p));
    constexpr int XBS = 136;
    h16* XB = (h16*)lds;
    const int tid = tidx, lane = tid & 63, wv = tid >> 6, d = wv >> 2, w4 = wv & 3;
    unsigned* stg = (unsigned*)(lds + 17408) + wv * 512;
    const int blk = bidx & 7, nslot = gridDim.x >> 3;
    if (bidx >= nslot * 8) return;
    const h16* xr = (const h16*)(p->ws + WS_UB) + (size_t)MT * D;
    f32x2* agg = (f32x2*)(p->ws + WS_AGG);
    unsigned* ab16 = (unsigned*)(p->ws + WS_CSCR) + (size_t)d * MT * D + blk * 128 + 32 * w4 + (lane & 3) * 8;
    const h16* GT = (const h16*)(p->ws + W_GATE16) + (size_t)((j * 2 + d) * 8 + blk) * 256 * 128;
    h16x8 Bf[2][2][4];
#pragma unroll
    for (int ct = 0; ct < 2; ++ct)
#pragma unroll
        for (int g = 0; g < 2; ++g)
#pragma unroll
            for (int ks = 0; ks < 4; ++ks) Bf[ct][g][ks] = *(const h16x8*)(GT + (size_t)(g * 128 + 32 * w4 + 16 * ct + (lane & 15)) * 128 + ks * 32 + 8 * (lane >> 4));
    float gbr[2], gbi[2], c8[2];
    f32x2 nl2 = {-LOG2E, -LOG2E}, one2 = {1.0f, 1.0f}, k1024 = {1024.0f, 1024.0f};
    asm volatile("" : "+v"(nl2), "+v"(one2), "+v"(k1024));
#pragma unroll
    for (int ct = 0; ct < 2; ++ct) { const int chl = 32 * w4 + 16 * ct + (lane & 15);
        gbr[ct] = -LOG2E * p->lru_gate_b[((j * 2 + d) * 8 + blk) * 256 + chl]; gbi[ct] = -LOG2E * p->lru_gate_b[((j * 2 + d) * 8 + blk) * 256 + 128 + chl];
        c8[ct] = LOG2E * logsig8(p->lru_lambda[(j * 2 + d) * D + blk * 128 + chl]); }
    const float* cw = p->lru_conv_w + (size_t)j * 4 * D + blk * 128; const float* cb = p->lru_conv_b + (size_t)j * D + blk * 128;
    const bool rev = d != 0;
    const bool first16 = rev ? ((lane >> 4) & 1) != 0 : ((lane >> 4) & 1) == 0;
    const bool first32 = rev ? (lane >> 5) != 0 : (lane >> 5) == 0;
    const int c0 = (tid & 15) * 8, tl0 = tid >> 4;
    h16x8 pre[2][4];
#define LRU_ROWS(q_, row0_, t0_, ns_) const int b_##q_ = (q_) / 36, c_##q_ = (q_) % 36; \
        const int row0_ = c_##q_ < 4 ? ML + b_##q_ * CTXL + c_##q_ * 64 : b_##q_ * SEQ + (c_##q_ - 4) * 64, t0_ = c_##q_ < 4 ? c_##q_ * 64 : (c_##q_ - 4) * 64, ns_ = c_##q_ < 4 ? CTXL : SEQ;
#define LRU_CONV_LOAD(row0_, t0_, ns_) { _Pragma("unroll") for (int rep = 0; rep < 2; ++rep) _Pragma("unroll") for (int k = 0; k < 4; ++k) { \
            const int tl = tl0 + 32 * rep, tt = (t0_) + tl + k - 1; \
            pre[rep][k] = (tt >= 0 && tt < (ns_)) ? *(const h16x8*)(xr + (size_t)((row0_) + tl + k - 1) * D + blk * 128 + c0) : (h16x8){0, 0, 0, 0, 0, 0, 0, 0}; } }
#define LRU_CONV_STORE() { _Pragma("unroll") for (int rep = 0; rep < 2; ++rep) { float acc[8]; \
            { const f32x4 b0 = *(const f32x4*)(cb + c0), b1 = *(const f32x4*)(cb + c0 + 4); acc[0] = b0[0]; acc[1] = b0[1]; acc[2] = b0[2]; acc[3] = b0[3]; acc[4] = b1[0]; acc[5] = b1[1]; acc[6] = b1[2]; acc[7] = b1[3]; } \
            _Pragma("unroll") for (int k = 0; k < 4; ++k) { const f32x4 w0 = *(const f32x4*)(cw + k * D + c0), w1 = *(const f32x4*)(cw + k * D + c0 + 4); \
                _Pragma("unroll") for (int e = 0; e < 4; ++e) { acc[e] += w0[e] * (float)pre[rep][k][e]; acc[4 + e] += w1[e] * (float)pre[rep][k][4 + e]; } } \
            h16x8 o; _Pragma("unroll") for (int e = 0; e < 8; ++e) o[e] = (h16)acc[e]; \
            *(h16x8*)(XB + (tl0 + 32 * rep) * XBS + c0) = o; } }
    int q = bidx >> 3;
    if (q < NB * 36) { LRU_ROWS(q, r0a, t0a, nsa) LRU_CONV_LOAD(r0a, t0a, nsa) LRU_CONV_STORE() }
    for (; q < NB * 36; q += nslot) {
        const int b = q / 36, c = q % 36;
        const int row0 = c < 4 ? ML + b * CTXL + c * 64 : b * SEQ + (c - 4) * 64;
        __syncthreads();
        const int qn = q + nslot; const bool hasn = qn < NB * 36;
        if (hasn) { LRU_ROWS(qn, r0n, t0n, nsn) LRU_CONV_LOAD(r0n, t0n, nsn) }
        float Ac[2] = {1.f, 1.f}, Hc[2] = {0.f, 0.f};
#pragma unroll 1
        for (int k = 0; k < 4; ++k) {
            const int sc = rev ? 3 - k : k;
            f32x4 acc[2][2];
#pragma unroll
            for (int ct = 0; ct < 2; ++ct)
#pragma unroll
                for (int g = 0; g < 2; ++g) acc[ct][g] = (f32x4){0.f, 0.f, 0.f, 0.f};
#pragma unroll
            for (int ks = 0; ks < 4; ++ks) {
                const h16x8 af = *(const h16x8*)(XB + (sc * 16 + (lane & 15)) * XBS + ks * 32 + 8 * (lane >> 4));
#pragma unroll
                for (int ct = 0; ct < 2; ++ct)
#pragma unroll
                    for (int g = 0; g < 2; ++g) acc[ct][g] = __builtin_amdgcn_mfma_f32_16x16x32_f16(af, Bf[ct][g][ks], acc[ct][g], 0, 0, 0);
            }
#pragma unroll
            for (int ct = 0; ct < 2; ++ct) { const int chl = 32 * w4 + 16 * ct + (lane & 15);
                float av[4], bv[4];
                {
                    const f32x2 gbr2 = {gbr[ct], gbr[ct]}, gbi2 = {gbi[ct], gbi[ct]}, c82 = {c8[ct], c8[ct]};
#pragma unroll
                    for (int h = 0; h < 2; ++h) {
                        const f32x2 ar = {acc[ct][0][2 * h], acc[ct][0][2 * h + 1]}, ai = {acc[ct][1][2 * h], acc[ct][1][2 * h + 1]};
                        const f32x2 tr = pk_fma(ar, nl2, gbr2), ti = pk_fma(ai, nl2, gbi2);
                        const f32x2 er = {__builtin_amdgcn_exp2f(tr[0]), __builtin_amdgcn_exp2f(tr[1])}, ei = {__builtin_amdgcn_exp2f(ti[0]), __builtin_amdgcn_exp2f(ti[1])};
                        const f32x2 dr = pk_add(er, one2), di = pk_add(ei, one2);
                        const f32x2 rr = {__builtin_amdgcn_rcpf(dr[0]), __builtin_amdgcn_rcpf(dr[1])}, ig = {__builtin_amdgcn_rcpf(di[0]), __builtin_amdgcn_rcpf(di[1])};
                        const f32x2 la = pk_mul(rr, c82);
                        const f32x2 a2 = {__builtin_amdgcn_exp2f(la[0]), __builtin_amdgcn_exp2f(la[1])};
                        const f32x2 om = pk_one_minus_sq(a2, one2);
                        const f32x2 sq = {__builtin_amdgcn_sqrtf(__builtin_fabsf(om[0])), __builtin_amdgcn_sqrtf(__builtin_fabsf(om[1]))};
                        const int tk = 4 * (lane >> 4) + 2 * h;
                        const f32x2 xb2 = {(float)XB[(sc * 16 + tk) * XBS + chl], (float)XB[(sc * 16 + tk + 1) * XBS + chl]};
                        const f32x2 bb = pk_mul(sq, pk_mul(ig, xb2)), lk = pk_mul(la, k1024);
#pragma unroll
                        for (int e = 0; e < 2; ++e) { const h16x2 pk = {(h16)lk[e], (h16)bb[e]};
                            stg[(tk + e) * 32 + 16 * ct + (lane & 15)] = __builtin_bit_cast(unsigned, pk); av[2 * h + e] = a2[e]; bv[2 * h + e] = bb[e]; }
                    }
                }
                float A, H;
                if (!rev) { A = av[0]; H = bv[0];
#pragma unroll
                    for (int r = 1; r < 4; ++r) { H = av[r] * H + bv[r]; A *= av[r]; } }
                else { A = av[3]; H = bv[3];
#pragma unroll
                    for (int r = 2; r >= 0; --r) { H = av[r] * H + bv[r]; A *= av[r]; } }
                { const float Ao = shx(A, 16, lane), Ho = shx(H, 16, lane); const float Hn = first16 ? Ao * H + Ho : A * Ho + H; A *= Ao; H = Hn; }
                { const float Ao = shx(A, 32, lane), Ho = shx(H, 32, lane); const float Hn = first32 ? Ao * H + Ho : A * Ho + H; A *= Ao; H = Hn; }
                Hc[ct] = A * Hc[ct] + H; Ac[ct] *= A;
            }
            asm volatile("s_waitcnt lgkmcnt(0)" ::: "memory"); __builtin_amdgcn_wave_barrier();
            { const int tk = lane >> 2; const u32x4 s0 = *(const u32x4*)(stg + tk * 32 + (lane & 3) * 8), s1 = *(const u32x4*)(stg + tk * 32 + (lane & 3) * 8 + 4);
              unsigned* dst = ab16 + (size_t)(row0 + sc * 16 + tk) * D; *(u32x4*)dst = s0; *(u32x4*)(dst + 4) = s1; }
            asm volatile("s_waitcnt lgkmcnt(0)" ::: "memory"); __builtin_amdgcn_wave_barrier();
        }
        if ((lane >> 4) == 0) {
#pragma unroll
            for (int ct = 0; ct < 2; ++ct) agg[(size_t)((b * 2 + d) * 36 + c) * D + blk * 128 + 32 * w4 + 16 * ct + (lane & 15)] = (f32x2){Ac[ct], Hc[ct]};
        }
        __syncthreads();
        if (hasn) LRU_CONV_STORE()
    }
#undef LRU_ROWS
#undef LRU_CONV_LOAD
#undef LRU_CONV_STORE
}

DI void phase_lru2(PC p, unsigned char* lds, int wid_) {
    int tidx = tid_from(wid_), bidx = blockIdx.x; asm volatile("" : "+v"(tidx), "+s"(bidx), "+s"(p));
    const int tid = tidx, half = tid >> 8, t8 = tid & 255, sd = t8 >> 7, sch = t8 & 127;
    float* SH = (float*)lds + (size_t)half * (2 * 64 * 128);
    const int blk = bidx & 7, nslot = gridDim.x >> 3;
    if (bidx >= nslot * 8) return;
    const unsigned* ab = (const unsigned*)(p->ws + WS_CSCR);
    const float* carry = (const float*)(p->ws + WS_AGG + 4608 * 1024);
    const h16* yg = (const h16*)(p->ws + WS_UB);
    h16* sy = (h16*)(p->ws + WS_SYB);
    for (int q0 = bidx >> 3; q0 < NB * 36; q0 += 2 * nslot) {
        const int q = q0 + half * nslot; const bool live = q < NB * 36;
        const int qq = live ? q : q0, b = qq / 36, c = qq % 36;
        const int row0 = c < 4 ? ML + b * CTXL + c * 64 : b * SEQ + (c - 4) * 64;
        const unsigned* src = ab + (size_t)sd * MT * D + (size_t)row0 * D + blk * 128 + sch;
        unsigned pk[64];
#pragma unroll
        for (int t = 0; t < 64; ++t) pk[t] = src[(size_t)(sd == 0 ? t : 63 - t) * D];
        h16x8 ygv[4];
#pragma unroll
        for (int rep = 0; rep < 4; ++rep) { const int idx = t8 + rep * 256; ygv[rep] = *(const h16x8*)(yg + (size_t)(row0 + (idx >> 4)) * D + blk * 128 + (idx & 15) * 8); }
        float h = carry[(size_t)((b * 2 + sd) * 36 + c) * D + blk * 128 + sch];
        float* sw = SH + (size_t)sd * 64 * 128 + sch;
#pragma unroll
        for (int t = 0; t < 64; ++t) { const h16x2 v = __builtin_bit_cast(h16x2, pk[t]); const float a = __builtin_amdgcn_exp2f((float)v[0] * (1.0f / 1024.0f));
            h = a * h + (float)v[1]; sw[(sd == 0 ? t : 63 - t) * 128] = h; }
        __syncthreads();
        if (live) {
#pragma unroll
            for (int rep = 0; rep < 4; ++rep) {
                const int idx = t8 + rep * 256, tl = idx >> 4, c0 = (idx & 15) * 8;
                const h16x8 yv = ygv[rep];
                const float* s0p = SH + tl * 128 + c0; const float* s1p = s0p + 64 * 128;
                const f32x4 f0 = *(const f32x4*)s0p, f1 = *(const f32x4*)(s0p + 4), r0 = *(const f32x4*)s1p, r1 = *(const f32x4*)(s1p + 4);
                h16x8 o;
#pragma unroll
                for (int e = 0; e < 4; ++e) { o[e] = (h16)((f0[e] + r0[e]) * (float)yv[e]); o[4 + e] = (h16)((f1[e] + r1[e]) * (float)yv[4 + e]); }
                *(h16x8*)(sy + (size_t)(row0 + tl) * D + blk * 128 + c0) = o;
            }
        }
        __syncthreads();
    }
}

DI void phase_lru_carry(PC p, int wid_) {
    int tidx = tid_from(wid_), bidx = blockIdx.x; asm volatile("" : "+v"(tidx), "+s"(bidx), "+s"(p));
    const int gt = bidx * NT + tidx;
    if (gt >= NB * 2 * D) return;
    const int b = gt >> 11, d = (gt >> 10) & 1, ch = gt & 1023;
    const f32x2* ag = (const f32x2*)(p->ws + WS_AGG) + (size_t)((b * 2 + d) * 36) * D + ch;
    float* cr = (float*)(p->ws + WS_AGG + 4608 * 1024) + (size_t)((b * 2 + d) * 36) * D + ch;
    f32x2 v[36];
#pragma unroll
    for (int s2 = 0; s2 < 36; ++s2) { const int cc = d == 0 ? s2 : (s2 < 4 ? 3 - s2 : 39 - s2); v[s2] = ag[(size_t)cc * D]; }
    float h = 0.f;
#pragma unroll
    for (int s2 = 0; s2 < 36; ++s2) { const int cc = d == 0 ? s2 : (s2 < 4 ? 3 - s2 : 39 - s2); cr[(size_t)cc * D] = h; h = v[s2][0] * h + v[s2][1]; }
}

typedef float f32x16 __attribute__((ext_vector_type(16)));
typedef short s16x4 __attribute__((ext_vector_type(4)));
DI h16x4 vtr4(const __attribute__((address_space(3))) unsigned char* ptr) {
    return __builtin_bit_cast(h16x4, __builtin_amdgcn_ds_read_tr16_b64_v4i16((__attribute__((address_space(3))) s16x4*)ptr));
}
DI void phase_attn(PC p, int l, unsigned char* lds, int wid_) {
    int tidx = tid_from(wid_), bidx = blockIdx.x; asm volatile("" : "+v"(tidx), "+s"(bidx), "+s"(p));
    constexpr int KS = 272, VS = 320, KBUF = 64 * KS, VBUF = 64 * VS;
    typedef __attribute__((address_space(3))) unsigned char lds_t;
    lds_t* Kl = (lds_t*)lds; lds_t* Vl = Kl + 2 * KBUF;
    const int tid = tidx, lane = tid & 63, wv = tid >> 6, g = wv >> 1, th = wv & 1, r32 = lane & 31, hi = lane >> 5;
    const h16* qkv = (const h16*)(p->ws + WS_UB);
    h16* o = (h16*)(p->ws + WS_SYB);
    const int j = l >> 1;
    const int nitems = 512 + (l == 3 ? 0 : 64);
    const int srow = tid >> 3, sc = tid & 7;
    const int vtoff = (4 * hi + ((lane & 15) >> 2)) * VS + (16 * ((lane >> 4) & 1) + 4 * (lane & 3)) * 2;
    for (int it = bidx; it < nitems; it += gridDim.x) {
        int b, kvh, q0 = 0, qrow0, jlo = 0, nband = 0;
        if (it < 512) { b = it >> 6; kvh = (it >> 5) & 1; q0 = (it & 31) * 64; qrow0 = b * SEQ + q0;
            jlo = q0 == 0 ? 2 : (q0 == 64 ? 1 : 0); const int jhi = q0 == SEQ - 64 ? 2 : (q0 == SEQ - 128 ? 3 : 4); nband = jhi - jlo + 1; }
        else { const int r = it - 512; b = r >> 3; kvh = (r >> 2) & 1; qrow0 = ML + b * CTXL + (r & 3) * 64; }
        const int nt = nband + 4, hq = kvh * 4 + g, qi = 32 * th + r32;
        const int bandrow0 = b * SEQ + q0 - 128 + 64 * jlo, ctxrow0 = ML + b * CTXL;
        h16x8 qf[8];
        { const h16* qp = qkv + (size_t)(qrow0 + qi) * QKVW + hq * HD + 8 * hi;
#pragma unroll
          for (int ks = 0; ks < 8; ++ks) qf[ks] = *(const h16x8*)(qp + 16 * ks); }
        float m = p->attn_sink[j * NH + hq] * LOG2E, lsum = hi == 0 ? 1.0f : 0.0f;
        f32x16 O[4];
#pragma unroll
        for (int dt = 0; dt < 4; ++dt)
#pragma unroll
            for (int r = 0; r < 16; ++r) O[dt][r] = 0.f;
        u32x4 st[4];
        { const int krow = (nband > 0 ? bandrow0 : ctxrow0) + srow; const h16* kp = qkv + (size_t)krow * QKVW + 1024 + kvh * HD + sc * 8;
          st[0] = *(const u32x4*)kp; st[1] = *(const u32x4*)(kp + 64); st[2] = *(const u32x4*)(kp + 256); st[3] = *(const u32x4*)(kp + 256 + 64); }
        *(__attribute__((address_space(3))) u32x4*)(Kl + srow * KS + sc * 16) = st[0]; *(__attribute__((address_space(3))) u32x4*)(Kl + srow * KS + sc * 16 + 128) = st[1];
        *(__attribute__((address_space(3))) u32x4*)(Vl + srow * VS + sc * 16) = st[2]; *(__attribute__((address_space(3))) u32x4*)(Vl + srow * VS + sc * 16 + 128) = st[3];
        __syncthreads();
        asm volatile("" : "+v"(qf[0]), "+v"(qf[1]), "+v"(qf[2]), "+v"(qf[3]), "+v"(qf[4]), "+v"(qf[5]), "+v"(qf[6]), "+v"(qf[7]));
#pragma unroll 1
        for (int i = 0; i < nt; ++i) {
            const int buf = i & 1;
            if (i + 1 < nt) { const int krow = (i + 1 < nband ? bandrow0 + 64 * (i + 1) : ctxrow0 + 64 * (i + 1 - nband)) + srow; const h16* kp = qkv + (size_t)krow * QKVW + 1024 + kvh * HD + sc * 8;
                st[0] = *(const u32x4*)kp; st[1] = *(const u32x4*)(kp + 64); st[2] = *(const u32x4*)(kp + 256); st[3] = *(const u32x4*)(kp + 256 + 64); }
            const lds_t* Kb = Kl + buf * KBUF; const lds_t* Vb = Vl + buf * VBUF;
            f32x16 s0, s1;
#pragma unroll
            for (int r = 0; r < 16; ++r) { s0[r] = 0.f; s1[r] = 0.f; }
            {
#define AT_KLOAD(dst, kq) { _Pragma("unroll") for (int u_ = 0; u_ < 2; ++u_) { \
                    dst[2 * u_] = *(const __attribute__((address_space(3))) h16x8*)(Kb + r32 * KS + (16 * (2 * (kq) + u_) + 8 * hi) * 2); \
                    dst[2 * u_ + 1] = *(const __attribute__((address_space(3))) h16x8*)(Kb + (32 + r32) * KS + (16 * (2 * (kq) + u_) + 8 * hi) * 2); } }
#define AT_KMMA(src, kq) { _Pragma("unroll") for (int u_ = 0; u_ < 2; ++u_) { \
                    s0 = __builtin_amdgcn_mfma_f32_32x32x16_f16(src[2 * u_], qf[2 * (kq) + u_], s0, 0, 0, 0); \
                    s1 = __builtin_amdgcn_mfma_f32_32x32x16_f16(src[2 * u_ + 1], qf[2 * (kq) + u_], s1, 0, 0, 0); } }
                h16x8 ka[4], kb[4];
                AT_KLOAD(ka, 0) AT_KLOAD(kb, 1)
                __builtin_amdgcn_sched_barrier(0);
                AT_KMMA(ka, 0) AT_KLOAD(ka, 2)
                __builtin_amdgcn_sched_barrier(0);
                AT_KMMA(kb, 1) AT_KLOAD(kb, 3)
                __builtin_amdgcn_sched_barrier(0);
                AT_KMMA(ka, 2) AT_KMMA(kb, 3)
#undef AT_KLOAD
#undef AT_KMMA
            }
            if (i < nband) { const int jt = jlo + i;
                if (jt == 0) {
#pragma unroll
                    for (int r = 0; r < 16; ++r) { const int kv = (r & 3) + 8 * (r >> 2) + 4 * hi; if (kv < qi) s0[r] = -1e30f; if (kv + 32 < qi) s1[r] = -1e30f; } }
                else if (jt == 4) {
#pragma unroll
                    for (int r = 0; r < 16; ++r) { const int kv = (r & 3) + 8 * (r >> 2) + 4 * hi; if (kv > qi) s0[r] = -1e30f; if (kv + 32 > qi) s1[r] = -1e30f; } }
            }
            float mx = fmaxf(s0[0], s1[0]);
#pragma unroll
            for (int r = 1; r < 16; ++r) mx = fmaxf(mx, fmaxf(s0[r], s1[r]));
            mx = fmaxf(mx, shx(mx, 32, lane));
            const float mnew = fmaxf(m, mx), alpha = __builtin_amdgcn_exp2f(m - mnew);
            m = mnew;
            float rs = 0.f;
#pragma unroll
            for (int r = 0; r < 16; ++r) { s0[r] = __builtin_amdgcn_exp2f(s0[r] - mnew); s1[r] = __builtin_amdgcn_exp2f(s1[r] - mnew); rs += s0[r] + s1[r]; }
            lsum = lsum * alpha + rs;
            if (!__all(alpha == 1.0f)) {
#pragma unroll
                for (int dt = 0; dt < 4; ++dt)
#pragma unroll
                    for (int r = 0; r < 16; ++r) O[dt][r] *= alpha;
            }
            h16x8 pf[2][2];
#pragma unroll
            for (int s2 = 0; s2 < 2; ++s2)
#pragma unroll
                for (int e = 0; e < 8; ++e) { pf[0][s2][e] = (h16)s0[8 * s2 + e]; pf[1][s2][e] = (h16)s1[8 * s2 + e]; }
            {
#define AT_VLOAD(dst, q4) { _Pragma("unroll") for (int dt = 0; dt < 4; ++dt) { const lds_t* vp = Vb + vtoff + (16 * (q4)) * VS + 64 * dt; dst[dt][0] = vtr4(vp); dst[dt][1] = vtr4(vp + 8 * VS); } }
#define AT_VMMA(src, q4) { _Pragma("unroll") for (int dt = 0; dt < 4; ++dt) { const h16x4 v0 = src[dt][0], v1 = src[dt][1]; \
                    const h16x8 va = {v0[0], v0[1], v0[2], v0[3], v1[0], v1[1], v1[2], v1[3]}; \
                    O[dt] = __builtin_amdgcn_mfma_f32_32x32x16_f16(va, pf[(q4) >> 1][(q4) & 1], O[dt], 0, 0, 0); } }
                h16x4 vf[4][2], vg[4][2];
                AT_VLOAD(vf, 0) AT_VLOAD(vg, 1)
                __builtin_amdgcn_sched_barrier(0);
                AT_VMMA(vf, 0) AT_VLOAD(vf, 2)
                __builtin_amdgcn_sched_barrier(0);
                AT_VMMA(vg, 1) AT_VLOAD(vg, 3)
                __builtin_amdgcn_sched_barrier(0);
                AT_VMMA(vf, 2) AT_VMMA(vg, 3)
#undef AT_VLOAD
#undef AT_VMMA
            }
            if (i + 1 < nt) { const int nb = buf ^ 1;
                *(__attribute__((address_space(3))) u32x4*)(Kl + nb * KBUF + srow * KS + sc * 16) = st[0]; *(__attribute__((address_space(3))) u32x4*)(Kl + nb * KBUF + srow * KS + sc * 16 + 128) = st[1];
                *(__attribute__((address_space(3))) u32x4*)(Vl + nb * VBUF + srow * VS + sc * 16) = st[2]; *(__attribute__((address_space(3))) u32x4*)(Vl + nb * VBUF + srow * VS + sc * 16 + 128) = st[3]; }
            __syncthreads();
        }
        const float ltot = lsum + shx(lsum, 32, lane), inv = 1.0f / ltot;
        h16* op = o + (size_t)(qrow0 + qi) * D + hq * HD + 4 * hi;
#pragma unroll
        for (int dt = 0; dt < 4; ++dt)
#pragma unroll
            for (int rq = 0; rq < 4; ++rq) {
                const h16x4 ov = {(h16)(O[dt][4 * rq] * inv), (h16)(O[dt][4 * rq + 1] * inv), (h16)(O[dt][4 * rq + 2] * inv), (h16)(O[dt][4 * rq + 3] * inv)};
                *(h16x4*)(op + 32 * dt + 8 * rq) = ov;
            }
    }
}

#define LAS __attribute__((address_space(3)))
#define XB_TMO      128
#define XB_XCNT(j)  (256  + 64 * (j))
#define XB_XSUB(j)  (1280 + 64 * (j))
#define XB_XGEN(j)  (2304 + 64 * (j))
#define XB_TOP      3328
#define XB_TOPGEN   3392
#define XCD_BAR_WORDS 3456
#define XB_SPIN_CAP (1u << 22)
DI unsigned xb_ld(unsigned* p)              { return __hip_atomic_load(p, __ATOMIC_RELAXED, __HIP_MEMORY_SCOPE_AGENT); }
DI unsigned xb_add(unsigned* p, unsigned v) { return __hip_atomic_fetch_add(p, v, __ATOMIC_RELAXED, __HIP_MEMORY_SCOPE_AGENT); }
DI unsigned xb_xcc_id() { return (unsigned)__builtin_amdgcn_s_getreg((3 << 11) | 20) & 0xFu; }
#define XB_SPIN(cond, bar) do { unsigned _sp = 0; while (cond) { __builtin_amdgcn_s_sleep(1); \
    if ((++_sp & 255u) == 0u) { if (xb_ld(&(bar)[XB_TMO])) break; if (_sp > XB_SPIN_CAP) { atomicAdd(&(bar)[XB_TMO], 1u); break; } } } } while (0)
struct XcdBarrier { unsigned* bar; unsigned x; volatile LAS unsigned* st; };
DI XcdBarrier xcd_barrier_post(unsigned* bar, volatile LAS unsigned* st) {
    XcdBarrier b; b.bar = bar; b.x = xb_xcc_id(); b.st = st;
    if (threadIdx.x == 0) (void)xb_add(&bar[XB_XCNT(b.x)], 1u);
    return b;
}
DI void xcd_barrier_complete(unsigned* bar, unsigned x, unsigned& nloc, unsigned& nx) {
    const unsigned G = gridDim.x * gridDim.y * gridDim.z;
    unsigned sum, cnt, mine, sp = 0u;
    for (;;) {
        sum = 0u; cnt = 0u; mine = 0u;
#pragma unroll
        for (unsigned j = 0; j < 16; ++j) { const unsigned c = xb_ld(&bar[XB_XCNT(j)]); sum += c; cnt += (c > 0u) ? 1u : 0u; mine = (j == x) ? c : mine; }
        if (sum == G) break;
        __builtin_amdgcn_s_sleep(1);
        if ((++sp & 255u) == 0u) { if (xb_ld(&bar[XB_TMO])) break; if (sp > XB_SPIN_CAP) { atomicAdd(&bar[XB_TMO], 1u); break; } }
    }
    nloc = mine > 0u ? mine : 1u; nx = cnt > 0u ? cnt : 1u;
}
DI void xcd_barrier(const XcdBarrier& b, int wid_) {
    asm volatile("s_waitcnt vmcnt(0)" ::: "memory");
    __syncthreads();
    if (tid_from(wid_) == 0) {
        unsigned* bar = b.bar;
        __builtin_amdgcn_s_waitcnt(0);
        unsigned nloc = b.st[0], nx = b.st[1];
        if (nloc == 0u) { xcd_barrier_complete(bar, b.x, nloc, nx); b.st[0] = nloc; b.st[1] = nx; }
        const unsigned old = xb_add(&bar[XB_XSUB(b.x)], 1u);
        const unsigned gen = old / nloc;
        if (old + 1u == (gen + 1u) * nloc) {
            __builtin_amdgcn_fence(__ATOMIC_RELEASE, "agent");
            asm volatile("s_waitcnt vmcnt(0)" ::: "memory");
            const unsigned og = xb_add(&bar[XB_TOP], 1u);
            const unsigned tg = og / nx;
            if (og + 1u == (tg + 1u) * nx) xb_add(&bar[XB_TOPGEN], 1u);
            else XB_SPIN(xb_ld(&bar[XB_TOPGEN]) == tg, bar);
            __builtin_amdgcn_fence(__ATOMIC_ACQUIRE, "agent");
            xb_add(&bar[XB_XGEN(b.x)], 1u);
            asm volatile("s_waitcnt vmcnt(0)" ::: "memory");
        } else {
            XB_SPIN(xb_ld(&bar[XB_XGEN(b.x)]) == gen, bar);
            __builtin_amdgcn_fence(__ATOMIC_ACQUIRE, "agent");
            asm volatile("s_waitcnt vmcnt(0)" ::: "memory");
        }
    }
    __syncthreads();
}
constexpr int CW_BAR = 4096;
constexpr int MISC_OFF = 147456 - 256;

#ifndef DUP_MASK
#define DUP_MASK 0
#endif
#define BAR(kind) xcd_barrier(bar, wid_)
#define REP(kind) for (int rep_ = 0; rep_ < (((DUP_MASK) >> (kind)) & 1) + 1; ++rep_)
template <int l> DI void run_layers(PC p, unsigned char* lds, const XcdBarrier& bar, int wid_) {
    const h16* hb = (const h16*)(p->ws + WS_HB);
    LAS unsigned char* l3 = (LAS unsigned char*)lds;
    const int G = gridDim.x, bid = blockIdx.x;
    const float* modp = (const float*)(p->ws + WS_MOD);
    {
        const int j = l >> 1;
        const pg8::Job nojob{0, 1, 0, 0, nullptr, nullptr, 0};
        if ((l & 1) == 0) {
            REP(2) { pg8::Sched S; S.init(pg8::Job{MT / 256, 8, 0, 0, (const char*)hb, (const char*)(p->ws + W_IN_T + (size_t)j * 2048 * D * 2), 0}, nojob, G, bid, D);
              pg8::EpiLruIn E{(h16*)(p->ws + WS_UB), (h16*)(p->ws + WS_UB) + (size_t)MT * D}; pg8::gemm_phase(l3, S, E, wid_);
              if (!rep_ && bid >= 64) conv_fill(p, lds, l, cv_p(l) + cv_prev(l) + (bid - 64) * FQ_A, FQ_A, wid_); BAR(2); }
#ifdef LRU_ABL
            phase_lru1<LRU_ABL>(p, j, lds, wid_); BAR(3);
#endif
            REP(3) { phase_lru1<0>(p, j, lds, wid_); BAR(3); phase_lru_carry(p, wid_); BAR(3); }
            REP(4) { phase_lru2(p, lds, wid_); BAR(4); }
        } else {
            REP(6) { pg8::Sched S; S.init(pg8::Job{MT / 256, 6, 0, 0, (const char*)hb, (const char*)(p->ws + W_QKV_T + (size_t)j * QKVW * D * 2), 0}, nojob, G, bid, D);
              pg8::EpiQKV E{(h16*)(p->ws + WS_UB), (const f32x2*)(p->ws + WS_ROPE)}; pg8::gemm_phase(l3, S, E, wid_);
              if (!rep_ && bid >= 176) conv_fill(p, lds, l, cv_p(l) + cv_prev(l) + (bid - 176) * FQ_A, FQ_A, wid_); BAR(6); }
            REP(7) { phase_attn(p, l, lds, wid_);
              if (!rep_ && l != DEPTH - 1 && bid >= 64) conv_fill(p, lds, l, cv_p(l) + cv_prev(l) + SEG_A_ATT + (bid - 64) * FQ_AT, FQ_AT, wid_); BAR(7); }
        }
        REP(5) {
#pragma unroll 1
            for (int part = 0; part < 3; ++part) {
                if (part == 2 && l == DEPTH - 1) break;
                const bool ctxp = (l < DEPTH - 1);
                const int gG = part == 0 ? G : (part == 1 && ctxp ? (G < 32 ? G : 32) : 0);
                const int gnM = part == 0 ? ML / 256 : (part == 1 && ctxp ? MC / 256 : 0), gpm0 = part == 0 ? 0 : ML / 256;
                if (gnM > 0 && bid < gG) {
                    pg8::Sched S; S.init(pg8::Job{gnM, 4, gpm0, 0, (const char*)(p->ws + WS_SYB), (const char*)(p->ws + ((l & 1) ? W_O_T : W_OUT_T) + (size_t)j * D * D * 2), 0}, nojob, gG, bid, D);
                    pg8::EpiResid E{(h16*)(p->ws + (rep_ ? WS_CSCR : WS_XRES)), modp + (size_t)l * 9 * 6144 + 2048}; pg8::gemm_phase(l3, S, E, wid_);
                } else if (part > 0 && !rep_) {
                    const int cu_lo = (part == 1 && ctxp) ? gG : 0;
                    phase_norm2(p, l, lds, cu_lo, G - cu_lo, part == 1 ? 0 : ML, part == 1 ? ML : MT, wid_);
                }
                BAR(5);
            }
        }
        REP(10) { phase_topk_gather(p, l, lds, wid_);
            if (!rep_ && bid >= 128) conv_fill(p, lds, l + 1, cv_p((l + 1) & 3) + (bid - 128) * FQ_T, FQ_T, wid_); BAR(10); }
        REP(11) {
#pragma unroll 1
            for (int part = 0; part < 3; ++part) {
                const bool last = (l == DEPTH - 1);
                if (part == 2 && last) break;
                const int tpe = last ? 8 : 9;
                const int m1n = part == 0 ? 128 : (part == 1 && !last ? 16 : 0), m1p = part == 0 ? 0 : 128;
                const int m2n = part == 0 ? 0 : (part == 1 ? (last ? 128 : 96) : 48), m2p = part == 1 ? 0 : 96;
                pg8::Sched S; S.init(pg8::Job{m1n, 8, m1p, tpe, (const char*)hb, (const char*)(p->ws + W_GU_T + (size_t)l * NE * 2048 * D * 2), (size_t)2048 * D * 2},
                                     pg8::Job{m2n, 4, m2p, tpe, (const char*)(p->ws + WS_ACT), (const char*)(p->ws + W_DN_T + (size_t)l * NE * D * FF * 2), (size_t)D * FF * 2}, G, bid, D);
                pg8::EpiMoeMix E{pg8::EpiMoe1{(h16*)(p->ws + WS_ACT), (const float*)(p->ws + WS_GV)}, pg8::EpiF16{(h16*)(p->ws + WS_YO), D}};
                pg8::gemm_phase_g(l3, S, E, (const int*)(p->ws + WS_ROWIDX), wid_);
                if (!rep_ && part == 2 && bid >= 192) conv_fill(p, lds, l + 1, cv_p((l + 1) & 3) + SEG_T + (bid - 192) * FQ_Z, FQ_Z, wid_);
                BAR(11);
            }
        }
        REP(13) { if (rep_) BAR(13); }
        phase_rowfin(p, l, lds, wid_);
        if (l < DEPTH - 1) BAR(1);
    }
    if constexpr (l + 1 < DEPTH) run_layers<l + 1>(p, lds, bar, wid_);
}
__global__ void __launch_bounds__(NT, 2) k_main(P p_unused) {
    PC p = (PC)__builtin_amdgcn_kernarg_segment_ptr();
    extern __shared__ __attribute__((aligned(16))) unsigned char lds[];
    volatile LAS unsigned* misc = (volatile LAS unsigned*)((LAS unsigned char*)lds + MISC_OFF);
    if (threadIdx.x < 64) misc[threadIdx.x] = 0u;
    __syncthreads();
    const XcdBarrier bar = xcd_barrier_post((unsigned*)(p->ws + WS_CTL) + CW_BAR, misc + 8);
    const int wid_ = __builtin_amdgcn_readfirstlane((int)threadIdx.x >> 6);
    REP(0) { phase_mod(p, lds, wid_); phase_convw(p, lds, wid_); BAR(0); }
    REP(1) { phase_rowfin(p, 255, lds, wid_); BAR(1); }
    run_layers<0>(p, lds, bar, wid_);
}
#undef REP
#undef BAR

extern "C" void kernel_launch(void* const* d_in, const int* in_sizes, int n_in, void* d_out, int out_size, void* d_ws, size_t ws_size, hipStream_t stream) {
    static int grid = 0;
    if (grid == 0) {
        if (n_in != 23 || out_size != ML * D || ws_size < WS_END) { fprintf(stderr, "kernel_launch: unexpected sizes n_in %d out %d ws %zu\n", n_in, out_size, ws_size); grid = -1; return; }
        int dev = 0, cus = 0, per_cu = 0;
        if (hipGetDevice(&dev) != hipSuccess || hipDeviceGetAttribute(&cus, hipDeviceAttributeMultiprocessorCount, dev) != hipSuccess) { grid = -1; return; }
        if (hipFuncSetAttribute((const void*)k_main, hipFuncAttributeMaxDynamicSharedMemorySize, LDS_BYTES) != hipSuccess) { fprintf(stderr, "hipFuncSetAttribute failed\n"); grid = -1; return; }
        if (hipOccupancyMaxActiveBlocksPerMultiprocessor(&per_cu, (const void*)k_main, NT, LDS_BYTES) != hipSuccess || per_cu < 1) { fprintf(stderr, "occupancy query says %d blocks/CU; not launching\n", per_cu); grid = -1; return; }
        (void)hipGetLastError();
        grid = cus;
    }
    if (grid < 0) return;
    P p{};
    const float** pp = (const float**)&p;
    for (int i = 0; i < 23; ++i) pp[i] = (const float*)d_in[i];
    p.out = (float*)d_out; p.ws = (unsigned char*)d_ws;
    (void)hipMemsetAsync((char*)d_ws + WS_CTL, 0, 1 * MiB, stream);
    hipLaunchKernelGGL(k_main, dim3(grid), dim3(NT), LDS_BYTES, stream, p);
}
```

```cpp
#include <hip/hip_runtime.h>
#include <stdint.h>
#include <stdio.h>

#define DI __device__ __forceinline__
typedef _Float16 h16;
typedef _Float16 h16x2 __attribute__((ext_vector_type(2)));
typedef _Float16 h16x4 __attribute__((ext_vector_type(4)));
typedef _Float16 h16x8 __attribute__((ext_vector_type(8)));
typedef float f32x2 __attribute__((ext_vector_type(2)));
typedef float f32x4 __attribute__((ext_vector_type(4)));
typedef unsigned u32x4 __attribute__((ext_vector_type(4)));
typedef unsigned u32x2 __attribute__((ext_vector_type(2)));
typedef unsigned long long u64;

constexpr int D = 1024, NB = 8, SEQ = 2048, CTXL = 256, DEPTH = 4;
constexpr int ML = NB * SEQ, MC = NB * CTXL, MT = ML + MC;
constexpr int NE = 16, FF = 1024, CAPL = 256, CAPC = 32;
constexpr int PPE = NB * CAPL + NB * CAPC;
constexpr int NPAIR = NE * PPE;
constexpr int NH = 8, HD = 128, NKV = 2, QKVW = 1536;
constexpr int NT = 512;
constexpr float EPS = 1e-6f;
constexpr float QSCALE = 0.08838834764831845f * 1.4426950408889634f;
constexpr float LOG2E = 1.4426950408889634f;

constexpr size_t MiB = 1u << 20;
constexpr size_t WS_CTL = 0;
constexpr size_t WS_MOD = 1 * MiB;
constexpr size_t WS_ROPE = 2 * MiB;
constexpr size_t WS_AFF = 3 * MiB;
constexpr size_t WS_INV = 5 * MiB;
constexpr size_t WS_ROWIDX = 7 * MiB;
constexpr size_t WS_GV = 8 * MiB;
constexpr size_t WS_AGG = 9 * MiB;
constexpr size_t WS_XRES = 16 * MiB;
constexpr size_t WS_HB = 88 * MiB;
constexpr size_t WS_UB = 124 * MiB;
constexpr size_t WS_SYB = 196 * MiB;
constexpr size_t WS_ACT = 232 * MiB;
constexpr size_t WS_YO = 304 * MiB;
constexpr size_t WS_CSCR = 376 * MiB;
constexpr size_t WS_W16 = 520 * MiB;
constexpr size_t WS_END = 1024 * MiB;

struct P {
    const float *x, *c, *ctx, *c_ctx, *ada_w, *ada_b, *norm1_g, *norm2_g;
    const float *lru_w_in, *lru_conv_w, *lru_conv_b, *lru_gate_w, *lru_gate_b, *lru_lambda, *lru_w_out;
    const float *attn_w_qkv, *attn_sink, *attn_w_o, *moe_router, *moe_w_gate, *moe_w_up, *moe_w_down, *final_g;
    float* out; unsigned char* ws;
};
typedef const P __attribute__((address_space(4)))* PC;
struct Prog { unsigned char kind[96]; unsigned char layer[96]; int n; int pad; };

enum Kind : unsigned char {
    K_MOD = 1, K_ROWFIN, K_NG_IN, K_EPI_IN, K_CONV, K_SCAN, K_NG_OUT, K_EPI_RES, K_NG_QKV, K_EPI_QKV, K_ATTN, K_NG_O,
    K_NORM2, K_TOPK, K_NG_MOE1, K_NG_MOE2, K_EPI_YO
};

DI int row_modr(int m) { return m < ML ? (m >> 11) : 8; }
DI float shx(float v, int m, int lane) { return __int_as_float(__builtin_amdgcn_ds_bpermute((lane ^ m) << 2, __float_as_int(v))); }
template <int CTRL> DI float dpp_f(float v) { return __int_as_float(__builtin_amdgcn_update_dpp(0, __float_as_int(v), CTRL, 0xF, 0xF, true)); }
constexpr int DPP_X1 = 0xB1, DPP_X2 = 0x4E, DPP_ROR4 = 0x124, DPP_ROR8 = 0x128;
DI void swap16(float a, float b, float& r0, float& r1) { const auto r = __builtin_amdgcn_permlane16_swap(__float_as_uint(a), __float_as_uint(b), false, false); r0 = __uint_as_float(r[0]); r1 = __uint_as_float(r[1]); }
DI void swap32(float a, float b, float& r0, float& r1) { const auto r = __builtin_amdgcn_permlane32_swap(__float_as_uint(a), __float_as_uint(b), false, false); r0 = __uint_as_float(r[0]); r1 = __uint_as_float(r[1]); }
DI float sum_x16(float v) { float a, b; swap16(v, v, a, b); return a + b; }
DI float sum_x32(float v) { float a, b; swap32(v, v, a, b); return a + b; }
DI float max_x16(float v) { float a, b; swap16(v, v, a, b); return fmaxf(a, b); }
DI float max_x32(float v) { float a, b; swap32(v, v, a, b); return fmaxf(a, b); }
DI float get_x16(float v, int lane) { float a, b; swap16(v, v, a, b); return (lane & 16) ? a : b; }
DI float get_x32(float v, int lane) { float a, b; swap32(v, v, a, b); return (lane & 32) ? a : b; }
DI float wave_sum(float v, int lane) {
    v += dpp_f<DPP_X1>(v); v += dpp_f<DPP_X2>(v); v += dpp_f<DPP_ROR4>(v); v += dpp_f<DPP_ROR8>(v);
    return sum_x32(sum_x16(v));
}
DI float wave_max(float v, int lane) {
    v = fmaxf(v, dpp_f<DPP_X1>(v)); v = fmaxf(v, dpp_f<DPP_X2>(v)); v = fmaxf(v, dpp_f<DPP_ROR4>(v)); v = fmaxf(v, dpp_f<DPP_ROR8>(v));
    return max_x32(max_x16(v));
}
DI float fast_exp(float x) { return __builtin_amdgcn_exp2f(x * LOG2E); }
DI float sigmoidf_(float x) { return __builtin_amdgcn_rcpf(1.0f + __builtin_amdgcn_exp2f(-LOG2E * x)); }
DI float siluf_(float x) { return x * sigmoidf_(x); }
DI float gelu_tanh(float x) {
    const float z2 = x * (1.5957691216057308f + 0.07135481627f * x * x);
    return x * __builtin_amdgcn_rcpf(1.0f + __builtin_amdgcn_exp2f(-LOG2E * z2));
}
DI int tid_from(int wid) { unsigned m = ~0u; asm volatile("" : "+s"(m), "+s"(wid)); return wid * 64 + (int)__builtin_amdgcn_mbcnt_hi(m, __builtin_amdgcn_mbcnt_lo(m, 0u)); }
DI float logsig8(float lam) {
    const float e = fast_exp(-lam);
    float l1p;
    if (e < 0.03f) l1p = e * (1.0f - e * (0.5f - e * (0.33333333f - e * (0.25f - e * 0.2f))));
    else l1p = __builtin_amdgcn_logf(1.0f + e) * 0.6931471805599453f;
    return -8.0f * l1p;
}
DI float neg_expm1(float z) {
    if (z > -0.25f) { const float p = z * (1.0f + z * (0.5f + z * (0.16666667f + z * (0.041666667f + z * (0.0083333333f + z * 0.0013888889f))))); return -p; }
    return 1.0f - fast_exp(z);
}
DI void lru_ab(float pr, float pi, float c8, float xb, float& a, float& bb) {
    const float r = sigmoidf_(pr), ig = sigmoidf_(pi);
    const float la = c8 * r;
    a = fast_exp(la);
    bb = sqrtf(neg_expm1(2.0f * la)) * (ig * xb);
}

DI void phase_mod(PC p, unsigned char* lds, int wid_) {
    int tidx = tid_from(wid_), bidx = blockIdx.x; asm volatile("" : "+v"(tidx), "+s"(bidx), "+s"(p));
    float* s = (float*)lds;
    float* red = s + 9 * 1024;
    const int tid = tidx;
    {
        const float* cp = p->c; const float* ccp = p->c_ctx; float cv[18];
#pragma unroll
        for (int it = 0; it < 18; ++it) { const int r = it >> 1, k = tid + NT * (it & 1); cv[it] = r < 8 ? cp[r * 1024 + k] : ccp[k]; }
#pragma unroll
        for (int it = 0; it < 18; ++it) s[(it >> 1) * 1024 + tid + NT * (it & 1)] = siluf_(cv[it]);
    }
    __syncthreads();
    float* mod = (float*)(p->ws + WS_MOD);
    const int nchunk = DEPTH * 6144 / 32;
    const int kq = tid >> 3, cq = (tid & 7) * 4;
    const float* adaw = p->ada_w; const float* adab = p->ada_b;
    f32x4 wn[16];
    if (bidx < nchunk) { const int l = bidx / 192, n0 = (bidx % 192) * 32; const float* w = adaw + (size_t)l * 1024 * 6144 + n0 + cq;
#pragma unroll
        for (int i = 0; i < 16; ++i) wn[i] = __builtin_nontemporal_load((const f32x4*)(w + (size_t)(kq + 64 * i) * 6144)); }
    for (int ch = bidx; ch < nchunk; ch += gridDim.x) {
        const int l = ch / 192, n0 = (ch % 192) * 32;
        f32x4 wv[16];
#pragma unroll
        for (int i = 0; i < 16; ++i) wv[i] = wn[i];
        { const int chn = ch + (int)gridDim.x; if (chn < nchunk) { const int ln = chn / 192, nn0 = (chn % 192) * 32; const float* w = adaw + (size_t)ln * 1024 * 6144 + nn0 + cq;
#pragma unroll
            for (int i = 0; i < 16; ++i) wn[i] = __builtin_nontemporal_load((const f32x4*)(w + (size_t)(kq + 64 * i) * 6144)); } }
        f32x4 acc[9];
#pragma unroll
        for (int r = 0; r < 9; ++r) acc[r] = (f32x4){0.f, 0.f, 0.f, 0.f};
#pragma unroll
        for (int i = 0; i < 16; ++i)
#pragma unroll
            for (int r = 0; r < 9; ++r) acc[r] += wv[i] * s[r * 1024 + kq + 64 * i];
#pragma unroll
        for (int r = 0; r < 9; ++r) *(f32x4*)(red + (kq * 9 + r) * 32 + cq) = acc[r];
        __syncthreads();
        if (tid < 288) {
            const int r = tid >> 5, cc = tid & 31; float v = 0.f;
#pragma unroll 8
            for (int q = 0; q < 64; ++q) v += red[(q * 9 + r) * 32 + cc];
            mod[((size_t)l * 9 + r) * 6144 + n0 + cc] = v + adab[l * 6144 + n0 + cc];
        }
        __syncthreads();
    }
    if (bidx == gridDim.x - 1) {
        f32x2* tab = (f32x2*)(p->ws + WS_ROPE);
        for (int idx = tid; idx < 64 * 32; idx += NT) {
            const int pos = idx >> 5, i = idx & 31;
            double f = 1.0; for (int q = 0; q < i; ++q) f *= 0.74989420933245582730;
            const double xa = (double)pos * f;
            const double n = __builtin_rint(xa * 0.63661977236758134308);
            const double r = (xa - n * 1.5707963267948966192) - n * 6.123233995736766e-17;
            const double r2 = r * r;
            double sn = r * (1.0 + r2 * (-1.0 / 6 + r2 * (1.0 / 120 + r2 * (-1.0 / 5040 + r2 * (1.0 / 362880 + r2 * (-1.0 / 39916800 + r2 * (1.0 / 6227020800.0)))))));
            double cs = 1.0 + r2 * (-0.5 + r2 * (1.0 / 24 + r2 * (-1.0 / 720 + r2 * (1.0 / 40320 + r2 * (-1.0 / 3628800 + r2 * (1.0 / 479001600.0 + r2 * (-1.0 / 87178291200.0)))))));
            const int q = ((int)n) & 3;
            double cv, sv;
            if (q == 0) { cv = cs; sv = sn; } else if (q == 1) { cv = -sn; sv = cs; } else if (q == 2) { cv = -cs; sv = -sn; } else { cv = sn; sv = -cs; }
            tab[idx] = (f32x2){(float)cv, (float)sv};
        }
    }
}

DI void rowfin_finish(PC p, int l, bool pro, int m, f32x4 (&v)[4], int lane, const float* T) {
    h16* xres = (h16*)(p->ws + WS_XRES);
    h16* hb = (h16*)(p->ws + WS_HB);
    float ss = 0.f;
#pragma unroll
    for (int j = 0; j < 4; ++j) ss += (v[j][0] * v[j][0] + v[j][1] * v[j][1]) + (v[j][2] * v[j][2] + v[j][3] * v[j][3]);
    ss = wave_sum(ss, lane);
    const float rs = __builtin_amdgcn_rsqf(ss * (1.0f / D) + EPS);
    const float* tb = T + (size_t)row_modr(m) * 3 * D + 4 * lane;
    if (!pro && l == 3) {
#pragma unroll
        for (int j = 0; j < 4; ++j) { const f32x4 g = *(const f32x4*)(tb + 256 * j); *(f32x4*)(p->out + (size_t)m * D + 4 * lane + 256 * j) = v[j] * rs * g; }
    } else {
#pragma unroll
        for (int j = 0; j < 4; ++j) {
            const f32x4 g = *(const f32x4*)(tb + 256 * j), sh = *(const f32x4*)(tb + D + 256 * j);
            const f32x4 h = (v[j] * rs) * g + sh;
            *(h16x4*)(xres + (size_t)m * D + 4 * lane + 256 * j) = (h16x4){(h16)v[j][0], (h16)v[j][1], (h16)v[j][2], (h16)v[j][3]};
            *(h16x4*)(hb + (size_t)m * D + 4 * lane + 256 * j) = (h16x4){(h16)h[0], (h16)h[1], (h16)h[2], (h16)h[3]};
        }
    }
}
DI void phase_rowfin(PC p, int l  , unsigned char* lds, int wid_) {
    int tidx = tid_from(wid_), bidx = blockIdx.x; asm volatile("" : "+v"(tidx), "+s"(bidx), "+s"(p));
    const int lane = tidx & 63, wv = tidx >> 6;
    const int gw = bidx * 8 + wv, ngw = gridDim.x * 8;
    const bool pro = (l == 255);
    const h16* xres = (const h16*)(p->ws + WS_XRES);
    const float* mod = (const float*)(p->ws + WS_MOD);
    const int* inv = (const int*)(p->ws + WS_INV);
    const h16* yo = (const h16*)(p->ws + WS_YO);
    const int mend = (!pro && l == 3) ? ML : MT;
    float* T = (float*)lds;
    { const bool fin = (!pro && l == 3); const int nl = pro ? 0 : l + 1;
      const float* gsrc = fin ? p->final_g : p->norm1_g + nl * D;
      const float* mbn = mod + (size_t)nl * 9 * 6144; const float* mbl = mod + (size_t)(pro ? 0 : l) * 9 * 6144 + 5120;
      float gk[2], scv[18], shv[18], g2v[18];
#pragma unroll
      for (int h = 0; h < 2; ++h) gk[h] = gsrc[tidx + NT * h];
#pragma unroll
      for (int it = 0; it < 18; ++it) { const int r = it >> 1, k = tidx + NT * (it & 1);
          scv[it] = fin ? 0.f : mbn[(size_t)r * 6144 + 1024 + k]; shv[it] = fin ? 0.f : mbn[(size_t)r * 6144 + k]; g2v[it] = pro ? 0.f : mbl[(size_t)r * 6144 + k]; }
#pragma unroll
      for (int it = 0; it < 18; ++it) { const int r = it >> 1, k = tidx + NT * (it & 1);
          T[(r * 3 + 0) * D + k] = fin ? gk[it & 1] : gk[it & 1] * (1.0f + scv[it]); T[(r * 3 + 1) * D + k] = shv[it]; T[(r * 3 + 2) * D + k] = g2v[it]; }
      __syncthreads(); }
    f32x4 n0[4], n1[4]; h16x4 ny0[4], ny1[4]; int npe0 = -1, npe1 = -1, qpe0 = -1, qpe1 = -1;
#pragma unroll
    for (int j = 0; j < 4; ++j) { ny0[j] = (h16x4){0, 0, 0, 0}; ny1[j] = ny0[j]; }
#define RF_INV(M0, d0, d1) { const int a_ = (M0), b_ = (a_ + ngw) < mend ? a_ + ngw : a_; d0 = -1; d1 = -1; \
        if (!pro && a_ < mend) { d0 = lane < NE ? inv[a_ * NE + lane] : -1; d1 = lane < NE ? inv[b_ * NE + lane] : -1; } }
#define RF_LOAD(M0) { const int a_ = (M0), b_ = (a_ + ngw) < mend ? a_ + ngw : a_; \
        if (pro) { const float* s0_ = a_ < ML ? p->x + (size_t)a_ * D : p->ctx + (size_t)(a_ - ML) * D; const float* s1_ = b_ < ML ? p->x + (size_t)b_ * D : p->ctx + (size_t)(b_ - ML) * D; \
            _Pragma("unroll") for (int j = 0; j < 4; ++j) { n0[j] = *(const f32x4*)(s0_ + 4 * lane + 256 * j); n1[j] = *(const f32x4*)(s1_ + 4 * lane + 256 * j); } } \
        else { _Pragma("unroll") for (int j = 0; j < 4; ++j) { const h16x4 q0_ = *(const h16x4*)(xres + (size_t)a_ * D + 4 * lane + 256 * j), q1_ = *(const h16x4*)(xres + (size_t)b_ * D + 4 * lane + 256 * j); \
            n0[j] = (f32x4){(float)q0_[0], (float)q0_[1], (float)q0_[2], (float)q0_[3]}; n1[j] = (f32x4){(float)q1_[0], (float)q1_[1], (float)q1_[2], (float)q1_[3]}; } \
            const unsigned f0_ = (unsigned)__ballot(npe0 >= 0), f1_ = (unsigned)__ballot(npe1 >= 0); \
            const int r0_ = f0_ ? __builtin_amdgcn_readlane(npe0, __builtin_ctz(f0_ | 0x10000u)) : 0, r1_ = f1_ ? __builtin_amdgcn_readlane(npe1, __builtin_ctz(f1_ | 0x10000u)) : 0; \
            _Pragma("unroll") for (int j = 0; j < 4; ++j) { ny0[j] = *(const h16x4*)(yo + (size_t)r0_ * D + 4 * lane + 256 * j); ny1[j] = *(const h16x4*)(yo + (size_t)r1_ * D + 4 * lane + 256 * j); } } }
    if (gw < mend) { RF_INV(gw, npe0, npe1) RF_LOAD(gw) RF_INV(gw + 2 * ngw, qpe0, qpe1) }
    for (int m0 = gw; m0 < mend; m0 += 2 * ngw) {
        const bool has1 = (m0 + ngw) < mend; const int m1 = has1 ? m0 + ngw : m0;
        f32x4 v0[4], v1[4]; h16x4 yf0[4], yf1[4];
#pragma unroll
        for (int j = 0; j < 4; ++j) { v0[j] = n0[j]; v1[j] = n1[j]; yf0[j] = ny0[j]; yf1[j] = ny1[j]; }
        const int pe0 = npe0, pe1 = npe1;
        npe0 = qpe0; npe1 = qpe1;
        if (m0 + 2 * ngw < mend) { RF_LOAD(m0 + 2 * ngw) RF_INV(m0 + 4 * ngw, qpe0, qpe1) }
        if (!pro) {
            f32x4 a0[4], a1[4];
            unsigned k0 = (unsigned)__ballot(pe0 >= 0), k1 = (unsigned)__ballot(pe1 >= 0);
#pragma unroll
            for (int j = 0; j < 4; ++j) {
                a0[j] = k0 ? (f32x4){(float)yf0[j][0], (float)yf0[j][1], (float)yf0[j][2], (float)yf0[j][3]} : (f32x4){0.f, 0.f, 0.f, 0.f};
                a1[j] = k1 ? (f32x4){(float)yf1[j][0], (float)yf1[j][1], (float)yf1[j][2], (float)yf1[j][3]} : (f32x4){0.f, 0.f, 0.f, 0.f}; }
            k0 &= k0 - 1; k1 &= k1 - 1;
            while (k0 | k1) {
                const bool t0 = k0 != 0u, t1 = k1 != 0u;
                const int e0 = t0 ? __builtin_ctz(k0) : 0, e1 = t1 ? __builtin_ctz(k1) : 0;
                k0 &= k0 - 1; k1 &= k1 - 1;
                int pr0 = __builtin_amdgcn_readlane(pe0, e0), pr1 = __builtin_amdgcn_readlane(pe1, e1);
                pr0 = t0 ? pr0 : 0; pr1 = t1 ? pr1 : 0;
                const h16* y0p = yo + (size_t)pr0 * D + 4 * lane; const h16* y1p = yo + (size_t)pr1 * D + 4 * lane;
                h16x4 y0[4], y1[4];
#pragma unroll
                for (int j = 0; j < 4; ++j) { y0[j] = *(const h16x4*)(y0p + 256 * j); y1[j] = *(const h16x4*)(y1p + 256 * j); }
                if (t0) {
#pragma unroll
                    for (int j = 0; j < 4; ++j) a0[j] += (f32x4){(float)y0[j][0], (float)y0[j][1], (float)y0[j][2], (float)y0[j][3]}; }
                if (t1) {
#pragma unroll
                    for (int j = 0; j < 4; ++j) a1[j] += (f32x4){(float)y1[j][0], (float)y1[j][1], (float)y1[j][2], (float)y1[j][3]}; }
            }
            const float* g20 = T + ((size_t)row_modr(m0) * 3 + 2) * D + 4 * lane;
            const float* g21 = T + ((size_t)row_modr(m1) * 3 + 2) * D + 4 * lane;
#pragma unroll
            for (int j = 0; j < 4; ++j) { v0[j] += *(const f32x4*)(g20 + 256 * j) * a0[j]; v1[j] += *(const f32x4*)(g21 + 256 * j) * a1[j]; }
        }
        rowfin_finish(p, l, pro, m0, v0, lane, T);
        if (has1) rowfin_finish(p, l, pro, m1, v1, lane, T);
    }
#undef RF_INV
#undef RF_LOAD
}

DI void phase_norm2(PC p, int l, unsigned char* lds, int cu_lo, int ncu, int m_lo, int m_hi, int wid_) {
    int tidx = tid_from(wid_), bidx = blockIdx.x; asm volatile("" : "+v"(tidx), "+s"(bidx), "+s"(p));
    if (bidx < cu_lo || bidx >= cu_lo + ncu || m_lo >= m_hi) return;
    float* rt = (float*)lds;
    const float* rsrc = p->moe_router + (size_t)l * D * NE;
    float* T2 = rt + NE * D;
    {
        f32x4 w[8];
#pragma unroll
        for (int it = 0; it < 8; ++it) w[it] = ((const f32x4*)rsrc)[tidx + NT * it];
        const float* g2p = p->norm2_g + l * D; const float* mb = (const float*)(p->ws + WS_MOD) + (size_t)l * 9 * 6144 + 3072;
        float gk[2], scv[18], shv[18];
#pragma unroll
        for (int h = 0; h < 2; ++h) gk[h] = g2p[tidx + NT * h];
#pragma unroll
        for (int it = 0; it < 18; ++it) { const int r = it >> 1, k = tidx + NT * (it & 1); scv[it] = mb[(size_t)r * 6144 + 1024 + k]; shv[it] = mb[(size_t)r * 6144 + k]; }
#pragma unroll
        for (int it = 0; it < 8; ++it) { const int i = tidx + NT * it, k = i >> 2, e4 = (i & 3) * 4;
            rt[(e4 + 0) * D + k] = w[it][0]; rt[(e4 + 1) * D + k] = w[it][1]; rt[(e4 + 2) * D + k] = w[it][2]; rt[(e4 + 3) * D + k] = w[it][3]; }
#pragma unroll
        for (int it = 0; it < 18; ++it) { const int r = it >> 1, k = tidx + NT * (it & 1); T2[(r * 2 + 0) * D + k] = gk[it & 1] * (1.0f + scv[it]); T2[(r * 2 + 1) * D + k] = shv[it]; }
    }
    __syncthreads();
    const int lane = tidx & 63, wv = tidx >> 6;
    const int gw = (bidx - cu_lo) * 8 + wv, ngw = ncu * 8;
    const h16* xres = (const h16*)(p->ws + WS_XRES);
    const float* mod = (const float*)(p->ws + WS_MOD);
    h16* hb = (h16*)(p->ws + WS_HB);
    float* aff = (float*)(p->ws + WS_AFF);
    const int mend = m_hi;
    for (int m0 = m_lo + gw; m0 < mend; m0 += 2 * ngw) {
        const bool has1 = (m0 + ngw) < mend; const int m1 = has1 ? m0 + ngw : m0;
        f32x4 v0[4], v1[4];
#pragma unroll
        for (int j = 0; j < 4; ++j) { const h16x4 q0_ = *(const h16x4*)(xres + (size_t)m0 * D + 4 * lane + 256 * j), q1_ = *(const h16x4*)(xres + (size_t)m1 * D + 4 * lane + 256 * j);
            v0[j] = (f32x4){(float)q0_[0], (float)q0_[1], (float)q0_[2], (float)q0_[3]}; v1[j] = (f32x4){(float)q1_[0], (float)q1_[1], (float)q1_[2], (float)q1_[3]}; }
        float ss0 = 0.f, ss1 = 0.f;
#pragma unroll
        for (int j = 0; j < 4; ++j) { ss0 += (v0[j][0] * v0[j][0] + v0[j][1] * v0[j][1]) + (v0[j][2] * v0[j][2] + v0[j][3] * v0[j][3]); ss1 += (v1[j][0] * v1[j][0] + v1[j][1] * v1[j][1]) + (v1[j][2] * v1[j][2] + v1[j][3] * v1[j][3]); }
        ss0 = wave_sum(ss0, lane); ss1 = wave_sum(ss1, lane);
        const float rs0 = __builtin_amdgcn_rsqf(ss0 * (1.0f / D) + EPS), rs1 = __builtin_amdgcn_rsqf(ss1 * (1.0f / D) + EPS);
        const float* tb0 = T2 + (size_t)row_modr(m0) * 2 * D + 4 * lane;
        const float* tb1 = T2 + (size_t)row_modr(m1) * 2 * D + 4 * lane;
#pragma unroll
        for (int j = 0; j < 4; ++j) {
            v0[j] = (v0[j] * rs0) * *(const f32x4*)(tb0 + 256 * j) + *(const f32x4*)(tb0 + D + 256 * j);
            v1[j] = (v1[j] * rs1) * *(const f32x4*)(tb1 + 256 * j) + *(const f32x4*)(tb1 + D + 256 * j);
            *(h16x4*)(hb + (size_t)m0 * D + 4 * lane + 256 * j) = (h16x4){(h16)v0[j][0], (h16)v0[j][1], (h16)v0[j][2], (h16)v0[j][3]};
            if (has1) *(h16x4*)(hb + (size_t)m1 * D + 4 * lane + 256 * j) = (h16x4){(h16)v1[j][0], (h16)v1[j][1], (h16)v1[j][2], (h16)v1[j][3]};
        }
        float lg0[NE], lg1[NE];
#pragma unroll
        for (int e = 0; e < NE; ++e) {
            f32x2 a0 = {0.f, 0.f}, a1 = {0.f, 0.f};
#pragma unroll
            for (int j = 0; j < 4; ++j) { const f32x4 w = *(const f32x4*)(rt + e * D + 4 * lane + 256 * j);
                const f32x2 wl = {w[0], w[1]}, wh = {w[2], w[3]};
                a0 = __builtin_elementwise_fma((f32x2){v0[j][0], v0[j][1]}, wl, a0); a0 = __builtin_elementwise_fma((f32x2){v0[j][2], v0[j][3]}, wh, a0);
                a1 = __builtin_elementwise_fma((f32x2){v1[j][0], v1[j][1]}, wl, a1); a1 = __builtin_elementwise_fma((f32x2){v1[j][2], v1[j][3]}, wh, a1); }
            lg0[e] = a0[0] + a0[1]; lg1[e] = a1[0] + a1[1];
            if (e & 1) asm volatile("" ::: "memory");
        }
#define HALVE_SW(N, SWAP) { _Pragma("unroll") for (int e = 0; e < (N); ++e) { float a_, b_; SWAP(lg0[e], lg0[e + (N)], a_, b_); lg0[e] = a_ + b_; SWAP(lg1[e], lg1[e + (N)], a_, b_); lg1[e] = a_ + b_; } }
        HALVE_SW(8, swap32) HALVE_SW(4, swap16)
#undef HALVE_SW
        { const bool up_ = (lane & 8) != 0;
#pragma unroll
          for (int e = 0; e < 2; ++e) {
            const float k0_ = up_ ? lg0[e + 2] : lg0[e], s0_ = up_ ? lg0[e] : lg0[e + 2]; lg0[e] = k0_ + dpp_f<DPP_ROR8>(s0_);
            const float k1_ = up_ ? lg1[e + 2] : lg1[e], s1_ = up_ ? lg1[e] : lg1[e + 2]; lg1[e] = k1_ + dpp_f<DPP_ROR8>(s1_); } }
        { const bool up_ = (lane & 4) != 0;
          const float k0_ = up_ ? lg0[1] : lg0[0], s0_ = up_ ? lg0[0] : lg0[1]; lg0[0] = k0_ + shx(s0_, 4, lane);
          const float k1_ = up_ ? lg1[1] : lg1[0], s1_ = up_ ? lg1[0] : lg1[1]; lg1[0] = k1_ + shx(s1_, 4, lane); }
        float x0 = lg0[0], x1 = lg1[0];
        x0 += dpp_f<DPP_X2>(x0); x1 += dpp_f<DPP_X2>(x1); x0 += dpp_f<DPP_X1>(x0); x1 += dpp_f<DPP_X1>(x1);
        float mx0 = x0, mx1 = x1;
        mx0 = fmaxf(mx0, dpp_f<DPP_ROR4>(mx0)); mx1 = fmaxf(mx1, dpp_f<DPP_ROR4>(mx1)); mx0 = fmaxf(mx0, dpp_f<DPP_ROR8>(mx0)); mx1 = fmaxf(mx1, dpp_f<DPP_ROR8>(mx1));
        mx0 = max_x32(max_x16(mx0)); mx1 = max_x32(max_x16(mx1));
        const float p0 = __builtin_amdgcn_exp2f((x0 - mx0) * LOG2E), p1 = __builtin_amdgcn_exp2f((x1 - mx1) * LOG2E);
        float d0 = p0, d1 = p1;
        d0 += dpp_f<DPP_ROR4>(d0); d1 += dpp_f<DPP_ROR4>(d1); d0 += dpp_f<DPP_ROR8>(d0); d1 += dpp_f<DPP_ROR8>(d1);
        d0 = sum_x32(sum_x16(d0)); d1 = sum_x32(sum_x16(d1));
        if ((lane & 3) == 0) { aff[(size_t)m0 * NE + (lane >> 2)] = p0 / d0; if (has1) aff[(size_t)m1 * NE + (lane >> 2)] = p1 / d1; }
    }
}

constexpr int LDS_BYTES = 147456;
constexpr size_t W_IN_T = WS_W16, W_OUT_T = WS_W16 + 8 * MiB, W_QKV_T = WS_W16 + 12 * MiB, W_O_T = WS_W16 + 18 * MiB, W_GATE16 = WS_W16 + 22 * MiB;
constexpr size_t W_GU_T = WS_W16 + 24 * MiB, W_DN_T = WS_W16 + 280 * MiB;
static_assert(W_DN_T + 128 * MiB <= WS_END, "ws map");

DI int map_row(int kind, int n) {
    if (kind == 1) { if (n >= 1280) return n; const int d = n & 127, hb = n - d, hh = d >> 6, e = d & 63; return hb + hh * 64 + 2 * (e & 31) + (e >> 5); }
    if (kind == 2) return 256 * (n >> 7) + (n & 127);
    if (kind == 3) return 256 * (n >> 7) + 128 + (n & 127);
    return n;
}
struct CvItem { const float* src; h16* dst; int K, N, kind, k0, n0; };
DI void cv_load(const CvItem& c, f32x4 (&ld)[8], int lane) {
#pragma unroll
    for (int i = 0; i < 8; ++i) ld[i] = __builtin_nontemporal_load((const f32x4*)(c.src + (size_t)(c.k0 + 8 * i + (lane >> 3)) * c.N + c.n0 + (lane & 7) * 4));
}
DI void cv_finish(const CvItem& c, const f32x4 (&ld)[8], float* scr, int lane) {
#pragma unroll
    for (int i = 0; i < 8; ++i) { float* d = scr + (8 * i + (lane >> 3)) * 33 + (lane & 7) * 4; d[0] = ld[i][0]; d[1] = ld[i][1]; d[2] = ld[i][2]; d[3] = ld[i][3]; }
    asm volatile("s_waitcnt lgkmcnt(0)" ::: "memory");
    const int cc = lane & 7;
    const float wsc = c.kind == 2 ? LOG2E : 1.0f;
#pragma unroll
    for (int j = 0; j < 4; ++j) { const int n = (lane >> 3) + 8 * j; const float* sp = scr + (8 * cc) * 33 + n;
        h16x8 o;
#pragma unroll
        for (int q = 0; q < 8; ++q) o[q] = (h16)(sp[q * 33] * wsc);
        __builtin_nontemporal_store(o, (h16x8*)(c.dst + (size_t)map_row(c.kind, c.n0 + n) * c.K + c.k0 + 8 * cc)); }
    asm volatile("s_waitcnt lgkmcnt(0)" ::: "memory");
}
constexpr int CV_DENSE = 5632, CV_PRE = 6144, CV_LAYER = 24576;
constexpr int FQ_A = 76, FQ_T = 24, FQ_Z = 96, FQ_AT = 44;
constexpr int FQ_N1 = 13, FQ_T2 = 6;
constexpr int SEG_T = 224 * FQ_N1 + 128 * FQ_T2, SEG_Z = 64 * FQ_Z, SEG_PREV = SEG_T + SEG_Z, SEG_A_LRU = 192 * FQ_A, SEG_A_ATT = 80 * FQ_A, SEG_AT = 192 * FQ_AT;
DI constexpr int cv_prev(int L) { return L == 0 ? 0 : SEG_PREV; }
constexpr int FQ_C = 10, SEG_C = 224 * FQ_C;
DI constexpr int cv_own(int L) { return (L & 1) ? SEG_A_ATT + (L == DEPTH - 1 ? 0 : SEG_AT) : SEG_A_LRU + (L == 0 ? SEG_C : 0); }
DI constexpr int cv_p(int L) { return CV_LAYER - cv_prev(L) - cv_own(L); }
static_assert(cv_p(0) >= 0 && cv_p(1) >= 0 && cv_p(2) >= 0 && cv_p(3) >= 0, "filler plan");
DI CvItem cv_decode(PC p, int it) {
    constexpr int I_IN = 1024, I_SQ = 512, I_QKV = 768;
    CvItem c; int r = it, item;
    if (r >= CV_PRE) {
        r -= CV_PRE; const int mat = r / I_SQ, le = mat / 3, kind = mat % 3; item = r % I_SQ;
        c.K = D; c.N = FF;
        if (kind == 0) { c.src = p->moe_w_gate + (size_t)le * D * FF; c.dst = (h16*)(p->ws + W_GU_T) + (size_t)le * 2048 * D; c.kind = 2; }
        else if (kind == 1) { c.src = p->moe_w_up + (size_t)le * D * FF; c.dst = (h16*)(p->ws + W_GU_T) + (size_t)le * 2048 * D; c.kind = 3; }
        else { c.src = p->moe_w_down + (size_t)le * FF * D; c.dst = (h16*)(p->ws + W_DN_T) + (size_t)le * D * FF; c.kind = 0; }
    } else if (r >= CV_DENSE) { r -= CV_DENSE; const int mat = r >> 4; item = r & 15;
        c.src = p->lru_gate_w + (size_t)mat * 128 * 256; c.dst = (h16*)(p->ws + W_GATE16) + (size_t)mat * 256 * 128; c.K = 128; c.N = 256; c.kind = 0;
    } else if (r < 2 * I_IN) { const int j = r / I_IN; item = r % I_IN; c.src = p->lru_w_in + (size_t)j * D * 2048; c.dst = (h16*)(p->ws + W_IN_T) + (size_t)j * 2048 * D; c.K = D; c.N = 2048; c.kind = 0;
    } else if (r < 2 * I_IN + 2 * I_SQ) { r -= 2 * I_IN; const int j = r / I_SQ; item = r % I_SQ; c.src = p->lru_w_out + (size_t)j * D * D; c.dst = (h16*)(p->ws + W_OUT_T) + (size_t)j * D * D; c.K = D; c.N = D; c.kind = 0;
    } else if (r < 2 * I_IN + 2 * I_SQ + 2 * I_QKV) { r -= 2 * I_IN + 2 * I_SQ; const int j = r / I_QKV; item = r % I_QKV; c.src = p->attn_w_qkv + (size_t)j * D * QKVW; c.dst = (h16*)(p->ws + W_QKV_T) + (size_t)j * QKVW * D; c.K = D; c.N = QKVW; c.kind = 1;
    } else { r -= 2 * I_IN + 2 * I_SQ + 2 * I_QKV; const int j = r / I_SQ; item = r % I_SQ; c.src = p->attn_w_o + (size_t)j * D * D; c.dst = (h16*)(p->ws + W_O_T) + (size_t)j * D * D; c.K = D; c.N = D; c.kind = 0; }
    const int nblk = c.N / 32; c.k0 = 64 * (item / nblk); c.n0 = 32 * (item % nblk);
    return c;
}
#define CV_PIPE(COUNT, ITEM_OF) { const int cnt_ = (COUNT); if (cnt_ > 0) { CvItem ca_ = cv_decode(p, ITEM_OF(0)), cb_; f32x4 la_[8], lb_[8]; cv_load(ca_, la_, lane); \
        for (int k_ = 0; k_ < cnt_; k_ += 2) { \
            if (k_ + 1 < cnt_) { cb_ = cv_decode(p, ITEM_OF(k_ + 1)); cv_load(cb_, lb_, lane); } \
            cv_finish(ca_, la_, scr, lane); \
            if (k_ + 1 < cnt_) { if (k_ + 2 < cnt_) { ca_ = cv_decode(p, ITEM_OF(k_ + 2)); cv_load(ca_, la_, lane); } cv_finish(cb_, lb_, scr, lane); } } } }
DI void phase_convw(PC p, unsigned char* lds, int wid_) {
    int tidx = tid_from(wid_), bidx = blockIdx.x; asm volatile("" : "+v"(tidx), "+s"(bidx), "+s"(p));
    const int lane = tidx & 63, wv = tidx >> 6;
    float* scr = (float*)lds + wv * (64 * 33 + 16);
    const int gw = bidx * 8 + wv, ngw = gridDim.x * 8;
    if (gridDim.x != 256) {
#define IT_ALL(k) (gw + (k) * ngw)
        CV_PIPE((CV_PRE + 4 * CV_LAYER - gw + ngw - 1) / ngw, IT_ALL)
#undef IT_ALL
        return; }
    const int n0 = cv_p(0), n1 = cv_p(1), n2 = cv_p(2), n3 = cv_p(3), ntot = CV_PRE + n0 + n1 + n2 + n3;
    auto gmap = [&](int k) { int r = gw + k * ngw, g;
        if (r < CV_PRE + n0) g = r;
        else { r -= CV_PRE + n0; if (r < n1) g = CV_PRE + CV_LAYER + r; else { r -= n1; if (r < n2) g = CV_PRE + 2 * CV_LAYER + r; else g = CV_PRE + 3 * CV_LAYER + (r - n2); } }
        return g; };
    CV_PIPE(gw < ntot ? (ntot - gw + ngw - 1) / ngw : 0, gmap)
}
DI void conv_fill(PC p, unsigned char* lds, int l, int first, int quota, int wid_) {
    int tidx = tid_from(wid_), bidx = blockIdx.x; asm volatile("" : "+v"(tidx), "+s"(bidx), "+s"(p), "+s"(l));
    if (l >= DEPTH || gridDim.x != 256) return;
    const int lane = tidx & 63, wv = tidx >> 6;
    float* scr = (float*)lds + wv * (64 * 33 + 16);
    const int base = first;
    int cnt = 0; { const int lim = (CV_LAYER - base) < quota ? (CV_LAYER - base) : quota; cnt = lim > wv ? (lim - wv + 7) / 8 : 0; }
#define IT_FILL(k) (CV_PRE + l * CV_LAYER + base + wv + 8 * (k))
    CV_PIPE(cnt, IT_FILL)
#undef IT_FILL
}

namespace pg8 {
#define PG8_LAS __attribute__((address_space(3)))
constexpr int BM = 256, BK = 64, HALF = 128, HTB = HALF * BK * 2, STAGE_BYTES = 8 * HTB, NXCD = 8, WGM = 8;
DI int lds_byte(int r, int c) { const int st = (r >> 4) * 2 + (c >> 5), rr = r & 15, cc = c & 31, ob = rr * 64 + cc * 2; return st * 1024 + (ob ^ (((ob >> 9) & 1) << 5)); }
DI void stage_rc(int b, int& R, int& C) { const int st = b / 1024, sb = b % 1024, swz = sb ^ (((sb >> 9) & 1) << 5); R = (st >> 1) * 16 + swz / 64; C = (st & 1) * 32 + (swz % 64) / 2; }
DI int perm32(int rho) { const int n = rho >> 4, i = rho & 15; return 8 * (i >> 2) + 4 * n + (i & 3); }
struct Unit { int pm, pn, row0, e, job; };
struct Job { int nM, nN, pm0, TPE; const char* A; const char* Bt; size_t bstride; };
struct Sched {
    Job j0, j1; int n0, nwg, G, c, K;
    DI void init(const Job& a, const Job& b, int G_, int c_, int K_) { j0 = a; j1 = b; n0 = a.nM * a.nN; nwg = n0 + b.nM * b.nN; G = G_; c = c_; K = K_; }
    DI bool next(int i, Unit& u) const {
        const long L = (long)i * G + c; if (L >= nwg || c >= G) return false;
        const int job = L >= n0 ? 1 : 0; int wgid = job ? (int)L - n0 : (int)L;
        const int nM = job ? j1.nM : j0.nM, nN = job ? j1.nN : j0.nN, pm0 = job ? j1.pm0 : j0.pm0, TPE = job ? j1.TPE : j0.TPE, nw = nM * nN;
        { const int q = nw / NXCD, r = nw % NXCD, xcd = wgid % NXCD, off = wgid / NXCD; wgid = (xcd < r ? xcd * (q + 1) : r * (q + 1) + (xcd - r) * q) + off; }
        const int nig = WGM * nN, gid = wgid / nig, fm = gid * WGM, gsz = (nM - fm) < WGM ? (nM - fm) : WGM;
        u.pm = pm0 + fm + ((wgid % nig) % gsz); u.pn = (wgid % nig) / gsz; u.job = job;
        u.row0 = u.pm * 256; u.e = TPE ? (u.pm < 128 ? (u.pm >> 3) : (u.pm - 128)) : 0;
        return true;
    }
    DI const char* a_base(const Unit& u) const { return (u.job ? j1.A : j0.A) + (size_t)u.row0 * K * 2; }
    DI const char* b_base(const Unit& u) const { return (u.job ? j1.Bt : j0.Bt) + (size_t)u.e * (u.job ? j1.bstride : j0.bstride) + (size_t)u.pn * 256 * K * 2; }
};
DI u32x4 pack8(const f32x4 a, const f32x4 b) {
    const h16x8 o = {(h16)a[0], (h16)a[1], (h16)a[2], (h16)a[3], (h16)b[0], (h16)b[1], (h16)b[2], (h16)b[3]};
    return __builtin_bit_cast(u32x4, o);
}
struct EpiF16 {
    static constexpr bool PERM = true;
    h16* O; int ldc;
    DI void operator()(const f32x4 (&acc)[2][2][4][2], const Unit& u, int wr, int wc, int fr, int fq) const {
        const int row0 = u.row0 + wr * 64 + fr, col0 = u.pn * BM + wc * 32 + 8 * fq;
#pragma unroll
        for (int ai = 0; ai < 2; ++ai)
#pragma unroll
            for (int m = 0; m < 4; ++m) { h16* rowp = O + (size_t)(row0 + ai * HALF + m * 16) * ldc + col0;
#pragma unroll
                for (int bj = 0; bj < 2; ++bj) *(u32x4*)(rowp + bj * HALF) = pack8(acc[ai][bj][m][0], acc[ai][bj][m][1]); }
    }
};
struct EpiLruIn {
    static constexpr bool PERM = true;
    h16* yg; h16* xr;
    DI void operator()(const f32x4 (&acc)[2][2][4][2], const Unit& u, int wr, int wc, int fr, int fq) const {
        const int row0 = u.row0 + wr * 64 + fr; const bool act = u.pn < 4;
        h16* base = act ? yg : xr; const int col0 = (u.pn & 3) * BM + wc * 32 + 8 * fq;
#pragma unroll
        for (int ai = 0; ai < 2; ++ai)
#pragma unroll
            for (int m = 0; m < 4; ++m) { h16* rowp = base + (size_t)(row0 + ai * HALF + m * 16) * D + col0;
#pragma unroll
                for (int bj = 0; bj < 2; ++bj) { f32x4 v0 = acc[ai][bj][m][0], v1 = acc[ai][bj][m][1];
                    if (act) {
#pragma unroll
                        for (int q = 0; q < 4; ++q) { v0[q] = gelu_tanh(v0[q]); v1[q] = gelu_tanh(v1[q]); } }
                    *(u32x4*)(rowp + bj * HALF) = pack8(v0, v1); } }
    }
};
struct EpiResid {
    static constexpr bool PERM = true;
    h16* x; const float* gate;
    DI void operator()(const f32x4 (&acc)[2][2][4][2], const Unit& u, int wr, int wc, int fr, int fq) const {
        const float* gp = gate + (size_t)(u.pm < 64 ? (u.pm >> 3) : 8) * 6144;
        const int col0 = u.pn * BM + wc * 32 + 8 * fq;
        f32x4 gv[2][2];
#pragma unroll
        for (int bj = 0; bj < 2; ++bj)
#pragma unroll
            for (int n = 0; n < 2; ++n) gv[bj][n] = *(const f32x4*)(gp + col0 + bj * HALF + n * 4);
        h16x8 xo[2][4][2];
#pragma unroll
        for (int ai = 0; ai < 2; ++ai)
#pragma unroll
            for (int m = 0; m < 4; ++m)
#pragma unroll
                for (int bj = 0; bj < 2; ++bj) xo[ai][m][bj] = *(const h16x8*)(x + (size_t)(u.row0 + ai * HALF + wr * 64 + m * 16 + fr) * D + col0 + bj * HALF);
#pragma unroll
        for (int ai = 0; ai < 2; ++ai)
#pragma unroll
            for (int m = 0; m < 4; ++m) { h16* xp = x + (size_t)(u.row0 + ai * HALF + wr * 64 + m * 16 + fr) * D + col0;
#pragma unroll
                for (int bj = 0; bj < 2; ++bj) { f32x4 o0, o1;
#pragma unroll
                    for (int q = 0; q < 4; ++q) { o0[q] = (float)xo[ai][m][bj][q] + gv[bj][0][q] * acc[ai][bj][m][0][q]; o1[q] = (float)xo[ai][m][bj][4 + q] + gv[bj][1][q] * acc[ai][bj][m][1][q]; }
                    *(u32x4*)(xp + bj * HALF) = pack8(o0, o1); } }
    }
};
struct EpiQKV {
    static constexpr bool PERM = true;
    h16* qkv; const f32x2* tab;
    DI void operator()(const f32x4 (&acc)[2][2][4][2], const Unit& u, int wr, int wc, int fr, int fq) const {
        const int row0 = u.row0 + wr * 64 + fr, col0 = u.pn * BM + wc * 32 + 8 * fq;
        const bool rope = (u.pn < 5) && (u.pm < 64); const float sc = u.pn < 4 ? QSCALE : 1.0f;
        const int hh = wc >> 1, i0 = 16 * (wc & 1) + 4 * fq;
        f32x4 csa[2][4][2];
#pragma unroll
        for (int ai = 0; ai < 2; ++ai)
#pragma unroll
            for (int m = 0; m < 4; ++m) { const int row = row0 + ai * HALF + m * 16;
                csa[ai][m][0] = (f32x4){1.f, 0.f, 1.f, 0.f}; csa[ai][m][1] = csa[ai][m][0];
                if (rope) { const int t = row & 2047, pos = hh ? (t & 63) : (t >> 6); const f32x4* tp = (const f32x4*)(tab + pos * 32 + i0); csa[ai][m][0] = tp[0]; csa[ai][m][1] = tp[1]; } }
#pragma unroll
        for (int ai = 0; ai < 2; ++ai)
#pragma unroll
            for (int m = 0; m < 4; ++m) { const int row = row0 + ai * HALF + m * 16; h16* rowp = qkv + (size_t)row * QKVW + col0;
                const f32x4 cs0 = csa[ai][m][0], cs1 = csa[ai][m][1];
#pragma unroll
                for (int bj = 0; bj < 2; ++bj) { const f32x4 a = acc[ai][bj][m][0], b = acc[ai][bj][m][1]; f32x4 o0, o1;
                    o0[0] = (a[0] * cs0[0] - a[1] * cs0[1]) * sc; o0[1] = (a[0] * cs0[1] + a[1] * cs0[0]) * sc; o0[2] = (a[2] * cs0[2] - a[3] * cs0[3]) * sc; o0[3] = (a[2] * cs0[3] + a[3] * cs0[2]) * sc;
                    o1[0] = (b[0] * cs1[0] - b[1] * cs1[1]) * sc; o1[1] = (b[0] * cs1[1] + b[1] * cs1[0]) * sc; o1[2] = (b[2] * cs1[2] - b[3] * cs1[3]) * sc; o1[3] = (b[2] * cs1[3] + b[3] * cs1[2]) * sc;
                    *(u32x4*)(rowp + bj * HALF) = pack8(o0, o1); } }
    }
};
struct EpiMoe1 {
    static constexpr bool PERM = true;
    h16* act; const float* gvp;
    DI void operator()(const f32x4 (&acc)[2][2][4][2], const Unit& u, int wr, int wc, int fr, int fq) const {
        const int row0 = u.row0 + wr * 64 + fr, col0 = u.pn * HALF + wc * 32 + 8 * fq;
        float gq[2][4];
#pragma unroll
        for (int ai = 0; ai < 2; ++ai)
#pragma unroll
            for (int m = 0; m < 4; ++m) gq[ai][m] = gvp[row0 + ai * HALF + m * 16];
        f32x4 t0[2][4], t1[2][4];
#pragma unroll
        for (int ai = 0; ai < 2; ++ai)
#pragma unroll
            for (int m = 0; m < 4; ++m)
#pragma unroll
                for (int q = 0; q < 4; ++q) { const float g0_ = acc[ai][0][m][0][q], g1_ = acc[ai][0][m][1][q];
                    t0[ai][m][q] = (g0_ * __builtin_amdgcn_rcpf(1.0f + __builtin_amdgcn_exp2f(-g0_))) * acc[ai][1][m][0][q]; t1[ai][m][q] = (g1_ * __builtin_amdgcn_rcpf(1.0f + __builtin_amdgcn_exp2f(-g1_))) * acc[ai][1][m][1][q]; }
        __builtin_amdgcn_sched_barrier(0);
#pragma unroll
        for (int ai = 0; ai < 2; ++ai)
#pragma unroll
            for (int m = 0; m < 4; ++m) { const int row = row0 + ai * HALF + m * 16; const float g = gq[ai][m] * (1.0f / LOG2E); f32x4 o0, o1;
#pragma unroll
                for (int q = 0; q < 4; ++q) { o0[q] = t0[ai][m][q] * g; o1[q] = t1[ai][m][q] * g; }
                *(u32x4*)(act + (size_t)row * FF + col0) = pack8(o0, o1); }
    }
};

struct EpiMoeMix {
    static constexpr bool PERM = true;
    EpiMoe1 e1; EpiF16 e2;
    DI void operator()(const f32x4 (&acc)[2][2][4][2], const Unit& u, int wr, int wc, int fr, int fq) const { if (u.job == 0) e1(acc, u, wr, wc, fr, fq); else e2(acc, u, wr, wc, fr, fq); }
};
template <class Epi>
DI void gemm_phase(PG8_LAS unsigned char* lds, const Sched& S, const Epi& E, int wid_) {
    const int tid = tid_from(wid_);
    const int wid = wid_, lane = tid & 63, wr = wid >> 2, wc = wid & 3, fr = lane & 15, fq = lane >> 4;
    const int K = S.K, nt = K / BK;
    unsigned voffA[2], voffB[2];
#pragma unroll
    for (int i = 0; i < 2; ++i) { int R, C; stage_rc(tid * 16 + i * 8192, R, C); const int Rb = Epi::PERM ? ((R & ~31) + perm32(R & 31)) : R;
        voffA[i] = (unsigned)(R * K + C) * 2u; voffB[i] = (unsigned)(Rb * K + C) * 2u; }
    const size_t kstep = (size_t)(BK * 2);
    const size_t hstep = (size_t)HALF * K * 2;
    const unsigned ldsw = (unsigned)wid * 1024u;
    const int aoff = lds_byte(wr * 64 + fr, fq * 8), boff = lds_byte(wc * 32 + fr, fq * 8);
#define PG8_SA(b, h) (((b) * 2 + (h)) * HTB)
#define PG8_SB(b, h) ((4 + (b) * 2 + (h)) * HTB)
#define PG8_STAGE(bufoff, gbase, voff) do { _Pragma("unroll") for (int _i = 0; _i < 2; ++_i) \
        __builtin_amdgcn_global_load_lds((const unsigned*)((const char*)(gbase) + (voff)[_i]), (PG8_LAS unsigned*)(lds + (bufoff) + ldsw + _i * 8192), 16, 0, 0); } while (0)
#define PG8_LDA(dst, b, h) do { _Pragma("unroll") for (int m = 0; m < 4; ++m) _Pragma("unroll") for (int k = 0; k < 2; ++k) dst[m][k] = *(const PG8_LAS h16x8*)(lds + PG8_SA(b, h) + aoff + m * 2048 + k * 1024); } while (0)
#define PG8_LDB(dst, b, h) do { _Pragma("unroll") for (int n = 0; n < 2; ++n) _Pragma("unroll") for (int k = 0; k < 2; ++k) dst[n][k] = *(const PG8_LAS h16x8*)(lds + PG8_SB(b, h) + boff + n * 2048 + k * 1024); } while (0)
#define PG8_MMA(ai, bj, At, Bt) do { __builtin_amdgcn_s_setprio(1); _Pragma("unroll") for (int m = 0; m < 4; ++m) _Pragma("unroll") for (int n = 0; n < 2; ++n) _Pragma("unroll") for (int k = 0; k < 2; ++k) \
        acc[ai][bj][m][n] = __builtin_amdgcn_mfma_f32_16x16x32_f16(Bt[n][k], At[m][k], acc[ai][bj][m][n], 0, 0, 0); __builtin_amdgcn_s_setprio(0); } while (0)
#define PG8_WAIT_V(n) asm volatile("s_waitcnt vmcnt(" #n ")" ::: "memory")
#define PG8_WAIT_L(n) asm volatile("s_waitcnt lgkmcnt(" #n ")" ::: "memory")
#define PG8_BAR __builtin_amdgcn_s_barrier()
#define PG8_SCHED __builtin_amdgcn_sched_barrier(0)
    Unit cur, nxt; int ui = 0;
    if (!S.next(0, cur)) return;
    f32x4 acc[2][2][4][2];
#pragma unroll
    for (int a = 0; a < 2; ++a)
#pragma unroll
        for (int b = 0; b < 2; ++b)
#pragma unroll
            for (int m = 0; m < 4; ++m)
#pragma unroll
                for (int n = 0; n < 2; ++n) acc[a][b][m][n] = (f32x4){0.f, 0.f, 0.f, 0.f};
    h16x8 At[4][2], B0[2][2], B1[2][2];
    const char* cA = S.a_base(cur); const char* cB = S.b_base(cur);
    PG8_STAGE(PG8_SB(0, 0), cB, voffB); PG8_STAGE(PG8_SB(0, 1), cB + hstep, voffB); PG8_STAGE(PG8_SA(0, 0), cA, voffA); PG8_STAGE(PG8_SA(0, 1), cA + hstep, voffA);
    if (wr == 1) PG8_BAR;
    PG8_WAIT_V(2); PG8_BAR;
    PG8_STAGE(PG8_SB(1, 0), cB + kstep, voffB); PG8_STAGE(PG8_SA(1, 0), cA + kstep, voffA); PG8_STAGE(PG8_SB(1, 1), cB + hstep + kstep, voffB);
    PG8_WAIT_V(6); PG8_BAR;
    for (;;) {
        const bool has_next = S.next(ui + 1, nxt);
        const char* nA = has_next ? S.a_base(nxt) : cA; const char* nB = has_next ? S.b_base(nxt) : cB;
        for (int t = 0; t < nt; t += 2) {
            const bool last = (t == nt - 2);
            const char* a1 = cA + (size_t)(t + 1) * kstep;
            const char* a2 = last ? nA : cA + (size_t)(t + 2) * kstep; const char* b2 = last ? nB : cB + (size_t)(t + 2) * kstep;
            const char* a3 = a2 + kstep; const char* b3 = b2 + kstep;
            PG8_LDB(B0, 0, 0); PG8_LDB(B1, 0, 1); PG8_SCHED; PG8_LDA(At, 0, 0); PG8_STAGE(PG8_SA(1, 1), a1 + hstep, voffA);
            PG8_WAIT_V(8); PG8_WAIT_L(0); PG8_BAR; PG8_MMA(0, 0, At, B0); PG8_MMA(0, 1, At, B1); PG8_BAR; PG8_SCHED;
            PG8_LDA(At, 0, 1); PG8_STAGE(PG8_SB(0, 0), b2, voffB); PG8_STAGE(PG8_SB(0, 1), b2 + hstep, voffB); PG8_STAGE(PG8_SA(0, 0), a2, voffA);
            PG8_WAIT_V(8); PG8_WAIT_L(0); PG8_BAR; PG8_MMA(1, 0, At, B0); PG8_MMA(1, 1, At, B1); PG8_BAR; PG8_SCHED;
            PG8_LDB(B0, 1, 0); PG8_LDB(B1, 1, 1); PG8_SCHED; PG8_LDA(At, 1, 0); PG8_STAGE(PG8_SA(0, 1), a2 + hstep, voffA);
            PG8_WAIT_V(8); PG8_WAIT_L(0); PG8_BAR; PG8_MMA(0, 0, At, B0); PG8_MMA(0, 1, At, B1); PG8_BAR; PG8_SCHED;
            PG8_LDA(At, 1, 1); PG8_STAGE(PG8_SB(1, 0), b3, voffB); PG8_STAGE(PG8_SB(1, 1), b3 + hstep, voffB); PG8_STAGE(PG8_SA(1, 0), a3, voffA);
            PG8_WAIT_V(8); PG8_WAIT_L(0); PG8_BAR; PG8_MMA(1, 0, At, B0); PG8_MMA(1, 1, At, B1); PG8_BAR; PG8_SCHED;
        }
        if (wr == 0) PG8_BAR;
        E(acc, cur, wr, wc, fr, fq);
        if (!has_next) break;
        {
            h16x8 z8 = {0, 0, 0, 0, 0, 0, 0, 0}; asm volatile("" : "+v"(z8));
#pragma unroll
            for (int a = 0; a < 2; ++a)
#pragma unroll
                for (int b = 0; b < 2; ++b)
#pragma unroll
                    for (int m = 0; m < 4; ++m)
#pragma unroll
                        for (int n = 0; n < 2; ++n) acc[a][b][m][n] = __builtin_amdgcn_mfma_f32_16x16x32_f16(z8, z8, (f32x4){0.f, 0.f, 0.f, 0.f}, 0, 0, 0);
        }
        cur = nxt; cA = nA; cB = nB; ++ui;
        if (wr == 1) PG8_BAR;
    }
    PG8_WAIT_V(0);
    PG8_BAR;
#undef PG8_SA
#undef PG8_SB
#undef PG8_STAGE
#undef PG8_LDA
#undef PG8_LDB
#undef PG8_MMA
#undef PG8_WAIT_V
#undef PG8_WAIT_L
#undef PG8_BAR
#undef PG8_SCHED
}
template <class Epi>
DI void gemm_phase_g(PG8_LAS unsigned char* lds, const Sched& S, const Epi& E, const int* gidx, int wid_) {
    const int tid = tid_from(wid_);
    const int wid = wid_, lane = tid & 63, wr = wid >> 2, wc = wid & 3, fr = lane & 15, fq = lane >> 4;
    const int K = S.K, nt = K / BK;
    unsigned voffB[2]; int R0, C0;
    stage_rc(tid * 16, R0, C0);
#pragma unroll
    for (int i = 0; i < 2; ++i) { int R, C; stage_rc(tid * 16 + i * 8192, R, C); const int Rb = Epi::PERM ? ((R & ~31) + perm32(R & 31)) : R; voffB[i] = (unsigned)(Rb * K + C) * 2u; }
    const unsigned cshift = (unsigned)C0 * 2u, rowb = (unsigned)K * 2u;
    const size_t kstep = (size_t)(BK * 2);
    const size_t hstep = (size_t)HALF * K * 2;
    const unsigned ldsw = (unsigned)wid * 1024u;
    const int aoff = lds_byte(wr * 64 + fr, fq * 8), boff = lds_byte(wc * 32 + fr, fq * 8);
#define PG8_SA(b, h) (((b) * 2 + (h)) * HTB)
#define PG8_SB(b, h) ((4 + (b) * 2 + (h)) * HTB)
#define PG8_STAGE(bufoff, gbase, voff) do { _Pragma("unroll") for (int _i = 0; _i < 2; ++_i) \
        __builtin_amdgcn_global_load_lds((const unsigned*)((const char*)(gbase) + (voff)[_i]), (PG8_LAS unsigned*)(lds + (bufoff) + ldsw + _i * 8192), 16, 0, 0); } while (0)
#define PG8_LDA(dst, b, h) do { _Pragma("unroll") for (int m = 0; m < 4; ++m) _Pragma("unroll") for (int k = 0; k < 2; ++k) dst[m][k] = *(const PG8_LAS h16x8*)(lds + PG8_SA(b, h) + aoff + m * 2048 + k * 1024); } while (0)
#define PG8_LDB(dst, b, h) do { _Pragma("unroll") for (int n = 0; n < 2; ++n) _Pragma("unroll") for (int k = 0; k < 2; ++k) dst[n][k] = *(const PG8_LAS h16x8*)(lds + PG8_SB(b, h) + boff + n * 2048 + k * 1024); } while (0)
#define PG8_MMA(ai, bj, At, Bt) do { __builtin_amdgcn_s_setprio(1); _Pragma("unroll") for (int m = 0; m < 4; ++m) _Pragma("unroll") for (int n = 0; n < 2; ++n) _Pragma("unroll") for (int k = 0; k < 2; ++k) \
        acc[ai][bj][m][n] = __builtin_amdgcn_mfma_f32_16x16x32_f16(Bt[n][k], At[m][k], acc[ai][bj][m][n], 0, 0, 0); __builtin_amdgcn_s_setprio(0); } while (0)
#define PG8_WAIT_V(n) asm volatile("s_waitcnt vmcnt(" #n ")" ::: "memory")
#define PG8_WAIT_L(n) asm volatile("s_waitcnt lgkmcnt(" #n ")" ::: "memory")
#define PG8_BAR __builtin_amdgcn_s_barrier()
#define PG8_SCHED __builtin_amdgcn_sched_barrier(0)
#define PG8_ROWOFF(u, o) do { _Pragma("unroll") for (int h_ = 0; h_ < 2; ++h_) _Pragma("unroll") for (int i_ = 0; i_ < 2; ++i_) { int row_ = (u).row0 + h_ * HALF + R0 + 64 * i_; \
        if ((u).job == 0 && gidx) row_ = gidx[row_]; (o)[h_][i_] = (unsigned)row_ * rowb + cshift; } } while (0)
    Unit cur, nxt; int ui = 0;
    if (!S.next(0, cur)) return;
    f32x4 acc[2][2][4][2];
#pragma unroll
    for (int a = 0; a < 2; ++a)
#pragma unroll
        for (int b = 0; b < 2; ++b)
#pragma unroll
            for (int m = 0; m < 4; ++m)
#pragma unroll
                for (int n = 0; n < 2; ++n) acc[a][b][m][n] = (f32x4){0.f, 0.f, 0.f, 0.f};
    h16x8 At[4][2], B0[2][2], B1[2][2];
    unsigned offA[2][2];
    PG8_ROWOFF(cur, offA);
    const char* cAj = cur.job ? S.j1.A : S.j0.A; const char* cB = S.b_base(cur);
    PG8_STAGE(PG8_SB(0, 0), cB, voffB); PG8_STAGE(PG8_SB(0, 1), cB + hstep, voffB); PG8_STAGE(PG8_SA(0, 0), cAj, offA[0]); PG8_STAGE(PG8_SA(0, 1), cAj, offA[1]);
    if (wr == 1) PG8_BAR;
    PG8_WAIT_V(2); PG8_BAR;
    PG8_STAGE(PG8_SB(1, 0), cB + kstep, voffB); PG8_STAGE(PG8_SA(1, 0), cAj + kstep, offA[0]); PG8_STAGE(PG8_SB(1, 1), cB + hstep + kstep, voffB);
    PG8_WAIT_V(6); PG8_BAR;
    for (;;) {
        const bool has_next = S.next(ui + 1, nxt);
        const char* nAj = has_next ? (nxt.job ? S.j1.A : S.j0.A) : cAj; const char* nB = has_next ? S.b_base(nxt) : cB;
        if (has_next) { unsigned offN[2][2]; PG8_ROWOFF(nxt, offN); *(PG8_LAS u32x4*)(lds + STAGE_BYTES + tid * 16) = (u32x4){offN[0][0], offN[0][1], offN[1][0], offN[1][1]}; }
        for (int t = 0; t < nt; t += 2) {
            const bool last = (t == nt - 2);
            const char* a1 = cAj + (size_t)(t + 1) * kstep;
            const char* b2 = last ? nB : cB + (size_t)(t + 2) * kstep; const char* b3 = b2 + kstep;
            PG8_LDB(B0, 0, 0); PG8_LDB(B1, 0, 1); PG8_SCHED; PG8_LDA(At, 0, 0); PG8_STAGE(PG8_SA(1, 1), a1, offA[1]);
            if (last) { if (has_next) { const u32x4 o_ = *(const PG8_LAS u32x4*)(lds + STAGE_BYTES + tid * 16); offA[0][0] = o_[0]; offA[0][1] = o_[1]; offA[1][0] = o_[2]; offA[1][1] = o_[3]; }
                cAj = nAj; }
            const char* a2 = last ? cAj : cAj + (size_t)(t + 2) * kstep; const char* a3 = a2 + kstep;
            PG8_WAIT_V(8); PG8_WAIT_L(0); PG8_BAR; PG8_MMA(0, 0, At, B0); PG8_MMA(0, 1, At, B1); PG8_BAR; PG8_SCHED;
            PG8_LDA(At, 0, 1); PG8_STAGE(PG8_SB(0, 0), b2, voffB); PG8_STAGE(PG8_SB(0, 1), b2 + hstep, voffB); PG8_STAGE(PG8_SA(0, 0), a2, offA[0]);
            PG8_WAIT_V(8); PG8_WAIT_L(0); PG8_BAR; PG8_MMA(1, 0, At, B0); PG8_MMA(1, 1, At, B1); PG8_BAR; PG8_SCHED;
            PG8_LDB(B0, 1, 0); PG8_LDB(B1, 1, 1); PG8_SCHED; PG8_LDA(At, 1, 0); PG8_STAGE(PG8_SA(0, 1), a2, offA[1]);
            PG8_WAIT_V(8); PG8_WAIT_L(0); PG8_BAR; PG8_MMA(0, 0, At, B0); PG8_MMA(0, 1, At, B1); PG8_BAR; PG8_SCHED;
            PG8_LDA(At, 1, 1); PG8_STAGE(PG8_SB(1, 0), b3, voffB); PG8_STAGE(PG8_SB(1, 1), b3 + hstep, voffB); PG8_STAGE(PG8_SA(1, 0), a3, offA[0]);
            PG8_WAIT_V(8); PG8_WAIT_L(0); PG8_BAR; PG8_MMA(1, 0, At, B0); PG8_MMA(1, 1, At, B1); PG8_BAR; PG8_SCHED;
        }
        if (wr == 0) PG8_BAR;
        E(acc, cur, wr, wc, fr, fq);
        if (!has_next) break;
        {
            h16x8 z8 = {0, 0, 0, 0, 0, 0, 0, 0}; asm volatile("" : "+v"(z8));
#pragma unroll
            for (int a = 0; a < 2; ++a)
#pragma unroll
                for (int b = 0; b < 2; ++b)
#pragma unroll
                    for (int m = 0; m < 4; ++m)
#pragma unroll
                        for (int n = 0; n < 2; ++n) acc[a][b][m][n] = __builtin_amdgcn_mfma_f32_16x16x32_f16(z8, z8, (f32x4){0.f, 0.f, 0.f, 0.f}, 0, 0, 0);
        }
        cur = nxt; cB = nB; ++ui;
        if (wr == 1) PG8_BAR;
    }
    PG8_WAIT_V(0);
    PG8_BAR;
#undef PG8_SA
#undef PG8_SB
#undef PG8_STAGE
#undef PG8_LDA
#undef PG8_LDB
#undef PG8_MMA
#undef PG8_WAIT_V
#undef PG8_WAIT_L
#undef PG8_BAR
#undef PG8_SCHED
#undef PG8_ROWOFF
}
}

DI void phase_topk_gather(PC p, int l, unsigned char* lds, int pb_lo, int pb_hi, int blk_rel, int blk_cnt, int wid_) {
    int tidx = tid_from(wid_), bidx = blockIdx.x; asm volatile("" : "+v"(tidx), "+s"(bidx), "+s"(p));
    unsigned* hist = (unsigned*)lds;
    int* wtot = (int*)(lds + 4096);
    const float* aff = (const float*)(p->ws + WS_AFF);
    int* inv = (int*)(p->ws + WS_INV);
    float* gv = (float*)(p->ws + WS_GV);
    int* rowidx = (int*)(p->ws + WS_ROWIDX);
    const int tid = tidx, wv = tid >> 6;
    const int lane = tidx & 63;
    for (int pb = pb_lo + blk_rel; pb < pb_hi; pb += blk_cnt) {
        const int s = pb >> 7, b = (pb >> 4) & 7, e = pb & 15;
        const int n = s ? CTXL : SEQ, cap = n >> 3;
        const int row0 = s ? ML + b * CTXL : b * SEQ;
        const bool wvalid = wv * 256 < n;
        const int m0 = row0 + wv * 256 + lane;
        unsigned v[4];
#pragma unroll
        for (int i = 0; i < 4; ++i) v[i] = wvalid ? __float_as_uint(aff[(size_t)(m0 + 64 * i) * NE + e]) : 0u;
        hist[tid] = 0u; hist[tid + 512] = 0u;
        __syncthreads();
        unsigned prefix = 0u; int need = cap;
#pragma unroll
        for (int ps = 0; ps < 4; ++ps) {
            const int shift = 24 - 8 * ps;
            unsigned* h = hist + ps * 256;
            if (wvalid) {
#pragma unroll
                for (int i = 0; i < 4; ++i) {
                    bool in = true;
                    if (ps > 0) in = ((v[i] ^ prefix) >> ((shift + 8) & 31)) == 0u;
                    if (in) atomicAdd(&h[(v[i] >> shift) & 255u], 1u);
                }
            }
            __syncthreads();
            const uint4 c = *(const uint4*)(h + lane * 4);
            const unsigned sl = c.x + c.y + c.z + c.w;
            unsigned S = sl;
#pragma unroll
            for (int d = 1; d < 64; d <<= 1) {
                const unsigned t = (unsigned)__builtin_amdgcn_ds_bpermute(((lane + d) & 63) * 4, (int)S);
                S += (lane + d < 64) ? t : 0u;
            }
            int a = (int)(S - sl), dsel = -1, nneed = 0;
            if (a < need && need <= a + (int)c.w) { dsel = 4 * lane + 3; nneed = need - a; } a += (int)c.w;
            if (a < need && need <= a + (int)c.z) { dsel = 4 * lane + 2; nneed = need - a; } a += (int)c.z;
            if (a < need && need <= a + (int)c.y) { dsel = 4 * lane + 1; nneed = need - a; } a += (int)c.y;
            if (a < need && need <= a + (int)c.x) { dsel = 4 * lane + 0; nneed = need - a; }
            const u64 bm = __ballot(dsel >= 0);
            const int srcl = (int)__builtin_ctzll(bm);
            dsel = __builtin_amdgcn_readlane(dsel, srcl); nneed = __builtin_amdgcn_readlane(nneed, srcl);
            prefix |= (unsigned)dsel << shift; need = nneed;
        }
        const unsigned T = prefix;
        u64 bg[4], bq[4];
        int wg = 0, wq = 0;
#pragma unroll
        for (int i = 0; i < 4; ++i) {
            bg[i] = __ballot(wvalid && v[i] > T); bq[i] = __ballot(wvalid && v[i] == T);
            wg += __builtin_popcountll(bg[i]); wq += __builtin_popcountll(bq[i]);
        }
        if (lane == 0) { wtot[wv * 2] = wg; wtot[wv * 2 + 1] = wq; }
        __syncthreads();
        int base_g = 0, base_q = 0, tot_g = 0;
#pragma unroll
        for (int w = 0; w < 8; ++w) {
            const int g_ = wtot[2 * w], q_ = wtot[2 * w + 1];
            tot_g += g_;
            if (w < wv) { base_g += g_; base_q += q_; }
        }
        const int pbase = s ? NE * NB * CAPL + e * NB * CAPC + b * CAPC : e * NB * CAPL + b * CAPL;
        if (wvalid) {
#pragma unroll
            for (int i = 0; i < 4; ++i) {
                const int m = m0 + 64 * i;
                int slot = -1;
                if (v[i] > T) slot = base_g + (int)__builtin_amdgcn_mbcnt_hi((unsigned)(bg[i] >> 32), __builtin_amdgcn_mbcnt_lo((unsigned)bg[i], 0u));
                else if (v[i] == T) {
                    const int r = base_q + (int)__builtin_amdgcn_mbcnt_hi((unsigned)(bq[i] >> 32), __builtin_amdgcn_mbcnt_lo((unsigned)bq[i], 0u));
                    if (r < need) slot = tot_g + r;
                }
                base_g += __builtin_popcountll(bg[i]); base_q += __builtin_popcountll(bq[i]);
                if (slot >= 0) { gv[pbase + slot] = __uint_as_float(v[i]); rowidx[pbase + slot] = m; inv[m * NE + e] = pbase + slot; }
                else inv[m * NE + e] = -1;
            }
        }
        __syncthreads();
    }
}
DI float fsig(float x) { return __builtin_amdgcn_rcpf(1.0f + __builtin_amdgcn_exp2f(-LOG2E * x)); }
DI f32x2 pk_fma(f32x2 a, f32x2 b, f32x2 c) { return __builtin_elementwise_fma(a, b, c); }
DI f32x2 pk_mul(f32x2 a, f32x2 b) { return a * b; }
DI f32x2 pk_add(f32x2 a, f32x2 b) { return a + b; }
DI f32x2 pk_one_minus_sq(f32x2 a, f32x2 one) { return __builtin_elementwise_fma(-a, a, one); }
DI void lru_ab_fast(float tr, float ti, float c8l, float xb, float& a, float& bb, float& la2) {
    const float r = __builtin_amdgcn_rcpf(1.0f + __builtin_amdgcn_exp2f(tr)), ig = __builtin_amdgcn_rcpf(1.0f + __builtin_amdgcn_exp2f(ti));
    la2 = c8l * r;
    a = __builtin_amdgcn_exp2f(la2);
    const float om = fmaxf(__builtin_fmaf(-a, a, 1.0f), 0.0f);
    bb = __builtin_amdgcn_sqrtf(om) * (ig * xb);
}
template <int MODE> DI void phase_lru1(PC p, int j, unsigned char* lds, int wid_) {
    int tidx = tid_from(wid_), bidx = blockIdx.x; asm volatile("" : "+v"(tidx), "+s"(bidx), "+s"(p));
    constexpr int XBS = 136;
    h16* XB = (h16*)lds;
    const int tid = tidx, lane = tid & 63, wv = tid >> 6, d = wv >> 2, w4 = wv & 3;
    unsigned* stg = (unsigned*)(lds + 17408) + wv * 512;
    const int blk = bidx & 7, nslot = gridDim.x >> 3;
    if (bidx >= nslot * 8) return;
    const h16* xr = (const h16*)(p->ws + WS_UB) + (size_t)MT * D;
    f32x2* agg = (f32x2*)(p->ws + WS_AGG);
    unsigned* ab16 = (unsigned*)(p->ws + WS_CSCR) + (size_t)d * MT * D + blk * 128 + 32 * w4 + (lane & 3) * 8;
    const h16* GT = (const h16*)(p->ws + W_GATE16) + (size_t)((j * 2 + d) * 8 + blk) * 256 * 128;
    h16x8 Bf[2][2][4];
#pragma unroll
    for (int ct = 0; ct < 2; ++ct)
#pragma unroll
        for (int g = 0; g < 2; ++g)
#pragma unroll
            for (int ks = 0; ks < 4; ++ks) Bf[ct][g][ks] = *(const h16x8*)(GT + (size_t)(g * 128 + 32 * w4 + 16 * ct + (lane & 15)) * 128 + ks * 32 + 8 * (lane >> 4));
    float gbr[2], gbi[2], c8[2];
    f32x2 nl2 = {-LOG2E, -LOG2E}, one2 = {1.0f, 1.0f}, k1024 = {1024.0f, 1024.0f};
    asm volatile("" : "+v"(nl2), "+v"(one2), "+v"(k1024));
#pragma unroll
    for (int ct = 0; ct < 2; ++ct) { const int chl = 32 * w4 + 16 * ct + (lane & 15);
        gbr[ct] = -LOG2E * p->lru_gate_b[((j * 2 + d) * 8 + blk) * 256 + chl]; gbi[ct] = -LOG2E * p->lru_gate_b[((j * 2 + d) * 8 + blk) * 256 + 128 + chl];
        c8[ct] = LOG2E * logsig8(p->lru_lambda[(j * 2 + d) * D + blk * 128 + chl]); }
    const float* cw = p->lru_conv_w + (size_t)j * 4 * D + blk * 128; const float* cb = p->lru_conv_b + (size_t)j * D + blk * 128;
    const bool rev = d != 0;
    const bool first16 = rev ? ((lane >> 4) & 1) != 0 : ((lane >> 4) & 1) == 0;
    const bool first32 = rev ? (lane >> 5) != 0 : (lane >> 5) == 0;
    const int c0 = (tid & 15) * 8, tl0 = tid >> 4;
    h16x8 pre[2][4];
#define LRU_ROWS(q_, row0_, t0_, ns_) const int b_##q_ = (q_) / 36, c_##q_ = (q_) % 36; \
        const int row0_ = c_##q_ < 4 ? ML + b_##q_ * CTXL + c_##q_ * 64 : b_##q_ * SEQ + (c_##q_ - 4) * 64, t0_ = c_##q_ < 4 ? c_##q_ * 64 : (c_##q_ - 4) * 64, ns_ = c_##q_ < 4 ? CTXL : SEQ;
#define LRU_CONV_LOAD(row0_, t0_, ns_) { _Pragma("unroll") for (int rep = 0; rep < 2; ++rep) _Pragma("unroll") for (int k = 0; k < 4; ++k) { \
            const int tl = tl0 + 32 * rep, tt = (t0_) + tl + k - 1; \
            pre[rep][k] = (tt >= 0 && tt < (ns_)) ? *(const h16x8*)(xr + (size_t)((row0_) + tl + k - 1) * D + blk * 128 + c0) : (h16x8){0, 0, 0, 0, 0, 0, 0, 0}; } }
#define LRU_CONV_STORE() { _Pragma("unroll") for (int rep = 0; rep < 2; ++rep) { float acc[8]; \
            { const f32x4 b0 = *(const f32x4*)(cb + c0), b1 = *(const f32x4*)(cb + c0 + 4); acc[0] = b0[0]; acc[1] = b0[1]; acc[2] = b0[2]; acc[3] = b0[3]; acc[4] = b1[0]; acc[5] = b1[1]; acc[6] = b1[2]; acc[7] = b1[3]; } \
            _Pragma("unroll") for (int k = 0; k < 4; ++k) { const f32x4 w0 = *(const f32x4*)(cw + k * D + c0), w1 = *(const f32x4*)(cw + k * D + c0 + 4); \
                _Pragma("unroll") for (int e = 0; e < 4; ++e) { acc[e] += w0[e] * (float)pre[rep][k][e]; acc[4 + e] += w1[e] * (float)pre[rep][k][4 + e]; } } \
            h16x8 o; _Pragma("unroll") for (int e = 0; e < 8; ++e) o[e] = (h16)acc[e]; \
            *(h16x8*)(XB + (tl0 + 32 * rep) * XBS + c0) = o; } }
    int q = bidx >> 3;
    if (q < NB * 36) { LRU_ROWS(q, r0a, t0a, nsa) LRU_CONV_LOAD(r0a, t0a, nsa) LRU_CONV_STORE() }
    for (; q < NB * 36; q += nslot) {
        const int b = q / 36, c = q % 36;
        const int row0 = c < 4 ? ML + b * CTXL + c * 64 : b * SEQ + (c - 4) * 64;
        __syncthreads();
        const int qn = q + nslot; const bool hasn = qn < NB * 36;
        if (hasn) { LRU_ROWS(qn, r0n, t0n, nsn) LRU_CONV_LOAD(r0n, t0n, nsn) }
        float Ac[2] = {1.f, 1.f}, Hc[2] = {0.f, 0.f};
#pragma unroll 1
        for (int k = 0; k < 4; ++k) {
            const int sc = rev ? 3 - k : k;
            f32x4 acc[2][2];
#pragma unroll
            for (int ct = 0; ct < 2; ++ct)
#pragma unroll
                for (int g = 0; g < 2; ++g) acc[ct][g] = (f32x4){0.f, 0.f, 0.f, 0.f};
#pragma unroll
            for (int ks = 0; ks < 4; ++ks) {
                const h16x8 af = *(const h16x8*)(XB + (sc * 16 + (lane & 15)) * XBS + ks * 32 + 8 * (lane >> 4));
#pragma unroll
                for (int ct = 0; ct < 2; ++ct)
#pragma unroll
                    for (int g = 0; g < 2; ++g) acc[ct][g] = __builtin_amdgcn_mfma_f32_16x16x32_f16(af, Bf[ct][g][ks], acc[ct][g], 0, 0, 0);
            }
#pragma unroll
            for (int ct = 0; ct < 2; ++ct) { const int chl = 32 * w4 + 16 * ct + (lane & 15);
                float av[4], bv[4];
                {
                    const f32x2 gbr2 = {gbr[ct], gbr[ct]}, gbi2 = {gbi[ct], gbi[ct]}, c82 = {c8[ct], c8[ct]};
#pragma unroll
                    for (int h = 0; h < 2; ++h) {
                        const f32x2 ar = {acc[ct][0][2 * h], acc[ct][0][2 * h + 1]}, ai = {acc[ct][1][2 * h], acc[ct][1][2 * h + 1]};
                        const f32x2 tr = pk_fma(ar, nl2, gbr2), ti = pk_fma(ai, nl2, gbi2);
                        const f32x2 er = {__builtin_amdgcn_exp2f(tr[0]), __builtin_amdgcn_exp2f(tr[1])}, ei = {__builtin_amdgcn_exp2f(ti[0]), __builtin_amdgcn_exp2f(ti[1])};
                        const f32x2 dr = pk_add(er, one2), di = pk_add(ei, one2);
                        const f32x2 rr = {__builtin_amdgcn_rcpf(dr[0]), __builtin_amdgcn_rcpf(dr[1])}, ig = {__builtin_amdgcn_rcpf(di[0]), __builtin_amdgcn_rcpf(di[1])};
                        const f32x2 la = pk_mul(rr, c82);
                        const f32x2 a2 = {__builtin_amdgcn_exp2f(la[0]), __builtin_amdgcn_exp2f(la[1])};
                        const f32x2 om = pk_one_minus_sq(a2, one2);
                        const f32x2 sq = {__builtin_amdgcn_sqrtf(__builtin_fabsf(om[0])), __builtin_amdgcn_sqrtf(__builtin_fabsf(om[1]))};
                        const int tk = 4 * (lane >> 4) + 2 * h;
                        const f32x2 xb2 = {(float)XB[(sc * 16 + tk) * XBS + chl], (float)XB[(sc * 16 + tk + 1) * XBS + chl]};
                        const f32x2 bb = pk_mul(sq, pk_mul(ig, xb2)), lk = pk_mul(la, k1024);
#pragma unroll
                        for (int e = 0; e < 2; ++e) { const h16x2 pk = {(h16)lk[e], (h16)bb[e]};
                            stg[(tk + e) * 32 + 16 * ct + (lane & 15)] = __builtin_bit_cast(unsigned, pk); av[2 * h + e] = a2[e]; bv[2 * h + e] = bb[e]; }
                    }
                }
                float A, H;
                if (!rev) { A = av[0]; H = bv[0];
#pragma unroll
                    for (int r = 1; r < 4; ++r) { H = av[r] * H + bv[r]; A *= av[r]; } }
                else { A = av[3]; H = bv[3];
#pragma unroll
                    for (int r = 2; r >= 0; --r) { H = av[r] * H + bv[r]; A *= av[r]; } }
                { const float Ao = get_x16(A, lane), Ho = get_x16(H, lane); const float Hn = first16 ? Ao * H + Ho : A * Ho + H; A *= Ao; H = Hn; }
                { const float Ao = get_x32(A, lane), Ho = get_x32(H, lane); const float Hn = first32 ? Ao * H + Ho : A * Ho + H; A *= Ao; H = Hn; }
                Hc[ct] = A * Hc[ct] + H; Ac[ct] *= A;
            }
            asm volatile("s_waitcnt lgkmcnt(0)" ::: "memory"); __builtin_amdgcn_wave_barrier();
            { const int tk = lane >> 2; const u32x4 s0 = *(const u32x4*)(stg + tk * 32 + (lane & 3) * 8), s1 = *(const u32x4*)(stg + tk * 32 + (lane & 3) * 8 + 4);
              unsigned* dst = ab16 + (size_t)(row0 + sc * 16 + tk) * D; *(u32x4*)dst = s0; *(u32x4*)(dst + 4) = s1; }
            asm volatile("s_waitcnt lgkmcnt(0)" ::: "memory"); __builtin_amdgcn_wave_barrier();
        }
        if ((lane >> 4) == 0) {
#pragma unroll
            for (int ct = 0; ct < 2; ++ct) agg[(size_t)((b * 2 + d) * 36 + c) * D + blk * 128 + 32 * w4 + 16 * ct + (lane & 15)] = (f32x2){Ac[ct], Hc[ct]};
        }
        __syncthreads();
        if (hasn) LRU_CONV_STORE()
    }
#undef LRU_ROWS
#undef LRU_CONV_LOAD
#undef LRU_CONV_STORE
}

DI void phase_lru2(PC p, unsigned char* lds, int wid_) {
    int tidx = tid_from(wid_), bidx = blockIdx.x; asm volatile("" : "+v"(tidx), "+s"(bidx), "+s"(p));
    const int tid = tidx, half = tid >> 8, t8 = tid & 255, sd = t8 >> 7, sch = t8 & 127;
    float* SH = (float*)lds + (size_t)half * (2 * 64 * 128);
    const int blk = bidx & 7, nslot = gridDim.x >> 3;
    if (bidx >= nslot * 8) return;
    const unsigned* ab = (const unsigned*)(p->ws + WS_CSCR);
    const float* carry = (const float*)(p->ws + WS_AGG + 4608 * 1024);
    const h16* yg = (const h16*)(p->ws + WS_UB);
    h16* sy = (h16*)(p->ws + WS_SYB);
    for (int q0 = bidx >> 3; q0 < NB * 36; q0 += 2 * nslot) {
        const int q = q0 + half * nslot; const bool live = q < NB * 36;
        const int qq = live ? q : q0, b = qq / 36, c = qq % 36;
        const int row0 = c < 4 ? ML + b * CTXL + c * 64 : b * SEQ + (c - 4) * 64;
        const unsigned* src = ab + (size_t)sd * MT * D + (size_t)row0 * D + blk * 128 + sch;
        unsigned pk[64];
#pragma unroll
        for (int t = 0; t < 64; ++t) pk[t] = src[(size_t)(sd == 0 ? t : 63 - t) * D];
        h16x8 ygv[4];
#pragma unroll
        for (int rep = 0; rep < 4; ++rep) { const int idx = t8 + rep * 256; ygv[rep] = *(const h16x8*)(yg + (size_t)(row0 + (idx >> 4)) * D + blk * 128 + (idx & 15) * 8); }
        float h = carry[(size_t)((b * 2 + sd) * 36 + c) * D + blk * 128 + sch];
        float* sw = SH + (size_t)sd * 64 * 128 + sch;
#pragma unroll
        for (int t = 0; t < 64; ++t) { const h16x2 v = __builtin_bit_cast(h16x2, pk[t]); const float a = __builtin_amdgcn_exp2f((float)v[0] * (1.0f / 1024.0f));
            h = a * h + (float)v[1]; sw[(sd == 0 ? t : 63 - t) * 128] = h; }
        __syncthreads();
        if (live) {
#pragma unroll
            for (int rep = 0; rep < 4; ++rep) {
                const int idx = t8 + rep * 256, tl = idx >> 4, c0 = (idx & 15) * 8;
                const h16x8 yv = ygv[rep];
                const float* s0p = SH + tl * 128 + c0; const float* s1p = s0p + 64 * 128;
                const f32x4 f0 = *(const f32x4*)s0p, f1 = *(const f32x4*)(s0p + 4), r0 = *(const f32x4*)s1p, r1 = *(const f32x4*)(s1p + 4);
                h16x8 o;
#pragma unroll
                for (int e = 0; e < 4; ++e) { o[e] = (h16)((f0[e] + r0[e]) * (float)yv[e]); o[4 + e] = (h16)((f1[e] + r1[e]) * (float)yv[4 + e]); }
                *(h16x8*)(sy + (size_t)(row0 + tl) * D + blk * 128 + c0) = o;
            }
        }
        __syncthreads();
    }
}

DI void phase_lru_carry(PC p, int wid_) {
    int tidx = tid_from(wid_), bidx = blockIdx.x; asm volatile("" : "+v"(tidx), "+s"(bidx), "+s"(p));
    const int gt = bidx * NT + tidx;
    if (gt >= NB * 2 * D) return;
    const int b = gt >> 11, d = (gt >> 10) & 1, ch = gt & 1023;
    const f32x2* ag = (const f32x2*)(p->ws + WS_AGG) + (size_t)((b * 2 + d) * 36) * D + ch;
    float* cr = (float*)(p->ws + WS_AGG + 4608 * 1024) + (size_t)((b * 2 + d) * 36) * D + ch;
    f32x2 v[36];
#pragma unroll
    for (int s2 = 0; s2 < 36; ++s2) { const int cc = d == 0 ? s2 : (s2 < 4 ? 3 - s2 : 39 - s2); v[s2] = ag[(size_t)cc * D]; }
    float h = 0.f;
#pragma unroll
    for (int s2 = 0; s2 < 36; ++s2) { const int cc = d == 0 ? s2 : (s2 < 4 ? 3 - s2 : 39 - s2); cr[(size_t)cc * D] = h; h = v[s2][0] * h + v[s2][1]; }
}

typedef float f32x16 __attribute__((ext_vector_type(16)));
typedef short s16x4 __attribute__((ext_vector_type(4)));
DI h16x4 vtr4(const __attribute__((address_space(3))) unsigned char* ptr) {
    return __builtin_bit_cast(h16x4, __builtin_amdgcn_ds_read_tr16_b64_v4i16((__attribute__((address_space(3))) s16x4*)ptr));
}
DI void phase_attn(PC p, int l, unsigned char* lds, int wid_) {
    int tidx = tid_from(wid_), bidx = blockIdx.x; asm volatile("" : "+v"(tidx), "+s"(bidx), "+s"(p));
    constexpr int KS = 272, VS = 320, KBUF = 64 * KS, VBUF = 64 * VS;
    typedef __attribute__((address_space(3))) unsigned char lds_t;
    lds_t* Kl = (lds_t*)lds; lds_t* Vl = Kl + 2 * KBUF;
    const int tid = tidx, lane = tid & 63, wv = tid >> 6, g = wv >> 1, th = wv & 1, r32 = lane & 31, hi = lane >> 5;
    const h16* qkv = (const h16*)(p->ws + WS_UB);
    h16* o = (h16*)(p->ws + WS_SYB);
    const int j = l >> 1;
    const int nitems = 512 + (l == 3 ? 0 : 64);
    const int srow = tid >> 3, sc = tid & 7;
    const int vtoff = (4 * hi + ((lane & 15) >> 2)) * VS + (16 * ((lane >> 4) & 1) + 4 * (lane & 3)) * 2;
    for (int it = bidx; it < nitems; it += gridDim.x) {
        int b, kvh, q0 = 0, qrow0, jlo = 0, nband = 0;
        if (it < 512) { b = it >> 6; kvh = (it >> 5) & 1; q0 = (it & 31) * 64; qrow0 = b * SEQ + q0;
            jlo = q0 == 0 ? 2 : (q0 == 64 ? 1 : 0); const int jhi = q0 == SEQ - 64 ? 2 : (q0 == SEQ - 128 ? 3 : 4); nband = jhi - jlo + 1; }
        else { const int r = it - 512; b = r >> 3; kvh = (r >> 2) & 1; qrow0 = ML + b * CTXL + (r & 3) * 64; }
        const int nt = nband + 4, hq = kvh * 4 + g, qi = 32 * th + r32;
        const int bandrow0 = b * SEQ + q0 - 128 + 64 * jlo, ctxrow0 = ML + b * CTXL;
        h16x8 qf[8];
        { const h16* qp = qkv + (size_t)(qrow0 + qi) * QKVW + hq * HD + 8 * hi;
#pragma unroll
          for (int ks = 0; ks < 8; ++ks) qf[ks] = *(const h16x8*)(qp + 16 * ks); }
        float m = p->attn_sink[j * NH + hq] * LOG2E, lsum = hi == 0 ? 1.0f : 0.0f;
        f32x16 O[4];
#pragma unroll
        for (int dt = 0; dt < 4; ++dt)
#pragma unroll
            for (int r = 0; r < 16; ++r) O[dt][r] = 0.f;
        u32x4 st[4];
        { const int krow = (nband > 0 ? bandrow0 : ctxrow0) + srow; const h16* kp = qkv + (size_t)krow * QKVW + 1024 + kvh * HD + sc * 8;
          st[0] = *(const u32x4*)kp; st[1] = *(const u32x4*)(kp + 64); st[2] = *(const u32x4*)(kp + 256); st[3] = *(const u32x4*)(kp + 256 + 64); }
        *(__attribute__((address_space(3))) u32x4*)(Kl + srow * KS + sc * 16) = st[0]; *(__attribute__((address_space(3))) u32x4*)(Kl + srow * KS + sc * 16 + 128) = st[1];
        *(__attribute__((address_space(3))) u32x4*)(Vl + srow * VS + sc * 16) = st[2]; *(__attribute__((address_space(3))) u32x4*)(Vl + srow * VS + sc * 16 + 128) = st[3];
        __syncthreads();
        asm volatile("" : "+v"(qf[0]), "+v"(qf[1]), "+v"(qf[2]), "+v"(qf[3]), "+v"(qf[4]), "+v"(qf[5]), "+v"(qf[6]), "+v"(qf[7]));
#pragma unroll 1
        for (int i = 0; i < nt; ++i) {
            const int buf = i & 1;
            if (i + 1 < nt) { const int krow = (i + 1 < nband ? bandrow0 + 64 * (i + 1) : ctxrow0 + 64 * (i + 1 - nband)) + srow; const h16* kp = qkv + (size_t)krow * QKVW + 1024 + kvh * HD + sc * 8;
                st[0] = *(const u32x4*)kp; st[1] = *(const u32x4*)(kp + 64); st[2] = *(const u32x4*)(kp + 256); st[3] = *(const u32x4*)(kp + 256 + 64); }
            const lds_t* Kb = Kl + buf * KBUF; const lds_t* Vb = Vl + buf * VBUF;
            f32x16 s0, s1;
#pragma unroll
            for (int r = 0; r < 16; ++r) { s0[r] = 0.f; s1[r] = 0.f; }
            {
#define AT_KLOAD(dst, kq) { _Pragma("unroll") for (int u_ = 0; u_ < 2; ++u_) { \
                    dst[2 * u_] = *(const __attribute__((address_space(3))) h16x8*)(Kb + r32 * KS + (16 * (2 * (kq) + u_) + 8 * hi) * 2); \
                    dst[2 * u_ + 1] = *(const __attribute__((address_space(3))) h16x8*)(Kb + (32 + r32) * KS + (16 * (2 * (kq) + u_) + 8 * hi) * 2); } }
#define AT_KMMA(src, kq) { _Pragma("unroll") for (int u_ = 0; u_ < 2; ++u_) { \
                    s0 = __builtin_amdgcn_mfma_f32_32x32x16_f16(src[2 * u_], qf[2 * (kq) + u_], s0, 0, 0, 0); \
                    s1 = __builtin_amdgcn_mfma_f32_32x32x16_f16(src[2 * u_ + 1], qf[2 * (kq) + u_], s1, 0, 0, 0); } }
                h16x8 ka[4], kb[4];
                AT_KLOAD(ka, 0) AT_KLOAD(kb, 1)
                __builtin_amdgcn_sched_barrier(0);
                AT_KMMA(ka, 0) AT_KLOAD(ka, 2)
                __builtin_amdgcn_sched_barrier(0);
                AT_KMMA(kb, 1) AT_KLOAD(kb, 3)
                __builtin_amdgcn_sched_barrier(0);
                AT_KMMA(ka, 2) AT_KMMA(kb, 3)
#undef AT_KLOAD
#undef AT_KMMA
            }
            if (i < nband) { const int jt = jlo + i;
                if (jt == 0) {
#pragma unroll
                    for (int r = 0; r < 16; ++r) { const int kv = (r & 3) + 8 * (r >> 2) + 4 * hi; if (kv < qi) s0[r] = -1e30f; if (kv + 32 < qi) s1[r] = -1e30f; } }
                else if (jt == 4) {
#pragma unroll
                    for (int r = 0; r < 16; ++r) { const int kv = (r & 3) + 8 * (r >> 2) + 4 * hi; if (kv > qi) s0[r] = -1e30f; if (kv + 32 > qi) s1[r] = -1e30f; } }
            }
            float mx = fmaxf(s0[0], s1[0]);
#pragma unroll
            for (int r = 1; r < 16; ++r) mx = fmaxf(mx, fmaxf(s0[r], s1[r]));
            mx = max_x32(mx);
            float mnew = m, alpha = 1.0f;
            if (!__all(mx - m <= 8.0f)) { mnew = fmaxf(m, mx); alpha = __builtin_amdgcn_exp2f(m - mnew); }
            m = mnew;
            float rs = 0.f;
#pragma unroll
            for (int r = 0; r < 16; ++r) { s0[r] = __builtin_amdgcn_exp2f(s0[r] - mnew); s1[r] = __builtin_amdgcn_exp2f(s1[r] - mnew); rs += s0[r] + s1[r]; }
            lsum = lsum * alpha + rs;
            if (!__all(alpha == 1.0f)) {
#pragma unroll
                for (int dt = 0; dt < 4; ++dt)
#pragma unroll
                    for (int r = 0; r < 16; ++r) O[dt][r] *= alpha;
            }
            h16x8 pf[2][2];
#pragma unroll
            for (int s2 = 0; s2 < 2; ++s2)
#pragma unroll
                for (int e = 0; e < 8; ++e) { pf[0][s2][e] = (h16)s0[8 * s2 + e]; pf[1][s2][e] = (h16)s1[8 * s2 + e]; }
            {
#define AT_VLOAD(dst, q4) { _Pragma("unroll") for (int dt = 0; dt < 4; ++dt) { const lds_t* vp = Vb + vtoff + (16 * (q4)) * VS + 64 * dt; dst[dt][0] = vtr4(vp); dst[dt][1] = vtr4(vp + 8 * VS); } }
#define AT_VMMA(src, q4) { _Pragma("unroll") for (int dt = 0; dt < 4; ++dt) { const h16x4 v0 = src[dt][0], v1 = src[dt][1]; \
                    const h16x8 va = {v0[0], v0[1], v0[2], v0[3], v1[0], v1[1], v1[2], v1[3]}; \
                    O[dt] = __builtin_amdgcn_mfma_f32_32x32x16_f16(va, pf[(q4) >> 1][(q4) & 1], O[dt], 0, 0, 0); } }
                h16x4 vf[4][2], vg[4][2];
                AT_VLOAD(vf, 0) AT_VLOAD(vg, 1)
                __builtin_amdgcn_sched_barrier(0);
                AT_VMMA(vf, 0) AT_VLOAD(vf, 2)
                __builtin_amdgcn_sched_barrier(0);
                AT_VMMA(vg, 1) AT_VLOAD(vg, 3)
                __builtin_amdgcn_sched_barrier(0);
                AT_VMMA(vf, 2) AT_VMMA(vg, 3)
#undef AT_VLOAD
#undef AT_VMMA
            }
            if (i + 1 < nt) { const int nb = buf ^ 1;
                *(__attribute__((address_space(3))) u32x4*)(Kl + nb * KBUF + srow * KS + sc * 16) = st[0]; *(__attribute__((address_space(3))) u32x4*)(Kl + nb * KBUF + srow * KS + sc * 16 + 128) = st[1];
                *(__attribute__((address_space(3))) u32x4*)(Vl + nb * VBUF + srow * VS + sc * 16) = st[2]; *(__attribute__((address_space(3))) u32x4*)(Vl + nb * VBUF + srow * VS + sc * 16 + 128) = st[3]; }
            __syncthreads();
        }
        const float ltot = sum_x32(lsum), inv = 1.0f / ltot;
        h16* rowp = o + (size_t)(qrow0 + qi) * D + hq * HD + 8 * hi;
#pragma unroll
        for (int dt = 0; dt < 4; ++dt)
#pragma unroll
            for (int rp = 0; rp < 2; ++rp) {
                const h16x4 oa = {(h16)(O[dt][8 * rp] * inv), (h16)(O[dt][8 * rp + 1] * inv), (h16)(O[dt][8 * rp + 2] * inv), (h16)(O[dt][8 * rp + 3] * inv)};
                const h16x4 ob = {(h16)(O[dt][8 * rp + 4] * inv), (h16)(O[dt][8 * rp + 5] * inv), (h16)(O[dt][8 * rp + 6] * inv), (h16)(O[dt][8 * rp + 7] * inv)};
                const u32x2 ua = __builtin_bit_cast(u32x2, oa), ub = __builtin_bit_cast(u32x2, ob);
                const auto s0 = __builtin_amdgcn_permlane32_swap(ua[0], ub[0], false, false), s1 = __builtin_amdgcn_permlane32_swap(ua[1], ub[1], false, false);
                *(u32x4*)(rowp + 32 * dt + 16 * rp) = (u32x4){s0[0], s1[0], s0[1], s1[1]};
            }
    }
}

#define LAS __attribute__((address_space(3)))
#define XB_TMO      128
#define XB_XCNT(j)  (256  + 64 * (j))
#define XB_XSUB(j)  (1280 + 64 * (j))
#define XB_XGEN(j)  (2304 + 64 * (j))
#define XB_TOP      3328
#define XB_TOPGEN   3392
#define XCD_BAR_WORDS 3456
#define XB_SPIN_CAP (1u << 22)
DI unsigned xb_ld(unsigned* p)              { return __hip_atomic_load(p, __ATOMIC_RELAXED, __HIP_MEMORY_SCOPE_AGENT); }
DI unsigned xb_add(unsigned* p, unsigned v) { return __hip_atomic_fetch_add(p, v, __ATOMIC_RELAXED, __HIP_MEMORY_SCOPE_AGENT); }
DI unsigned xb_xcc_id() { return (unsigned)__builtin_amdgcn_s_getreg((3 << 11) | 20) & 0xFu; }
#define XB_SPIN(cond, bar) do { unsigned _sp = 0; while (cond) { __builtin_amdgcn_s_sleep(1); \
    if ((++_sp & 255u) == 0u) { if (xb_ld(&(bar)[XB_TMO])) break; if (_sp > XB_SPIN_CAP) { atomicAdd(&(bar)[XB_TMO], 1u); break; } } } } while (0)
struct XcdBarrier { unsigned* bar; unsigned x; volatile LAS unsigned* st; };
DI XcdBarrier xcd_barrier_post(unsigned* bar, volatile LAS unsigned* st) {
    XcdBarrier b; b.bar = bar; b.x = xb_xcc_id(); b.st = st;
    if (threadIdx.x == 0) (void)xb_add(&bar[XB_XCNT(b.x)], 1u);
    return b;
}
DI void xcd_barrier_complete(unsigned* bar, unsigned x, unsigned& nloc, unsigned& nx) {
    const unsigned G = gridDim.x * gridDim.y * gridDim.z;
    unsigned sum, cnt, mine, sp = 0u;
    for (;;) {
        sum = 0u; cnt = 0u; mine = 0u;
#pragma unroll
        for (unsigned j = 0; j < 16; ++j) { const unsigned c = xb_ld(&bar[XB_XCNT(j)]); sum += c; cnt += (c > 0u) ? 1u : 0u; mine = (j == x) ? c : mine; }
        if (sum == G) break;
        __builtin_amdgcn_s_sleep(1);
        if ((++sp & 255u) == 0u) { if (xb_ld(&bar[XB_TMO])) break; if (sp > XB_SPIN_CAP) { atomicAdd(&bar[XB_TMO], 1u); break; } }
    }
    nloc = mine > 0u ? mine : 1u; nx = cnt > 0u ? cnt : 1u;
}
DI void xcd_barrier(const XcdBarrier& b, int wid_) {
    asm volatile("s_waitcnt vmcnt(0)" ::: "memory");
    __syncthreads();
    if (tid_from(wid_) == 0) {
        unsigned* bar = b.bar;
        __builtin_amdgcn_s_waitcnt(0);
        unsigned nloc = b.st[0], nx = b.st[1];
        if (nloc == 0u) { xcd_barrier_complete(bar, b.x, nloc, nx); b.st[0] = nloc; b.st[1] = nx; }
        const unsigned old = xb_add(&bar[XB_XSUB(b.x)], 1u);
        const unsigned gen = old / nloc;
        if (old + 1u == (gen + 1u) * nloc) {
            __builtin_amdgcn_fence(__ATOMIC_RELEASE, "agent");
            asm volatile("s_waitcnt vmcnt(0)" ::: "memory");
            const unsigned og = xb_add(&bar[XB_TOP], 1u);
            const unsigned tg = og / nx;
            if (og + 1u == (tg + 1u) * nx) {
#pragma unroll
                for (unsigned j = 0; j < 16; ++j) xb_add(&bar[XB_XGEN(j)], 1u);
                __builtin_amdgcn_fence(__ATOMIC_ACQUIRE, "agent");
            } else {
                __builtin_amdgcn_fence(__ATOMIC_ACQUIRE, "agent");
                XB_SPIN(xb_ld(&bar[XB_XGEN(b.x)]) == gen, bar);
            }
            asm volatile("s_waitcnt vmcnt(0)" ::: "memory");
        } else {
            __builtin_amdgcn_fence(__ATOMIC_ACQUIRE, "agent");
            XB_SPIN(xb_ld(&bar[XB_XGEN(b.x)]) == gen, bar);
            asm volatile("s_waitcnt vmcnt(0)" ::: "memory");
        }
    }
    __syncthreads();
}
constexpr int CW_BAR = 4096;
constexpr int MISC_OFF = 147456 - 256;

#ifndef DUP_MASK
#define DUP_MASK 0
#endif
#define BAR(kind) xcd_barrier(bar, wid_)
#define REP(kind) for (int rep_ = 0; rep_ < (((DUP_MASK) >> (kind)) & 1) + 1; ++rep_)
template <int l> DI void run_layers(PC p, unsigned char* lds, const XcdBarrier& bar, int wid_) {
    const h16* hb = (const h16*)(p->ws + WS_HB);
    LAS unsigned char* l3 = (LAS unsigned char*)lds;
    const int G = gridDim.x, bid = blockIdx.x;
    const float* modp = (const float*)(p->ws + WS_MOD);
    {
        const int j = l >> 1;
        const pg8::Job nojob{0, 1, 0, 0, nullptr, nullptr, 0};
        if ((l & 1) == 0) {
            REP(2) { pg8::Sched S; S.init(pg8::Job{MT / 256, 8, 0, 0, (const char*)hb, (const char*)(p->ws + W_IN_T + (size_t)j * 2048 * D * 2), 0}, nojob, G, bid, D);
              pg8::EpiLruIn E{(h16*)(p->ws + WS_UB), (h16*)(p->ws + WS_UB) + (size_t)MT * D}; pg8::gemm_phase(l3, S, E, wid_);
              if (!rep_ && bid >= 64) conv_fill(p, lds, l, cv_p(l) + cv_prev(l) + (bid - 64) * FQ_A, FQ_A, wid_); BAR(2); }
#ifdef LRU_ABL
            phase_lru1<LRU_ABL>(p, j, lds, wid_); BAR(3);
#endif
            REP(3) { phase_lru1<0>(p, j, lds, wid_); BAR(3); phase_lru_carry(p, wid_);
              if (!rep_ && l == 0 && bid >= 32) conv_fill(p, lds, 0, cv_p(0) + SEG_A_LRU + (bid - 32) * FQ_C, FQ_C, wid_); BAR(3); }
            REP(4) { phase_lru2(p, lds, wid_); BAR(4); }
        } else {
            REP(6) { pg8::Sched S; S.init(pg8::Job{MT / 256, 6, 0, 0, (const char*)hb, (const char*)(p->ws + W_QKV_T + (size_t)j * QKVW * D * 2), 0}, nojob, G, bid, D);
              pg8::EpiQKV E{(h16*)(p->ws + WS_UB), (const f32x2*)(p->ws + WS_ROPE)}; pg8::gemm_phase(l3, S, E, wid_);
              if (!rep_ && bid >= 176) conv_fill(p, lds, l, cv_p(l) + cv_prev(l) + (bid - 176) * FQ_A, FQ_A, wid_); BAR(6); }
            REP(7) { phase_attn(p, l, lds, wid_);
              if (!rep_ && l != DEPTH - 1 && bid >= 64) conv_fill(p, lds, l, cv_p(l) + cv_prev(l) + SEG_A_ATT + (bid - 64) * FQ_AT, FQ_AT, wid_); BAR(7); }
        }
        REP(5) {
#pragma unroll 1
            for (int part = 0; part < 3; ++part) {
                if (part == 2 && l == DEPTH - 1) break;
                const bool ctxp = (l < DEPTH - 1);
                const int gG = part == 0 ? G : (part == 1 && ctxp ? (G < 32 ? G : 32) : 0);
                const int gnM = part == 0 ? ML / 256 : (part == 1 && ctxp ? MC / 256 : 0), gpm0 = part == 0 ? 0 : ML / 256;
                if (gnM > 0 && bid < gG) {
                    pg8::Sched S; S.init(pg8::Job{gnM, 4, gpm0, 0, (const char*)(p->ws + WS_SYB), (const char*)(p->ws + ((l & 1) ? W_O_T : W_OUT_T) + (size_t)j * D * D * 2), 0}, nojob, gG, bid, D);
                    pg8::EpiResid E{(h16*)(p->ws + (rep_ ? WS_CSCR : WS_XRES)), modp + (size_t)l * 9 * 6144 + 2048}; pg8::gemm_phase(l3, S, E, wid_);
                } else if (part > 0 && !rep_) {
                    const bool merged = ctxp && G == 256;
                    if (part == 2 && merged) {
                        if (bid < 128) phase_topk_gather(p, l, lds, 0, 128, bid, 128, wid_);
                        else { phase_norm2(p, l, lds, 128, 128, ML, MT, wid_); __syncthreads(); conv_fill(p, lds, l + 1, cv_p((l + 1) & 3) + 224 * FQ_N1 + (bid - 128) * FQ_T2, FQ_T2, wid_); }
                    } else {
                        const int cu_lo = (part == 1 && ctxp) ? gG : 0;
                        phase_norm2(p, l, lds, cu_lo, G - cu_lo, part == 1 ? 0 : ML, part == 1 ? ML : MT, wid_);
                        if (part == 1 && merged && bid >= 32) { __syncthreads(); conv_fill(p, lds, l + 1, cv_p((l + 1) & 3) + (bid - 32) * FQ_N1, FQ_N1, wid_); }
                    }
                }
                BAR(5);
            }
        }
        if (!(l < DEPTH - 1 && G == 256)) {
        REP(10) { phase_topk_gather(p, l, lds, 0, l == 3 ? 128 : 256, bid, G, wid_);
            if (!rep_ && bid >= 128) conv_fill(p, lds, l + 1, cv_p((l + 1) & 3) + (bid - 128) * FQ_T, FQ_T, wid_); BAR(10); }
        }
        REP(11) {
#pragma unroll 1
            for (int part = 0; part < 3; ++part) {
                const bool last = (l == DEPTH - 1);
                if (part == 2 && last) break;
                const int tpe = last ? 8 : 9;
                const int m1n = part == 0 ? 128 : (part == 1 && !last ? 16 : 0), m1p = part == 0 ? 0 : 128;
                const int m2n = part == 0 ? 0 : (part == 1 ? (last ? 128 : 96) : 48), m2p = part == 1 ? 0 : 96;
                pg8::Sched S; S.init(pg8::Job{m1n, 8, m1p, tpe, (const char*)hb, (const char*)(p->ws + W_GU_T + (size_t)l * NE * 2048 * D * 2), (size_t)2048 * D * 2},
                                     pg8::Job{m2n, 4, m2p, tpe, (const char*)(p->ws + WS_ACT), (const char*)(p->ws + W_DN_T + (size_t)l * NE * D * FF * 2), (size_t)D * FF * 2}, G, bid, D);
                pg8::EpiMoeMix E{pg8::EpiMoe1{(h16*)(p->ws + WS_ACT), (const float*)(p->ws + WS_GV)}, pg8::EpiF16{(h16*)(p->ws + WS_YO), D}};
                if (!rep_ && part == 0 && !last && G == 256 && bid >= 128) phase_topk_gather(p, l, lds, 128, 256, bid - 128, 128, wid_);
                pg8::gemm_phase_g(l3, S, E, (const int*)(p->ws + WS_ROWIDX), wid_);
                if (!rep_ && part == 2 && bid >= 192) conv_fill(p, lds, l + 1, cv_p((l + 1) & 3) + SEG_T + (bid - 192) * FQ_Z, FQ_Z, wid_);
                BAR(11);
            }
        }
        REP(13) { if (rep_) BAR(13); }
        phase_rowfin(p, l, lds, wid_);
        if (l < DEPTH - 1) BAR(1);
    }
    if constexpr (l + 1 < DEPTH) run_layers<l + 1>(p, lds, bar, wid_);
}
__global__ void __launch_bounds__(NT, 2) k_main(P p_unused) {
    PC p = (PC)__builtin_amdgcn_kernarg_segment_ptr();
    extern __shared__ __attribute__((aligned(16))) unsigned char lds[];
    volatile LAS unsigned* misc = (volatile LAS unsigned*)((LAS unsigned char*)lds + MISC_OFF);
    if (threadIdx.x < 64) misc[threadIdx.x] = 0u;
    __syncthreads();
    const XcdBarrier bar = xcd_barrier_post((unsigned*)(p->ws + WS_CTL) + CW_BAR, misc + 8);
    const int wid_ = __builtin_amdgcn_readfirstlane((int)threadIdx.x >> 6);
    REP(0) { phase_mod(p, lds, wid_); phase_convw(p, lds, wid_); BAR(0); }
    REP(1) { phase_rowfin(p, 255, lds, wid_); BAR(1); }
    run_layers<0>(p, lds, bar, wid_);
}
#undef REP
#undef BAR

extern "C" void kernel_launch(void* const* d_in, const int* in_sizes, int n_in, void* d_out, int out_size, void* d_ws, size_t ws_size, hipStream_t stream) {
    static int grid = 0;
    if (grid == 0) {
        if (n_in != 23 || out_size != ML * D || ws_size < WS_END) { fprintf(stderr, "kernel_launch: unexpected sizes n_in %d out %d ws %zu\n", n_in, out_size, ws_size); grid = -1; return; }
        int dev = 0, cus = 0, per_cu = 0;
        if (hipGetDevice(&dev) != hipSuccess || hipDeviceGetAttribute(&cus, hipDeviceAttributeMultiprocessorCount, dev) != hipSuccess) { grid = -1; return; }
        if (hipFuncSetAttribute((const void*)k_main, hipFuncAttributeMaxDynamicSharedMemorySize, LDS_BYTES) != hipSuccess) { fprintf(stderr, "hipFuncSetAttribute failed\n"); grid = -1; return; }
        if (hipOccupancyMaxActiveBlocksPerMultiprocessor(&per_cu, (const void*)k_main, NT, LDS_BYTES) != hipSuccess || per_cu < 1) { fprintf(stderr, "occupancy query says %d blocks/CU; not launching\n", per_cu); grid = -1; return; }
        (void)hipGetLastError();
        grid = cus;
    }
    if (grid < 0) return;
    P p{};
    const float** pp = (const float**)&p;
    for (int i = 0; i < 23; ++i) pp[i] = (const float*)d_in[i];
    p.out = (float*)d_out; p.ws = (unsigned char*)d_ws;
    (void)hipMemsetAsync((char*)d_ws + WS_CTL, 0, 1 * MiB, stream);
    hipLaunchKernelGGL(k_main, dim3(grid), dim3(NT), LDS_BYTES, stream, p);
}
```
